# Optimizing an MI355X kernel written in HIP

```python
import math
import jax, jax.numpy as jnp
from jax import lax
import numpy as np

D_MODEL = 1024
BATCH = 32
SEQ = 2048
DEPTH = 1

CHUNK = 64
Q_BLOCK = 128
MLA_HEADS = 8
MLA_NOPE = 64
MLA_ROPE = 32
MLA_V = 64
MLA_Q_RANK = 768
MLA_KV_RANK = 256
ROPE_THETA = 10000.0
DSA_HEADS = 8
DSA_HEAD_DIM = 64
IDX_HEADS = 8
IDX_DIM = 64
DSA_TOPK_MAX = 256
REL_BUCKETS = 32
REL_MAX_DIST = 128
PEER_HEADS = 8
PEER_NKEYS = 128
PEER_QDIM = 256
PEER_TOPK = 16
PEER_TOKENS = 128
N_EXPERTS = PEER_NKEYS * PEER_NKEYS
LN_EPS = 1e-5
RMS_EPS = 1e-6
DEEPNORM_ALPHA = (2.0 * DEPTH) ** 0.25
DEEPNORM_BETA = (8.0 * DEPTH) ** -0.25

IN_SIZES = (
    MLA_Q_RANK,
    MLA_KV_RANK,
    MLA_ROPE,
    DSA_HEADS * DSA_HEAD_DIM,
    DSA_HEAD_DIM,
    DSA_HEAD_DIM,
    IDX_HEADS * IDX_DIM,
    IDX_DIM,
    IDX_HEADS,
    D_MODEL,
    D_MODEL,
)
IN_WIDTH = sum(IN_SIZES)

kernel_name = "hybrid_mla_dsa_peer_deepnorm_block"


def split_cols(h, sizes):
    offs, acc = [], 0
    for s in sizes[:-1]:
        acc += s
        offs.append(acc)
    return jnp.split(h, offs, axis=-1)


def layer_norm(x, g, b):
    xf = x.astype(jnp.float32)
    mu = jnp.mean(xf, axis=-1, keepdims=True)
    var = jnp.mean(jnp.square(xf - mu), axis=-1, keepdims=True)
    y = (xf - mu) * lax.rsqrt(var + LN_EPS) * g.astype(jnp.float32) + b.astype(jnp.float32)
    return y.astype(x.dtype)


def rms_norm(x, g):
    xf = x.astype(jnp.float32)
    y = xf * lax.rsqrt(jnp.mean(jnp.square(xf), axis=-1, keepdims=True) + RMS_EPS)
    return (y * g.astype(jnp.float32)).astype(x.dtype)


def apply_rope(x, pos):
    d = x.shape[-1]
    inv = ROPE_THETA ** (-jnp.arange(0, d, 2, dtype=jnp.float32) / d)
    ang = pos.astype(jnp.float32)[..., None] * inv
    ang = ang.reshape(ang.shape[:2] + (1,) * (x.ndim - 3) + ang.shape[-1:])
    cos, sin = jnp.cos(ang), jnp.sin(ang)
    x1, x2 = jnp.split(x.astype(jnp.float32), 2, axis=-1)
    return jnp.concatenate([x1 * cos - x2 * sin, x2 * cos + x1 * sin], axis=-1).astype(x.dtype)


def t5_bucket(rel):
    nb = REL_BUCKETS // 2
    max_exact = nb // 2
    ret = (rel > 0).astype(jnp.int32) * nb
    n = jnp.abs(rel)
    nf = jnp.maximum(n, 1).astype(jnp.float32)
    large = max_exact + (jnp.log(nf / max_exact) / math.log(REL_MAX_DIST / max_exact)
                         * (nb - max_exact)).astype(jnp.int32)
    large = jnp.minimum(large, nb - 1)
    return ret + jnp.where(n < max_exact, n, large)


def mla_branch(c_q, c_kv, k_rope_in, pos, mla_q_norm, mla_kv_norm, w_q_up, w_kv_up):
    B, S, _ = c_q.shape
    q = (rms_norm(c_q, mla_q_norm) @ w_q_up).reshape(B, S, MLA_HEADS, MLA_NOPE + MLA_ROPE)
    q_nope, q_pe = q[..., :MLA_NOPE], apply_rope(q[..., MLA_NOPE:], pos)
    kv = (rms_norm(c_kv, mla_kv_norm) @ w_kv_up).reshape(B, S, MLA_HEADS, MLA_NOPE + MLA_V)
    k_nope, v = kv[..., :MLA_NOPE], kv[..., MLA_NOPE:]
    k_pe = apply_rope(k_rope_in, pos)
    scale = (MLA_NOPE + MLA_ROPE) ** -0.5
    chunk = pos // CHUNK

    def block(i):
        s0 = i * Q_BLOCK
        qn = lax.dynamic_slice_in_dim(q_nope, s0, Q_BLOCK, axis=1)
        qp = lax.dynamic_slice_in_dim(q_pe, s0, Q_BLOCK, axis=1)
        cq = lax.dynamic_slice_in_dim(chunk, s0, Q_BLOCK, axis=1)
        logits = (jnp.einsum('bqhd,bkhd->bhqk', qn, k_nope, preferred_element_type=jnp.float32)
                  + jnp.einsum('bqhd,bkd->bhqk', qp, k_pe, preferred_element_type=jnp.float32)) * scale
        mask = cq[:, None, :, None] >= chunk[:, None, None, :]
        p = jax.nn.softmax(jnp.where(mask, logits, -jnp.inf), axis=-1)
        return jnp.einsum('bhqk,bkhd->bqhd', p.astype(v.dtype), v)

    out = lax.map(block, jnp.arange(S // Q_BLOCK))
    return out.transpose(1, 0, 2, 3, 4).reshape(B, S, MLA_HEADS * MLA_V)


def dsa_branch(q, k, v, q_idx, k_idx, w_idx, pos, rel_bias):
    B, S, _ = q.shape
    q = q.reshape(B, S, DSA_HEADS, DSA_HEAD_DIM)
    q_idx = q_idx.reshape(B, S, IDX_HEADS, IDX_DIM)
    w_idx = w_idx.astype(jnp.float32) * IDX_HEADS ** -0.5
    topk = min(DSA_TOPK_MAX, S // 4)
    chunk = pos // CHUNK
    scale = DSA_HEAD_DIM ** -0.5
    take = jax.vmap(lambda a, idx: a[idx])

    def block(i):
        s0 = i * Q_BLOCK
        qb = lax.dynamic_slice_in_dim(q, s0, Q_BLOCK, axis=1)
        qib = lax.dynamic_slice_in_dim(q_idx, s0, Q_BLOCK, axis=1)
        wib = lax.dynamic_slice_in_dim(w_idx, s0, Q_BLOCK, axis=1)
        pq = lax.dynamic_slice_in_dim(pos, s0, Q_BLOCK, axis=1)
        cq = pq // CHUNK
        dots = jnp.einsum('bqhd,bkd->bhqk', qib, k_idx, preferred_element_type=jnp.float32) * IDX_DIM ** -0.5
        score = jnp.einsum('bqh,bhqk->bqk', wib, jax.nn.relu(dots))
        allowed = cq[:, :, None] >= chunk[:, None, :]
        _, sel = lax.top_k(jnp.where(allowed, score, -jnp.inf), topk)
        k_sel = take(k, sel)
        v_sel = take(v, sel)
        pos_sel = take(pos, sel)
        valid = (pos_sel // CHUNK) <= cq[:, :, None]
        bias = rel_bias.astype(jnp.float32)[t5_bucket(pos_sel - pq[:, :, None])]
        logits = (jnp.einsum('bqhd,bqkd->bqhk', qb, k_sel, preferred_element_type=jnp.float32) * scale
                  + bias.transpose(0, 1, 3, 2))
        p = jax.nn.softmax(jnp.where(valid[:, :, None, :], logits, -jnp.inf), axis=-1)
        return jnp.einsum('bqhk,bqkd->bqhd', p.astype(v.dtype), v_sel)

    out = lax.map(block, jnp.arange(S // Q_BLOCK))
    return out.transpose(1, 0, 2, 3, 4).reshape(B, S, DSA_HEADS * DSA_HEAD_DIM)


def peer_layer(x, w_peer_q, peer_sub_keys, peer_u, peer_v):
    B, S, D = x.shape
    xt = x.reshape(-1, PEER_TOKENS, D)

    def block(xb):
        T = xb.shape[0]
        q = (xb @ w_peer_q).reshape(T, PEER_HEADS, 2, PEER_QDIM // 2)
        s = jnp.einsum('thpd,hpnd->thpn', q, peer_sub_keys, preferred_element_type=jnp.float32)
        v1, i1 = lax.top_k(s[:, :, 0], PEER_TOPK)
        v2, i2 = lax.top_k(s[:, :, 1], PEER_TOPK)
        cand = (v1[..., :, None] + v2[..., None, :]).reshape(T, PEER_HEADS, PEER_TOPK * PEER_TOPK)
        cidx = (i1[..., :, None] * PEER_NKEYS + i2[..., None, :]).reshape(T, PEER_HEADS, PEER_TOPK * PEER_TOPK)
        top, pick = lax.top_k(cand, PEER_TOPK)
        eidx = jnp.take_along_axis(cidx, pick, axis=-1)
        g = jax.nn.softmax(top, axis=-1)
        u = jnp.take(peer_u, eidx, axis=0)
        a = jax.nn.gelu(jnp.einsum('thkd,td->thk', u, xb, preferred_element_type=jnp.float32))
        vv = jnp.take(peer_v, eidx, axis=0)
        return jnp.einsum('thk,thkd->td', (g * a).astype(xb.dtype), vv)

    return lax.map(block, xt).reshape(B, S, D)


def setup_inputs(seed: int = 0) -> dict:
    key = jax.random.key(seed)
    ks = jax.random.split(key, 24)
    f32 = jnp.float32
    nrm = lambda k, shape, s: jax.random.normal(k, shape, f32) * s
    offs = CHUNK * jax.random.randint(ks[0], (BATCH, 1), 0, 256, dtype=jnp.int32)
    positions = (offs + jnp.arange(SEQ, dtype=jnp.int32)[None, :]).astype(jnp.int32)
    return {
        "x": nrm(ks[1], (BATCH, SEQ, D_MODEL), 1.0),
        "positions": positions,
        "w_in": nrm(ks[2], (D_MODEL, IN_WIDTH), D_MODEL ** -0.5),
        "b_in": nrm(ks[3], (IN_WIDTH,), 0.02),
        "mla_q_norm": 1.0 + nrm(ks[4], (MLA_Q_RANK,), 0.02),
        "mla_kv_norm": 1.0 + nrm(ks[5], (MLA_KV_RANK,), 0.02),
        "w_q_up": nrm(ks[6], (MLA_Q_RANK, MLA_HEADS * (MLA_NOPE + MLA_ROPE)), MLA_Q_RANK ** -0.5),
        "w_kv_up": nrm(ks[7], (MLA_KV_RANK, MLA_HEADS * (MLA_NOPE + MLA_V)), MLA_KV_RANK ** -0.5),
        "w_o_mla": nrm(ks[8], (MLA_HEADS * MLA_V, D_MODEL), (MLA_HEADS * MLA_V) ** -0.5),
        "w_o_dsa": nrm(ks[9], (DSA_HEADS * DSA_HEAD_DIM, D_MODEL), (DSA_HEADS * DSA_HEAD_DIM) ** -0.5),
        "rel_bias": nrm(ks[10], (REL_BUCKETS, DSA_HEADS), 0.5),
        "w_out": nrm(ks[11], (D_MODEL, D_MODEL), DEEPNORM_BETA * D_MODEL ** -0.5),
        "ln1_g": 1.0 + nrm(ks[12], (D_MODEL,), 0.02),
        "ln1_b": nrm(ks[13], (D_MODEL,), 0.02),
        "w_peer_q": nrm(ks[14], (D_MODEL, PEER_HEADS * PEER_QDIM), D_MODEL ** -0.5),
        "peer_sub_keys": nrm(ks[15], (PEER_HEADS, 2, PEER_NKEYS, PEER_QDIM // 2), (PEER_QDIM // 2) ** -0.5),
        "peer_u": nrm(ks[16], (N_EXPERTS, D_MODEL), D_MODEL ** -0.5),
        "peer_v": nrm(ks[17], (N_EXPERTS, D_MODEL), DEEPNORM_BETA),
        "ln2_g": 1.0 + nrm(ks[18], (D_MODEL,), 0.02),
        "ln2_b": nrm(ks[19], (D_MODEL,), 0.02),
    }


def reference(x, positions, w_in, b_in, mla_q_norm, mla_kv_norm, w_q_up, w_kv_up,
              w_o_mla, w_o_dsa, rel_bias, w_out, ln1_g, ln1_b,
              w_peer_q, peer_sub_keys, peer_u, peer_v, ln2_g, ln2_b):
    for _ in range(DEPTH):
        h = x @ w_in + b_in
        (c_q, c_kv, k_rope, q_b, k_b, v_b, q_idx, k_idx, w_idx, g_a, g_b) = split_cols(h, IN_SIZES)
        o_a = mla_branch(c_q, c_kv, k_rope, positions, mla_q_norm, mla_kv_norm, w_q_up, w_kv_up) @ w_o_mla
        o_b = dsa_branch(q_b, k_b, v_b, q_idx, k_idx, w_idx, positions, rel_bias) @ w_o_dsa
        merged = jax.nn.sigmoid(g_a) * o_a + jax.nn.sigmoid(g_b) * o_b
        x = layer_norm(DEEPNORM_ALPHA * x + merged @ w_out, ln1_g, ln1_b)
        x = layer_norm(DEEPNORM_ALPHA * x + peer_layer(x, w_peer_q, peer_sub_keys, peer_u, peer_v), ln2_g, ln2_b)
    return x
```

```cpp
#include <hip/hip_runtime.h>
#include <cstdio>
#include <cstdint>
namespace pg8 {
#define PG8_LAS __attribute__((address_space(3)))
typedef unsigned short bf16_t;
typedef short bf16x8 __attribute__((ext_vector_type(8)));
typedef float f32x4 __attribute__((ext_vector_type(4)));
typedef unsigned u32x4 __attribute__((ext_vector_type(4)));
constexpr int BM = 256, BK = 64, HALF = 128, HTB = HALF * BK * 2  , STAGE_BYTES = 8 * HTB, NXCD = 8, WGM = 8;

__host__ __device__ __forceinline__ int lds_byte(int r, int c) { const int st = (r >> 4) * 2 + (c >> 5), rr = r & 15, cc = c & 31, ob = rr * 64 + cc * 2; return st * 1024 + (ob ^ (((ob >> 9) & 1) << 5)); }
__host__ __device__ __forceinline__ void stage_rc(int b, int& R, int& C) { const int st = b / 1024, sb = b % 1024, swz = sb ^ (((sb >> 9) & 1) << 5); R = (st >> 1) * 16 + swz / 64; C = (st & 1) * 32 + (swz % 64) / 2; }
__host__ __device__ __forceinline__ int perm32(int rho) { const int n = rho >> 4, i = rho & 15; return 8 * (i >> 2) + 4 * n + (i & 3); }

struct Unit { int pm, pn; };
struct Gemm { const bf16_t* A; const bf16_t* Bt; int M, N, K, lda, ldb; };

struct StaticOrder {
    int nM, nN, nwg, G, c;
    __host__ __device__ void init(int M, int N, int G_, int c_) { nM = M / BM; nN = N / BM; nwg = nM * nN; G = G_; c = c_; }
    __host__ __device__ bool next(int i, Unit& u) const {
        const long L = (long)i * G + c; if (L >= nwg) return false;
        int wgid = (int)L; { const int q = nwg / NXCD, r = nwg % NXCD, xcd = wgid % NXCD, off = wgid / NXCD; wgid = (xcd < r ? xcd * (q + 1) : r * (q + 1) + (xcd - r) * q) + off; }
        const int nig = WGM * nN, gid = wgid / nig, fm = gid * WGM, gsz = (nM - fm) < WGM ? (nM - fm) : WGM;
        u.pm = fm + ((wgid % nig) % gsz); u.pn = (wgid % nig) / gsz; return true;
    }
    __device__ __forceinline__ void a_ready(const Unit&) const {}
    __device__ __forceinline__ void done(const Unit&) const {}
};
__device__ __forceinline__ unsigned cvt_pk_bf16(float lo, float hi) { unsigned r; asm volatile("v_cvt_pk_bf16_f32 %0, %1, %2" : "=v"(r) : "v"(lo), "v"(hi)); return r; }
__device__ __forceinline__ float bflo(unsigned w) { return __uint_as_float(w << 16); }
__device__ __forceinline__ float bfhi(unsigned w) { return __uint_as_float(w & 0xffff0000u); }
typedef int i32x4 __attribute__((ext_vector_type(4)));
struct EpiBf16 { typedef f32x4 AccT;
    static constexpr bool PERM = true, AFTER_DRAIN = false, HAS_MID = false;
    bf16_t* O; int ldc; const float* bias;
    __device__ __forceinline__ void operator()(const f32x4 (&acc)[2][2][4][2], const Unit& u, int wr, int wc, int fr, int fq) const {
        const int row0 = u.pm * BM + wr * 64 + fr, col0 = u.pn * BM + wc * 32 + 8 * fq;
        f32x4 bv[2][2];
#pragma unroll
        for (int bj = 0; bj < 2; ++bj)
#pragma unroll
            for (int n = 0; n < 2; ++n) bv[bj][n] = bias ? *(const f32x4*)(bias + col0 + bj * HALF + 4 * n) : (f32x4){0.f, 0.f, 0.f, 0.f};
#pragma unroll
        for (int ai = 0; ai < 2; ++ai)
#pragma unroll
            for (int m = 0; m < 4; ++m) { bf16_t* rowp = O + (size_t)(row0 + ai * HALF + m * 16) * ldc + col0;
#pragma unroll
                for (int bj = 0; bj < 2; ++bj) { const f32x4 v0 = acc[ai][bj][m][0] + bv[bj][0], v1 = acc[ai][bj][m][1] + bv[bj][1];
                    u32x4 w; w.x = cvt_pk_bf16(v0[0], v0[1]); w.y = cvt_pk_bf16(v0[2], v0[3]); w.z = cvt_pk_bf16(v1[0], v1[1]); w.w = cvt_pk_bf16(v1[2], v1[3]);
                    *(u32x4*)(rowp + bj * HALF) = w; } }
    }
};
struct EpiI8 { typedef i32x4 AccT;
    static constexpr bool PERM = true, AFTER_DRAIN = false, HAS_MID = false;
    bf16_t* O; int ldc; const float* sa; const float* sb; const float* bias;
    __device__ __forceinline__ void operator()(const i32x4 (&acc)[2][2][4][2], const Unit& u, int wr, int wc, int fr, int fq) const {
        const int row0 = u.pm * BM + wr * 64 + fr, col0 = u.pn * BM + wc * 32 + 8 * fq;
        f32x4 bv[2][2], sv[2][2];
#pragma unroll
        for (int bj = 0; bj < 2; ++bj)
#pragma unroll
            for (int n = 0; n < 2; ++n) { bv[bj][n] = bias ? *(const f32x4*)(bias + col0 + bj * HALF + 4 * n) : (f32x4){0.f, 0.f, 0.f, 0.f}; sv[bj][n] = *(const f32x4*)(sb + col0 + bj * HALF + 4 * n); }
#pragma unroll
        for (int ai = 0; ai < 2; ++ai)
#pragma unroll
            for (int m = 0; m < 4; ++m) { const int row = row0 + ai * HALF + m * 16; const float sr = sa[row]; bf16_t* rowp = O + (size_t)row * ldc + col0;
#pragma unroll
                for (int bj = 0; bj < 2; ++bj) { f32x4 v0, v1;
#pragma unroll
                    for (int i = 0; i < 4; ++i) { v0[i] = (float)acc[ai][bj][m][0][i] * (sr * sv[bj][0][i]) + bv[bj][0][i]; v1[i] = (float)acc[ai][bj][m][1][i] * (sr * sv[bj][1][i]) + bv[bj][1][i]; }
                    u32x4 w; w.x = cvt_pk_bf16(v0[0], v0[1]); w.y = cvt_pk_bf16(v0[2], v0[3]); w.z = cvt_pk_bf16(v1[0], v1[1]); w.w = cvt_pk_bf16(v1[2], v1[3]);
                    *(u32x4*)(rowp + bj * HALF) = w; } }
    }
};
struct EpiI8G { typedef i32x4 AccT;
    static constexpr bool PERM = true, AFTER_DRAIN = false, HAS_MID = false;
    bf16_t* O; int ldc; const float* sa; const float* sb; const float* bias; int glo, ghi, f8hi;
    __device__ __forceinline__ void operator()(const i32x4 (&acc)[2][2][4][2], const Unit& u, int wr, int wc, int fr, int fq) const {
        const int row0 = u.pm * BM + wr * 64 + fr, col0 = u.pn * BM + wc * 32 + 8 * fq; const bool gate = (u.pn * BM >= glo) && (u.pn * BM < ghi), f8 = u.pn * BM < f8hi;
        f32x4 bv[2][2], sv[2][2];
#pragma unroll
        for (int bj = 0; bj < 2; ++bj)
#pragma unroll
            for (int n = 0; n < 2; ++n) { bv[bj][n] = *(const f32x4*)(bias + col0 + bj * HALF + 4 * n); sv[bj][n] = *(const f32x4*)(sb + col0 + bj * HALF + 4 * n); }
#pragma unroll
        for (int ai = 0; ai < 2; ++ai)
#pragma unroll
            for (int m = 0; m < 4; ++m) { const int row = row0 + ai * HALF + m * 16; const float sr = sa[row]; bf16_t* rowp = O + (size_t)row * ldc + col0;
                unsigned char* growp = (unsigned char*)(O + (size_t)row * ldc + glo) + (col0 - glo);
#pragma unroll
                for (int bj = 0; bj < 2; ++bj) { f32x4 v0, v1;
#pragma unroll
                    for (int i = 0; i < 4; ++i) { v0[i] = (float)acc[ai][bj][m][0][i] * (sr * sv[bj][0][i]) + bv[bj][0][i]; v1[i] = (float)acc[ai][bj][m][1][i] * (sr * sv[bj][1][i]) + bv[bj][1][i]; }
                    if (gate) { unsigned w4 = 0u;
#pragma unroll
                        for (int i = 0; i < 4; ++i) { const float s0 = 15.0f * __builtin_amdgcn_rcpf(1.0f + __builtin_amdgcn_exp2f(-1.44269504f * v0[i])), s1 = 15.0f * __builtin_amdgcn_rcpf(1.0f + __builtin_amdgcn_exp2f(-1.44269504f * v1[i]));
                            w4 |= ((unsigned)__builtin_rintf(s0) << (4 * i)) | ((unsigned)__builtin_rintf(s1) << (16 + 4 * i)); }
                        *(unsigned*)((unsigned char*)(O + (size_t)row * ldc + glo) + ((col0 - glo + bj * HALF) >> 1)) = w4; }
                    else if (f8) { int w0 = 0, w1 = 0;
#pragma unroll
                        for (int i = 0; i < 4; ++i) { v0[i] = __builtin_fminf(__builtin_fmaxf(v0[i], -448.0f), 448.0f); v1[i] = __builtin_fminf(__builtin_fmaxf(v1[i], -448.0f), 448.0f); }
                        w0 = __builtin_amdgcn_cvt_pk_fp8_f32(v0[0], v0[1], w0, false); w0 = __builtin_amdgcn_cvt_pk_fp8_f32(v0[2], v0[3], w0, true);
                        w1 = __builtin_amdgcn_cvt_pk_fp8_f32(v1[0], v1[1], w1, false); w1 = __builtin_amdgcn_cvt_pk_fp8_f32(v1[2], v1[3], w1, true);
                        typedef unsigned u32x2 __attribute__((ext_vector_type(2))); u32x2 w; w.x = (unsigned)w0; w.y = (unsigned)w1; *(u32x2*)((unsigned char*)(O + (size_t)row * ldc) + col0 + bj * HALF) = w; }
                    else { u32x4 w; w.x = cvt_pk_bf16(v0[0], v0[1]); w.y = cvt_pk_bf16(v0[2], v0[3]); w.z = cvt_pk_bf16(v1[0], v1[1]); w.w = cvt_pk_bf16(v1[2], v1[3]);
                        *(u32x4*)(rowp + bj * HALF) = w; } } }
    }
};
struct EpiI8F8 { typedef i32x4 AccT;
    static constexpr bool PERM = true, AFTER_DRAIN = false, HAS_MID = false;
    unsigned char* O; int ldc; const float* sa; const float* sb;
    __device__ __forceinline__ void operator()(const i32x4 (&acc)[2][2][4][2], const Unit& u, int wr, int wc, int fr, int fq) const {
        const int row0 = u.pm * BM + wr * 64 + fr, col0 = u.pn * BM + wc * 32 + 8 * fq; typedef unsigned u32x2 __attribute__((ext_vector_type(2)));
        f32x4 sv[2][2];
#pragma unroll
        for (int bj = 0; bj < 2; ++bj)
#pragma unroll
            for (int n = 0; n < 2; ++n) sv[bj][n] = *(const f32x4*)(sb + col0 + bj * HALF + 4 * n);
#pragma unroll
        for (int ai = 0; ai < 2; ++ai)
#pragma unroll
            for (int m = 0; m < 4; ++m) { const int row = row0 + ai * HALF + m * 16; const float sr = sa[row];
#pragma unroll
                for (int bj = 0; bj < 2; ++bj) { float v[8];
#pragma unroll
                    for (int i = 0; i < 4; ++i) { v[i] = __builtin_fminf(__builtin_fmaxf((float)acc[ai][bj][m][0][i] * (sr * sv[bj][0][i]), -448.0f), 448.0f); v[4 + i] = __builtin_fminf(__builtin_fmaxf((float)acc[ai][bj][m][1][i] * (sr * sv[bj][1][i]), -448.0f), 448.0f); }
                    int w0 = 0, w1 = 0;
                    w0 = __builtin_amdgcn_cvt_pk_fp8_f32(v[0], v[1], w0, false); w0 = __builtin_amdgcn_cvt_pk_fp8_f32(v[2], v[3], w0, true);
                    w1 = __builtin_amdgcn_cvt_pk_fp8_f32(v[4], v[5], w1, false); w1 = __builtin_amdgcn_cvt_pk_fp8_f32(v[6], v[7], w1, true);
                    u32x2 w; w.x = (unsigned)w0; w.y = (unsigned)w1; *(u32x2*)(O + (unsigned)(row * ldc + col0 + bj * HALF)) = w; } }
    }
};
struct EpiScaleF8 { typedef f32x4 AccT;
    static constexpr bool PERM = true, AFTER_DRAIN = false, HAS_MID = false;
    unsigned char* O; int ldc; const float* rs;
    __device__ __forceinline__ void operator()(const f32x4 (&acc)[2][2][4][2], const Unit& u, int wr, int wc, int fr, int fq) const {
        const int row0 = u.pm * BM + wr * 64 + fr, col0 = u.pn * BM + wc * 32 + 8 * fq; typedef unsigned u32x2 __attribute__((ext_vector_type(2)));
#pragma unroll
        for (int ai = 0; ai < 2; ++ai)
#pragma unroll
            for (int m = 0; m < 4; ++m) { const int row = row0 + ai * HALF + m * 16; const float s = rs[row];
#pragma unroll
                for (int bj = 0; bj < 2; ++bj) { float v[8];
#pragma unroll
                    for (int i = 0; i < 4; ++i) { v[i] = __builtin_fminf(__builtin_fmaxf(acc[ai][bj][m][0][i] * s, -448.0f), 448.0f); v[4 + i] = __builtin_fminf(__builtin_fmaxf(acc[ai][bj][m][1][i] * s, -448.0f), 448.0f); }
                    int w0 = 0, w1 = 0;
                    w0 = __builtin_amdgcn_cvt_pk_fp8_f32(v[0], v[1], w0, false); w0 = __builtin_amdgcn_cvt_pk_fp8_f32(v[2], v[3], w0, true);
                    w1 = __builtin_amdgcn_cvt_pk_fp8_f32(v[4], v[5], w1, false); w1 = __builtin_amdgcn_cvt_pk_fp8_f32(v[6], v[7], w1, true);
                    u32x2 w; w.x = (unsigned)w0; w.y = (unsigned)w1; *(u32x2*)(O + (unsigned)(row * ldc + col0 + bj * HALF)) = w; } }
    }
};
struct EpiScaleRope { typedef f32x4 AccT;
    static constexpr bool PERM = true, AFTER_DRAIN = false, HAS_MID = false;
    bf16_t* O; int ldc; const float* rs; const float* cs; int rope_pn;
    __device__ __forceinline__ void operator()(const f32x4 (&acc)[2][2][4][2], const Unit& u, int wr, int wc, int fr, int fq) const {
        const int row0 = u.pm * BM + wr * 64 + fr, col0 = u.pn * BM + wc * 32 + 8 * fq; const bool rope = (u.pn == rope_pn);
#pragma unroll
        for (int ai = 0; ai < 2; ++ai)
#pragma unroll
            for (int m = 0; m < 4; ++m) { const int row = row0 + ai * HALF + m * 16; const float s = rs[row]; bf16_t* rowp = O + (size_t)row * ldc + col0;
                f32x4 ca = (f32x4){1.f, 0.f, 1.f, 0.f}, cb = ca;
                if (rope) { ca = *(const f32x4*)(cs + (size_t)row * 32 + 8 * fq); cb = *(const f32x4*)(cs + (size_t)row * 32 + 8 * fq + 4); }
#pragma unroll
                for (int bj = 0; bj < 2; ++bj) { const f32x4 a = acc[ai][bj][m][0] * s, b = acc[ai][bj][m][1] * s; f32x4 o0, o1;
                    o0[0] = a[0] * ca[0] - b[0] * ca[1]; o1[0] = b[0] * ca[0] + a[0] * ca[1];
                    o0[1] = a[1] * ca[2] - b[1] * ca[3]; o1[1] = b[1] * ca[2] + a[1] * ca[3];
                    o0[2] = a[2] * cb[0] - b[2] * cb[1]; o1[2] = b[2] * cb[0] + a[2] * cb[1];
                    o0[3] = a[3] * cb[2] - b[3] * cb[3]; o1[3] = b[3] * cb[2] + a[3] * cb[3];
                    u32x4 w; w.x = cvt_pk_bf16(o0[0], o0[1]); w.y = cvt_pk_bf16(o0[2], o0[3]); w.z = cvt_pk_bf16(o1[0], o1[1]); w.w = cvt_pk_bf16(o1[2], o1[3]);
                    *(u32x4*)(rowp + bj * HALF) = w; } }
    }
};
struct EpiScaleRopeI8 { typedef i32x4 AccT;
    static constexpr bool PERM = true, AFTER_DRAIN = false, HAS_MID = false;
    bf16_t* O; int ldc; const float* rs; const float* sb; const float* cs; int rope_pn;
    __device__ __forceinline__ void operator()(const i32x4 (&acc)[2][2][4][2], const Unit& u, int wr, int wc, int fr, int fq) const {
        const int row0 = u.pm * BM + wr * 64 + fr, col0 = u.pn * BM + wc * 32 + 8 * fq; const bool rope = (u.pn == rope_pn);
#pragma unroll
        for (int ai = 0; ai < 2; ++ai)
#pragma unroll
            for (int m = 0; m < 4; ++m) { const int row = row0 + ai * HALF + m * 16; const float s = rs[row]; bf16_t* rowp = O + (size_t)row * ldc + col0;
                f32x4 ca = (f32x4){1.f, 0.f, 1.f, 0.f}, cb = ca;
                if (rope) { ca = *(const f32x4*)(cs + (size_t)row * 32 + 8 * fq); cb = *(const f32x4*)(cs + (size_t)row * 32 + 8 * fq + 4); }
#pragma unroll
                for (int bj = 0; bj < 2; ++bj) { const f32x4 sv0 = *(const f32x4*)(sb + col0 + bj * HALF) * s, sv1 = *(const f32x4*)(sb + col0 + bj * HALF + 4) * s; f32x4 a, b, o0, o1;
#pragma unroll
                    for (int i = 0; i < 4; ++i) { a[i] = (float)acc[ai][bj][m][0][i] * sv0[i]; b[i] = (float)acc[ai][bj][m][1][i] * sv1[i]; }
                    o0[0] = a[0] * ca[0] - b[0] * ca[1]; o1[0] = b[0] * ca[0] + a[0] * ca[1];
                    o0[1] = a[1] * ca[2] - b[1] * ca[3]; o1[1] = b[1] * ca[2] + a[1] * ca[3];
                    o0[2] = a[2] * cb[0] - b[2] * cb[1]; o1[2] = b[2] * cb[0] + a[2] * cb[1];
                    o0[3] = a[3] * cb[2] - b[3] * cb[3]; o1[3] = b[3] * cb[2] + a[3] * cb[3];
                    u32x4 w; w.x = cvt_pk_bf16(o0[0], o0[1]); w.y = cvt_pk_bf16(o0[2], o0[3]); w.z = cvt_pk_bf16(o1[0], o1[1]); w.w = cvt_pk_bf16(o1[2], o1[3]);
                    *(u32x4*)(rowp + bj * HALF) = w; }
                asm volatile("" ::: "memory"); }
    }
};
template <bool OUT8>
struct EpiGate { typedef f32x4 AccT;
    static constexpr bool PERM = true, AFTER_DRAIN = false, HAS_MID = false;
    void* O; int ldc; const unsigned char* G; int ldg; const bf16_t* T; int ldt; float cs;
    __device__ __forceinline__ void operator()(const f32x4 (&acc)[2][2][4][2], const Unit& u, int wr, int wc, int fr, int fq) const {
        const int row0 = u.pm * BM + wr * 64 + fr, col0 = u.pn * BM + wc * 32 + 8 * fq; const float gs = cs * (1.0f / 255.0f);
        typedef unsigned u32x2 __attribute__((ext_vector_type(2)));
#pragma unroll
        for (int ai = 0; ai < 2; ++ai)
#pragma unroll
            for (int m = 0; m < 4; ++m) { const int row = row0 + ai * HALF + m * 16;
#pragma unroll
                for (int bj = 0; bj < 2; ++bj) { const int col = col0 + bj * HALF;
                    const u32x2 g = *(const u32x2*)(G + (size_t)row * ldg + col); u32x4 t = (u32x4){0u, 0u, 0u, 0u}; if (T) t = *(const u32x4*)(T + (size_t)row * ldt + col);
                    const f32x4 a = acc[ai][bj][m][0], b = acc[ai][bj][m][1];
                    float gv[8] = {(float)(g.x & 0xffu), (float)((g.x >> 8) & 0xffu), (float)((g.x >> 16) & 0xffu), (float)(g.x >> 24), (float)(g.y & 0xffu), (float)((g.y >> 8) & 0xffu), (float)((g.y >> 16) & 0xffu), (float)(g.y >> 24)};
                    float tv[8] = {bflo(t.x), bfhi(t.x), bflo(t.y), bfhi(t.y), bflo(t.z), bfhi(t.z), bflo(t.w), bfhi(t.w)}; float o[8];
#pragma unroll
                    for (int i = 0; i < 8; ++i) o[i] = tv[i] + (gv[i] * gs) * (i < 4 ? a[i & 3] : b[i & 3]);
                    if constexpr (OUT8) { int w0 = 0, w1 = 0;
#pragma unroll
                        for (int i = 0; i < 8; ++i) o[i] = __builtin_fminf(__builtin_fmaxf(o[i] * 32.0f, -448.0f), 448.0f);
                        w0 = __builtin_amdgcn_cvt_pk_fp8_f32(o[0], o[1], w0, false); w0 = __builtin_amdgcn_cvt_pk_fp8_f32(o[2], o[3], w0, true);
                        w1 = __builtin_amdgcn_cvt_pk_fp8_f32(o[4], o[5], w1, false); w1 = __builtin_amdgcn_cvt_pk_fp8_f32(o[6], o[7], w1, true);
                        u32x2 w; w.x = (unsigned)w0; w.y = (unsigned)w1; *(u32x2*)((unsigned char*)O + (size_t)row * ldc + col) = w; }
                    else { u32x4 w; w.x = cvt_pk_bf16(o[0], o[1]); w.y = cvt_pk_bf16(o[2], o[3]); w.z = cvt_pk_bf16(o[4], o[5]); w.w = cvt_pk_bf16(o[6], o[7]);
                        *(u32x4*)((bf16_t*)O + (size_t)row * ldc + col) = w; } } }
    }
};
struct EpiGate2 { typedef f32x4 AccT;
    static constexpr bool PERM = true, AFTER_DRAIN = false, HAS_MID = true;
    unsigned char* O; int ldc; const unsigned char* G; int ldg; float cs;
    typedef unsigned u32x2 __attribute__((ext_vector_type(2)));
    __device__ __forceinline__ void mid(f32x4 (&acc)[2][2][4][2], const Unit& u, int wr, int wc, int fr, int fq) const {
        asm volatile("" : "+v"(fr), "+v"(fq));
        const int row0 = u.pm * BM + wr * 64 + fr, col0 = u.pn * BM + wc * 32 + 8 * fq;
#pragma unroll
        for (int ai = 0; ai < 2; ++ai)
#pragma unroll
            for (int m = 0; m < 4; ++m) { const int row = row0 + ai * HALF + m * 16;
#pragma unroll
                for (int bj = 0; bj < 2; ++bj) { const int col = col0 + bj * HALF;
                    const unsigned go = (unsigned)(row * ldg + (col >> 1)); const unsigned ga = *(const unsigned*)(G + go), gb = *(const unsigned*)(G + go + 512u);
#pragma unroll
                    for (int i = 0; i < 4; ++i) { const float a0 = (float)((ga >> (4 * i)) & 0xfu), a1 = (float)((ga >> (16 + 4 * i)) & 0xfu);
                        const float b0 = __builtin_fmaxf((float)((gb >> (4 * i)) & 0xfu), 1.0f), b1 = __builtin_fmaxf((float)((gb >> (16 + 4 * i)) & 0xfu), 1.0f);
                        acc[ai][bj][m][0][i] *= a0 * __builtin_amdgcn_rcpf(b0); acc[ai][bj][m][1][i] *= a1 * __builtin_amdgcn_rcpf(b1); } }
                asm volatile("" ::: "memory"); }
    }
    __device__ __forceinline__ void operator()(const f32x4 (&acc)[2][2][4][2], const Unit& u, int wr, int wc, int fr, int fq) const {
        const int row0 = u.pm * BM + wr * 64 + fr, col0 = u.pn * BM + wc * 32 + 8 * fq; const float gs = cs * (32.0f / 15.0f);
#pragma unroll
        for (int ai = 0; ai < 2; ++ai)
#pragma unroll
            for (int m = 0; m < 4; ++m) { const int row = row0 + ai * HALF + m * 16;
#pragma unroll
                for (int bj = 0; bj < 2; ++bj) { const int col = col0 + bj * HALF;
                    const unsigned gb = *(const unsigned*)(G + (unsigned)(row * ldg + (col >> 1)) + 512u); float o[8];
#pragma unroll
                    for (int i = 0; i < 4; ++i) { const float b0 = __builtin_fmaxf((float)((gb >> (4 * i)) & 0xfu), 1.0f), b1 = __builtin_fmaxf((float)((gb >> (16 + 4 * i)) & 0xfu), 1.0f);
                        o[i] = __builtin_fminf(__builtin_fmaxf(acc[ai][bj][m][0][i] * (b0 * gs), -448.0f), 448.0f); o[4 + i] = __builtin_fminf(__builtin_fmaxf(acc[ai][bj][m][1][i] * (b1 * gs), -448.0f), 448.0f); }
                    int w0 = 0, w1 = 0;
                    w0 = __builtin_amdgcn_cvt_pk_fp8_f32(o[0], o[1], w0, false); w0 = __builtin_amdgcn_cvt_pk_fp8_f32(o[2], o[3], w0, true);
                    w1 = __builtin_amdgcn_cvt_pk_fp8_f32(o[4], o[5], w1, false); w1 = __builtin_amdgcn_cvt_pk_fp8_f32(o[6], o[7], w1, true);
                    u32x2 w; w.x = (unsigned)w0; w.y = (unsigned)w1; *(u32x2*)(O + (unsigned)(row * ldc + col)) = w; } }
    }
};
struct EpiResF32 { typedef f32x4 AccT;
    static constexpr bool PERM = false, AFTER_DRAIN = false, HAS_MID = false;
    bf16_t* Y; const float* X; int ldc; float alpha, cs;
    __device__ __forceinline__ void operator()(const f32x4 (&acc)[2][2][4][2], const Unit& u, int wr, int wc, int fr, int fq) const {
        const int row0 = u.pm * BM + wr * 64 + fr, col0 = u.pn * BM + wc * 32 + 4 * fq;
#pragma unroll
        for (int ai = 0; ai < 2; ++ai)
#pragma unroll
            for (int m = 0; m < 4; ++m) { const size_t off = (size_t)(row0 + ai * HALF + m * 16) * ldc + col0;
#pragma unroll
                for (int bj = 0; bj < 2; ++bj)
#pragma unroll
                    for (int n = 0; n < 2; ++n) { const f32x4 xv = *(const f32x4*)(X + off + bj * HALF + n * 16); const f32x4 y = xv * alpha + acc[ai][bj][m][n] * cs;
                        typedef unsigned u32x2 __attribute__((ext_vector_type(2))); u32x2 w; w.x = cvt_pk_bf16(y[0], y[1]); w.y = cvt_pk_bf16(y[2], y[3]); *(u32x2*)(Y + off + bj * HALF + n * 16) = w; } }
    }
};
template <class Epi, class Sched, bool ALIGN_EPI = false, bool SP2 = false, int I8 = 0>
__device__ __forceinline__ void gemm_phase(PG8_LAS unsigned char* lds, const Gemm g, const Sched& S, const Epi& E) {
    int tid_ = threadIdx.x; asm volatile("" : "+v"(tid_));
    const int tid = tid_, wid = __builtin_amdgcn_readfirstlane(tid >> 6), lane = tid & 63, wr = wid >> 2, wc = wid & 3, fr = lane & 15, fq = lane >> 4;
    const int K = g.K, nt = K / BK;
    unsigned voffA[2], voffB[2];
#pragma unroll
    for (int i = 0; i < 2; ++i) { int R, C; stage_rc(tid * 16 + i * 8192, R, C); const int Rb = Epi::PERM ? ((R & ~31) + perm32(R & 31)) : R;
        voffA[i] = (unsigned)(R * g.lda + C) * 2u; voffB[i] = (unsigned)(Rb * g.ldb + C) * 2u; }
    const size_t kstep = (size_t)(BK * 2);
    const size_t hstepA = (size_t)HALF * g.lda * 2, hstepB = (size_t)HALF * g.ldb * 2;
    const size_t tstepA = 2 * hstepA, tstepB = 2 * hstepB;
    const unsigned ldsw = (unsigned)wid * 1024u;
    const int aoff = lds_byte(wr * 64 + fr, fq * 8), boff = lds_byte(wc * 32 + fr, fq * 8);
#define PG8_SA(b, h) (((b) * 2 + (h)) * HTB)
#define PG8_SB(b, h) ((4 + (b) * 2 + (h)) * HTB)
#define PG8_STAGE(bufoff, gbase, voff) do { _Pragma("unroll") for (int _i = 0; _i < 2; ++_i) \
        __builtin_amdgcn_global_load_lds((const unsigned*)((const char*)(gbase) + (voff)[_i]), (PG8_LAS unsigned*)(lds + (bufoff) + ldsw + _i * 8192), 16, 0, 0); } while (0)
#define PG8_LDA(dst, b, h) do { _Pragma("unroll") for (int m = 0; m < 4; ++m) _Pragma("unroll") for (int k = 0; k < 2; ++k) dst[m][k] = *(const PG8_LAS bf16x8*)(lds + PG8_SA(b, h) + aoff + m * 2048 + k * 1024); } while (0)
#define PG8_LDB(dst, b, h) do { _Pragma("unroll") for (int n = 0; n < 2; ++n) _Pragma("unroll") for (int k = 0; k < 2; ++k) dst[n][k] = *(const PG8_LAS bf16x8*)(lds + PG8_SB(b, h) + boff + n * 2048 + k * 1024); } while (0)
#define PG8_MMA(ai, bj, At, Bt) do { __builtin_amdgcn_s_setprio(1); _Pragma("unroll") for (int m = 0; m < 4; ++m) _Pragma("unroll") for (int n = 0; n < 2; ++n) _Pragma("unroll") for (int k = 0; k < 2; ++k) \
        { if constexpr (I8 == 2) { if (k == 0) { typedef int i32x8 __attribute__((ext_vector_type(8))); \
              const i32x8 b8_ = __builtin_shufflevector(__builtin_bit_cast(i32x4, Bt[n][0]), __builtin_bit_cast(i32x4, Bt[n][1]), 0, 1, 2, 3, 4, 5, 6, 7), a8_ = __builtin_shufflevector(__builtin_bit_cast(i32x4, At[m][0]), __builtin_bit_cast(i32x4, At[m][1]), 0, 1, 2, 3, 4, 5, 6, 7); \
              asm volatile("v_mfma_f32_16x16x128_f8f6f4 %0, %1, %2, %0" : "+v"(acc[ai][bj][m][n]) : "v"(b8_), "v"(a8_)); } } \
          else if constexpr (I8 == 1) acc[ai][bj][m][n] = __builtin_bit_cast(AccT, __builtin_amdgcn_mfma_i32_16x16x64_i8(__builtin_bit_cast(i32x4, Bt[n][k]), __builtin_bit_cast(i32x4, At[m][k]), __builtin_bit_cast(i32x4, acc[ai][bj][m][n]), 0, 0, 0)); \
          else acc[ai][bj][m][n] = __builtin_bit_cast(AccT, __builtin_amdgcn_mfma_f32_16x16x32_bf16(Bt[n][k], At[m][k], __builtin_bit_cast(f32x4, acc[ai][bj][m][n]), 0, 0, 0)); } __builtin_amdgcn_s_setprio(0); } while (0)
#define PG8_WAIT_V(n) asm volatile("s_waitcnt vmcnt(" #n ")" ::: "memory")
#define PG8_WAIT_L(n) asm volatile("s_waitcnt lgkmcnt(" #n ")" ::: "memory")
#define PG8_BAR __builtin_amdgcn_s_barrier()
#define PG8_SCHED __builtin_amdgcn_sched_barrier(0)
    Unit cur, nxt; int ui = 0;
    if (!S.next(0, cur)) return;
    typedef typename Epi::AccT AccT;
    AccT acc[2][2][4][2];
#pragma unroll
    for (int a = 0; a < 2; ++a)
#pragma unroll
        for (int b = 0; b < 2; ++b)
#pragma unroll
            for (int m = 0; m < 4; ++m)
#pragma unroll
                for (int n = 0; n < 2; ++n) acc[a][b][m][n] = (AccT){0, 0, 0, 0};
    bf16x8 At[4][2], B0[2][2], B1[2][2];
    const char* cA = (const char*)g.A + (size_t)cur.pm * tstepA; const char* cB = (const char*)g.Bt + (size_t)cur.pn * tstepB;
    S.a_ready(cur);
    if constexpr (SP2) {
        PG8_STAGE(PG8_SB(0, 0), cB, voffB); PG8_STAGE(PG8_SB(0, 1), cB + hstepB, voffB); PG8_STAGE(PG8_SA(0, 0), cA, voffA); PG8_STAGE(PG8_SA(0, 1), cA + hstepA, voffA);
        if (wr == 1) PG8_BAR;
        PG8_WAIT_V(2); PG8_BAR;
        PG8_STAGE(PG8_SB(1, 0), cB + kstep, voffB); PG8_STAGE(PG8_SA(1, 0), cA + kstep, voffA); PG8_STAGE(PG8_SB(1, 1), cB + hstepB + kstep, voffB);
        PG8_WAIT_V(6); PG8_BAR;
    } else {
        PG8_STAGE(PG8_SB(0, 0), cB, voffB); PG8_STAGE(PG8_SA(0, 0), cA, voffA); PG8_STAGE(PG8_SB(0, 1), cB + hstepB, voffB); PG8_STAGE(PG8_SA(0, 1), cA + hstepA, voffA);
        if (wr == 1) PG8_BAR;
        PG8_WAIT_V(4); PG8_BAR;
        PG8_STAGE(PG8_SB(1, 0), cB + kstep, voffB); PG8_STAGE(PG8_SA(1, 0), cA + kstep, voffA); PG8_STAGE(PG8_SB(1, 1), cB + hstepB + kstep, voffB);
        PG8_WAIT_V(6); PG8_BAR;
    }
    for (;;) {
        const bool has_next = S.next(ui + 1, nxt);
        const char* nA = has_next ? (const char*)g.A + (size_t)nxt.pm * tstepA : cA; const char* nB = has_next ? (const char*)g.Bt + (size_t)nxt.pn * tstepB : cB;
#pragma nounroll
        for (int t = 0; t < nt; t += 2) {
            if constexpr (Epi::HAS_MID) { if (t == (nt >> 1)) { if constexpr (I8 == 2) { asm volatile("s_nop 15\n\ts_nop 15" ::: "memory"); PG8_SCHED; } E.mid(acc, cur, wr, wc, fr, fq); asm volatile("s_nop 7" ::: "memory"); PG8_SCHED; } }
            const bool last = (t == nt - 2);
            const char* a1 = cA + (size_t)(t + 1) * kstep;
            const char* a2 = last ? nA : cA + (size_t)(t + 2) * kstep; const char* b2 = last ? nB : cB + (size_t)(t + 2) * kstep;
            const char* a3 = a2 + kstep; const char* b3 = b2 + kstep;
            if (last && has_next) S.a_ready(nxt);
            if constexpr (SP2) {
            PG8_LDB(B0, 0, 0); PG8_LDB(B1, 0, 1); PG8_SCHED; PG8_LDA(At, 0, 0); PG8_STAGE(PG8_SA(1, 1), a1 + hstepA, voffA);
            PG8_WAIT_V(8); PG8_WAIT_L(0); PG8_BAR; PG8_MMA(0, 0, At, B0); PG8_MMA(0, 1, At, B1); PG8_BAR; PG8_SCHED;
            PG8_LDA(At, 0, 1); PG8_STAGE(PG8_SB(0, 0), b2, voffB); PG8_STAGE(PG8_SB(0, 1), b2 + hstepB, voffB); PG8_STAGE(PG8_SA(0, 0), a2, voffA);
            PG8_WAIT_V(8); PG8_WAIT_L(0); PG8_BAR; PG8_MMA(1, 0, At, B0); PG8_MMA(1, 1, At, B1); PG8_BAR; PG8_SCHED;
            PG8_LDB(B0, 1, 0); PG8_LDB(B1, 1, 1); PG8_SCHED; PG8_LDA(At, 1, 0); PG8_STAGE(PG8_SA(0, 1), a2 + hstepA, voffA);
            PG8_WAIT_V(8); PG8_WAIT_L(0); PG8_BAR; PG8_MMA(0, 0, At, B0); PG8_MMA(0, 1, At, B1); PG8_BAR; PG8_SCHED;
            PG8_LDA(At, 1, 1); PG8_STAGE(PG8_SB(1, 0), b3, voffB); PG8_STAGE(PG8_SB(1, 1), b3 + hstepB, voffB); PG8_STAGE(PG8_SA(1, 0), a3, voffA);
            PG8_WAIT_V(8); PG8_WAIT_L(0); PG8_BAR; PG8_MMA(1, 0, At, B0); PG8_MMA(1, 1, At, B1); PG8_BAR; PG8_SCHED;
            } else {
            PG8_LDB(B0, 0, 0); PG8_SCHED; PG8_LDA(At, 0, 0); PG8_STAGE(PG8_SA(1, 1), a1 + hstepA, voffA);
            PG8_WAIT_L(8); PG8_BAR; PG8_WAIT_L(0); PG8_MMA(0, 0, At, B0); PG8_BAR; PG8_SCHED;
            PG8_LDB(B1, 0, 1); PG8_STAGE(PG8_SB(0, 0), b2, voffB);
            PG8_BAR; PG8_WAIT_L(0); PG8_MMA(0, 1, At, B1); PG8_BAR;
            PG8_LDA(At, 0, 1); PG8_STAGE(PG8_SA(0, 0), a2, voffA);
            PG8_BAR; PG8_WAIT_L(0); PG8_MMA(1, 0, At, B0); PG8_BAR; PG8_SCHED;
            PG8_STAGE(PG8_SB(0, 1), b2 + hstepB, voffB);
            PG8_WAIT_V(6); PG8_BAR; PG8_MMA(1, 1, At, B1); PG8_BAR;
            PG8_LDB(B0, 1, 0); PG8_SCHED; PG8_LDA(At, 1, 0); PG8_STAGE(PG8_SA(0, 1), a2 + hstepA, voffA);
            PG8_WAIT_L(8); PG8_BAR; PG8_WAIT_L(0); PG8_MMA(0, 0, At, B0); PG8_BAR; PG8_SCHED;
            PG8_LDB(B1, 1, 1); PG8_STAGE(PG8_SB(1, 0), b3, voffB);
            PG8_BAR; PG8_WAIT_L(0); PG8_MMA(0, 1, At, B1); PG8_BAR;
            PG8_LDA(At, 1, 1); PG8_STAGE(PG8_SA(1, 0), a3, voffA);
            PG8_BAR; PG8_WAIT_L(0); PG8_MMA(1, 0, At, B0); PG8_BAR; PG8_SCHED;
            PG8_STAGE(PG8_SB(1, 1), b3 + hstepB, voffB);
            PG8_WAIT_V(6); PG8_BAR; PG8_MMA(1, 1, At, B1); PG8_BAR;
            }
        }
        if constexpr (I8 == 2) { asm volatile("s_nop 15\n\ts_nop 15" ::: "memory"); PG8_SCHED; }
        if constexpr (ALIGN_EPI) { if (wr == 0) PG8_BAR; }
        if constexpr (!Epi::AFTER_DRAIN) { E(acc, cur, wr, wc, fr, fq); S.done(cur); }
        if (!has_next) break;
#pragma unroll
        for (int a = 0; a < 2; ++a)
#pragma unroll
            for (int b = 0; b < 2; ++b)
#pragma unroll
                for (int m = 0; m < 4; ++m)
#pragma unroll
                    for (int n = 0; n < 2; ++n) acc[a][b][m][n] = (AccT){0, 0, 0, 0};
        cur = nxt; cA = nA; cB = nB; ++ui;
        if constexpr (ALIGN_EPI) { if (wr == 1) PG8_BAR; }
    }
    PG8_WAIT_V(0);
    if constexpr (!ALIGN_EPI) { if (wr == 0) PG8_BAR; }
    PG8_BAR;
    if constexpr (Epi::AFTER_DRAIN) { E.fused(acc, cur, wr, wc, fr, fq, lds, wid, lane); S.done(cur); }
#undef PG8_SA
#undef PG8_SB
#undef PG8_STAGE
#undef PG8_LDA
#undef PG8_LDB
#undef PG8_MMA
#undef PG8_WAIT_V
#undef PG8_WAIT_L
#undef PG8_BAR
#undef PG8_SCHED
}
}

#define GAS __attribute__((address_space(1)))
#define LAS __attribute__((address_space(3)))
typedef unsigned short bf16;
typedef unsigned v4u __attribute__((ext_vector_type(4)));
typedef unsigned v2u __attribute__((ext_vector_type(2)));
typedef float f32x4 __attribute__((ext_vector_type(4)));
typedef float f32x16 __attribute__((ext_vector_type(16)));
typedef int i32x4 __attribute__((ext_vector_type(4)));
typedef short bf16x8 __attribute__((ext_vector_type(8)));
typedef __bf16 bf16x2v __attribute__((ext_vector_type(2)));
typedef GAS unsigned gu32;
#define RLX_AGENT __ATOMIC_RELAXED, __HIP_MEMORY_SCOPE_AGENT
#define LDS_WAIT() asm volatile("s_waitcnt lgkmcnt(0)" ::: "memory")
#define VM_WAIT() asm volatile("s_waitcnt vmcnt(0)" ::: "memory")
#define XB_TMO      128
#define XB_XCNT(j)  (256  + 64 * (j))
#define XB_XSUB(j)  (1280 + 64 * (j))
#define XB_XGEN(j)  (2304 + 64 * (j))
#define XB_TOP      3328
#define XB_TOPGEN   3392
#define XCD_BAR_WORDS 3456
#define XB_SPIN_CAP (1u << 18)

__device__ __forceinline__ unsigned xb_ld(unsigned* p)              { return __hip_atomic_load(p, __ATOMIC_RELAXED, __HIP_MEMORY_SCOPE_AGENT); }
__device__ __forceinline__ unsigned xb_add(unsigned* p, unsigned v) { return __hip_atomic_fetch_add(p, v, __ATOMIC_RELAXED, __HIP_MEMORY_SCOPE_AGENT); }
__device__ __forceinline__ unsigned xb_xcc_id() { return (unsigned)__builtin_amdgcn_s_getreg((3 << 11) | 20) & 0xFu; }
#define XB_SPIN(cond, bar) do { unsigned _sp = 0; while (cond) { __builtin_amdgcn_s_sleep(1); \
    if ((++_sp & 255u) == 0u) { if (xb_ld(&(bar)[XB_TMO])) break; if (_sp > XB_SPIN_CAP) { atomicAdd(&(bar)[XB_TMO], 1u); break; } } } } while (0)

struct XcdBarrier {
    unsigned* bar; unsigned x;
    volatile LAS unsigned* st;
};

__device__ __forceinline__ XcdBarrier xcd_barrier_post(unsigned* bar, volatile LAS unsigned* st) {
    XcdBarrier b; b.bar = bar; b.x = xb_xcc_id(); b.st = st;
    if (threadIdx.x == 0) (void)xb_add(&bar[XB_XCNT(b.x)], 1u);
    return b;
}
__device__ __forceinline__ void xcd_barrier_complete(unsigned* bar, unsigned x, unsigned& nloc, unsigned& nx) {
    const unsigned G = gridDim.x * gridDim.y * gridDim.z;
    unsigned sum, cnt, mine, sp = 0u;
    for (;;) {
        sum = 0u; cnt = 0u; mine = 0u;
#pragma unroll
        for (unsigned j = 0; j < 16; ++j) { const unsigned c = xb_ld(&bar[XB_XCNT(j)]); sum += c; cnt += (c > 0u) ? 1u : 0u; mine = (j == x) ? c : mine; }
        if (sum == G) break;
        __builtin_amdgcn_s_sleep(1);
        if ((++sp & 255u) == 0u) { if (xb_ld(&bar[XB_TMO])) break; if (sp > XB_SPIN_CAP) { atomicAdd(&bar[XB_TMO], 1u); break; } }
    }
    nloc = mine > 0u ? mine : 1u; nx = cnt > 0u ? cnt : 1u;
}

__device__ __forceinline__ void xcd_barrier(const XcdBarrier& b) {
    asm volatile("s_waitcnt vmcnt(0)" ::: "memory");
    __syncthreads();
    if (threadIdx.x == 0) {
        unsigned* bar = b.bar;
        __builtin_amdgcn_s_waitcnt(0);
        unsigned nloc = b.st[0], nx = b.st[1];
        if (nloc == 0u) { xcd_barrier_complete(bar, b.x, nloc, nx); b.st[0] = nloc; b.st[1] = nx; }
        const unsigned old = xb_add(&bar[XB_XSUB(b.x)], 1u);
        const unsigned gen = old / nloc;
        if (old + 1u == (gen + 1u) * nloc) {
            __builtin_amdgcn_fence(__ATOMIC_RELEASE, "agent");
            asm volatile("s_waitcnt vmcnt(0)" ::: "memory");
            const unsigned og = xb_add(&bar[XB_TOP], 1u);
            const unsigned tg = og / nx;
            if (og + 1u == (tg + 1u) * nx) xb_add(&bar[XB_TOPGEN], 1u);
            else XB_SPIN(xb_ld(&bar[XB_TOPGEN]) == tg, bar);
            __builtin_amdgcn_fence(__ATOMIC_ACQUIRE, "agent");
            xb_add(&bar[XB_XGEN(b.x)], 1u);
            asm volatile("s_waitcnt vmcnt(0)" ::: "memory");
        } else {
            XB_SPIN(xb_ld(&bar[XB_XGEN(b.x)]) == gen, bar);
            __builtin_amdgcn_fence(__ATOMIC_ACQUIRE, "agent");
            asm volatile("s_waitcnt vmcnt(0)" ::: "memory");
        }
    }
    __syncthreads();
}

constexpr int NWAVES = 8;
constexpr int BATCH = 32, SEQ = 2048, D = 1024, M = BATCH * SEQ;
constexpr int HW = 4352;
constexpr int H_CQ = 0, H_CKV = 768, H_QB = 1024, H_QIDX = 1536, H_GA = 2048, H_GB = 3072, H_KROPE = 4096, H_KB = 4128, H_VB = 4192, H_KIDX = 4256, H_WIDX = 4320;
constexpr float ALPHA = 1.189207115002721f;
constexpr float LN_EPS = 1e-5f, RMS_EPS = 1e-6f;
constexpr int NPHASES = 14;
constexpr size_t SHARD_BYTES = (size_t)16384 * 128;
#ifndef E2_ALAY
#define E2_ALAY 1
#endif
#ifndef DSA_REP
#define DSA_REP 1
#endif
#ifndef E2_TEST
#define E2_TEST 0
#endif
#ifndef REPEAT_MASK
#define REPEAT_MASK 0
#endif
#ifndef PHASE_MASK
#define PHASE_MASK 0x33fff
#endif
#ifndef EXP_NOMIX
#define EXP_NOMIX 0
#endif
#ifndef MLA_PROBE
#define MLA_PROBE 0
#endif
#ifndef DSA_SKIP
#define DSA_SKIP 0
#endif
#ifndef EXP_NODSA
#define EXP_NODSA 0
#endif
#ifndef EXP_NOMLA
#define EXP_NOMLA 0
#endif

constexpr size_t MiB = 1u << 20;
constexpr size_t WS_CTL = 0, CTL_ZERO_BYTES = 1 * MiB;
constexpr size_t WS_BIASP = 1 * MiB, WS_RSQ = 2 * MiB, WS_RSKV = 2 * MiB + 512 * 1024, WS_WIDX = 3 * MiB, WS_CS = 5 * MiB, WS_KPE = 13 * MiB, WS_KIDX = 17 * MiB, WS_KB = 25 * MiB, WS_VB = 33 * MiB;
constexpr size_t WS_WIN_T = 41 * MiB, WS_WQ_T = 50 * MiB, WS_WKV_T = 52 * MiB, WS_WOA_T = 53 * MiB, WS_WOB_T = 54 * MiB, WS_WOUT_T = 55 * MiB, WS_WPQ_T = 57 * MiB, WS_SUBK = 61 * MiB, WS_PU = 62 * MiB  , WS_PV = 78 * MiB, WS_SU = 94 * MiB  , WS_SV = 95 * MiB, WS_XMAX = 96 * MiB  , WS_CSUM = 97 * MiB  ,
                 WS_SX = 98 * MiB  , WS_SW = 99 * MiB  ;
constexpr size_t WS_XB = 128 * MiB;
constexpr size_t WS_XQ = 256 * MiB;
constexpr size_t WS_X1Q = 384 * MiB;
constexpr size_t WS_Q = 256 * MiB, WS_KV = 352 * MiB;
constexpr size_t WS_H = 480 * MiB;
constexpr size_t WS_END = 1024 * MiB;
constexpr int CW_BAR = 4096;

constexpr int LDS_BYTES = 163840;
constexpr int MISC_OFF = LDS_BYTES - 256;

typedef float f32x2v __attribute__((ext_vector_type(2)));
__device__ __forceinline__ unsigned pk4_fp8(float a, float b, float c, float d) {
    a = fminf(fmaxf(a, -448.f), 448.f); b = fminf(fmaxf(b, -448.f), 448.f); c = fminf(fmaxf(c, -448.f), 448.f); d = fminf(fmaxf(d, -448.f), 448.f);
    int w = 0; w = __builtin_amdgcn_cvt_pk_fp8_f32(a, b, w, false); w = __builtin_amdgcn_cvt_pk_fp8_f32(c, d, w, true); return (unsigned)w; }
__device__ __forceinline__ unsigned pk2(float lo, float hi) { const f32x2v v = {lo, hi}; return __builtin_bit_cast(unsigned, __builtin_convertvector(v, bf16x2v)); }
__device__ __forceinline__ float bflo(unsigned w) { return __uint_as_float(w << 16); }
__device__ __forceinline__ float bfhi(unsigned w) { return __uint_as_float(w & 0xffff0000u); }
__device__ __forceinline__ float bf1(unsigned short w) { return __uint_as_float(((unsigned)w) << 16); }
__device__ __forceinline__ float wave_sum(float v) {
#pragma unroll
    for (int o = 1; o < 64; o <<= 1) v += __shfl_xor(v, o);
    return v;
}
__device__ __forceinline__ float xhalf_max(float x) { const auto r = __builtin_amdgcn_permlane32_swap(__float_as_uint(x), __float_as_uint(x), false, false); return fmaxf(__uint_as_float(r[0]), __uint_as_float(r[1])); }
__device__ __forceinline__ float dpp_xor1(float x) { return __int_as_float(__builtin_amdgcn_update_dpp(0, __float_as_int(x), 0xB1, 0xf, 0xf, true)); }
__device__ __forceinline__ float dpp_xor2(float x) { return __int_as_float(__builtin_amdgcn_update_dpp(0, __float_as_int(x), 0x4E, 0xf, 0xf, true)); }
__device__ __forceinline__ float dpp_xor4(float x) { int r = __builtin_amdgcn_update_dpp(0, __float_as_int(x), 0x104, 0xf, 0x5, false); r = __builtin_amdgcn_update_dpp(r, __float_as_int(x), 0x114, 0xf, 0xa, false); return __int_as_float(r); }
__device__ __forceinline__ float xhalf_sum(float x) { const auto r = __builtin_amdgcn_permlane32_swap(__float_as_uint(x), __float_as_uint(x), false, false); return __uint_as_float(r[0]) + __uint_as_float(r[1]); }
__device__ __forceinline__ float dpp_xor8(float x) { return __int_as_float(__builtin_amdgcn_update_dpp(0, __float_as_int(x), 0x128, 0xf, 0xf, true)); }
__device__ __forceinline__ float xrow_max(float x) { const auto r = __builtin_amdgcn_permlane16_swap(__float_as_uint(x), __float_as_uint(x), false, false); return fmaxf(__uint_as_float(r[0]), __uint_as_float(r[1])); }
__device__ __forceinline__ float xrow_sum(float x) { const auto r = __builtin_amdgcn_permlane16_swap(__float_as_uint(x), __float_as_uint(x), false, false); return __uint_as_float(r[0]) + __uint_as_float(r[1]); }
template <int U> __device__ __forceinline__ void wave_sum_n(float (&v)[U]) {
#pragma unroll
    for (int u = 0; u < U; ++u) { float x = v[u]; x += dpp_xor1(x); x += dpp_xor2(x); x += dpp_xor4(x); x += dpp_xor8(x); x = xrow_sum(x); v[u] = xhalf_sum(x); }
}
template <int U> __device__ __forceinline__ void wave_max_n(float (&v)[U]) {
#pragma unroll
    for (int u = 0; u < U; ++u) { float x = v[u]; x = fmaxf(x, dpp_xor1(x)); x = fmaxf(x, dpp_xor2(x)); x = fmaxf(x, dpp_xor4(x)); x = fmaxf(x, dpp_xor8(x)); x = xrow_max(x); v[u] = xhalf_max(x); }
}
__device__ __forceinline__ float dot2bf(unsigned a, unsigned b, float c) { return __builtin_amdgcn_fdot2_f32_bf16(__builtin_bit_cast(bf16x2v, a), __builtin_bit_cast(bf16x2v, b), c, false); }
#define MFMA32(a, b, c) __builtin_amdgcn_mfma_f32_32x32x16_bf16((a), (b), (c), 0, 0, 0)
#define MFMA16(a, b, c) __builtin_amdgcn_mfma_f32_16x16x32_bf16((a), (b), (c), 0, 0, 0)

struct Args { const float* in[20]; float* out; unsigned char* ws; int ph_lo, ph_hi; };
struct Frame {
    LAS unsigned char* lds;
    int tid, lane, wave, vcu, G;
    const struct Args* a; const int* pos; float* out; unsigned char* ws;
};
#define WSP(T, off) ((T*)(F.ws + (off)))

__device__ __forceinline__ int win_src(int n) {
    if (n < 1024) return n;
    if (n < 1536) return 1056 + (n - 1024);
    if (n < 2048) return 1696 + (n - 1536);
    if (n < 3072) return 2280 + (n - 2048);
    if (n < 4096) return 3304 + (n - 3072);
    if (n < 4128) return 1024 + (n - 4096);
    if (n < 4192) return 1568 + (n - 4128);
    if (n < 4256) return 1632 + (n - 4192);
    if (n < 4320) return 2208 + (n - 4256);
    if (n < 4328) return 2272 + (n - 4320);
    return -1;
}
__device__ __forceinline__ int wq_src(int n) {
    if (n < 512) return (n >> 6) * 96 + (n & 63);
    const int p = n - 512, hd = p >> 5, pp = p & 31, f = pp >> 3, r = pp & 7, j = 4 * f + (r & 3);
    return hd * 96 + 64 + (r < 4 ? j : 16 + j);
}
__device__ __forceinline__ int wkv_src(int n) { return n < 512 ? (n >> 6) * 128 + (n & 63) : ((n - 512) >> 6) * 128 + 64 + ((n - 512) & 63); }

template <int MAP, bool OUT8 = false>
__device__ __forceinline__ void transpose_item(const float* W, int ldw, bf16* WT, int K, int nblk, int item, const float* kscale, LAS float* scr, int lane) {
    const int kb = item / nblk, nb = item % nblk, k0 = 64 * kb, n0 = 32 * nb;
    const int nd = n0 + (lane & 31);
    const int sc = MAP == 0 ? nd : (MAP == 1 ? win_src(nd) : (MAP == 2 ? wq_src(nd) : wkv_src(nd)));
#pragma unroll 8
    for (int i = 0; i < 32; ++i) { const int kk = 2 * i + (lane >> 5); float v = 0.f; if (sc >= 0) { v = W[(size_t)(k0 + kk) * ldw + sc]; if (kscale) v *= kscale[k0 + kk]; } scr[kk * 33 + (lane & 31)] = v; }
    LDS_WAIT(); asm volatile("" ::: "memory");
    const int c = lane & 7;
#pragma unroll
    for (int j = 0; j < 4; ++j) { const int n = (lane >> 3) + 8 * j; const LAS float* s = scr + (8 * c) * 33 + n;
        if constexpr (OUT8) { int w0 = 0, w1 = 0;
            w0 = __builtin_amdgcn_cvt_pk_fp8_f32(256.f * s[0 * 33], 256.f * s[1 * 33], w0, false); w0 = __builtin_amdgcn_cvt_pk_fp8_f32(256.f * s[2 * 33], 256.f * s[3 * 33], w0, true);
            w1 = __builtin_amdgcn_cvt_pk_fp8_f32(256.f * s[4 * 33], 256.f * s[5 * 33], w1, false); w1 = __builtin_amdgcn_cvt_pk_fp8_f32(256.f * s[6 * 33], 256.f * s[7 * 33], w1, true);
            v2u o; o.x = (unsigned)w0; o.y = (unsigned)w1; *(GAS v2u*)((unsigned char*)WT + (size_t)(n0 + n) * K + k0 + 8 * c) = o; }
        else { v4u o; o.x = pk2(s[0 * 33], s[1 * 33]); o.y = pk2(s[2 * 33], s[3 * 33]); o.z = pk2(s[4 * 33], s[5 * 33]); o.w = pk2(s[6 * 33], s[7 * 33]);
            *(GAS v4u*)(WT + (size_t)(n0 + n) * K + k0 + 8 * c) = o; } }
    LDS_WAIT(); asm volatile("" ::: "memory");
}
__device__ __forceinline__ void conv8(const float* src, bf16* dst, size_t ngroups, size_t gtid, size_t NT) {
    for (size_t i0 = gtid; i0 < ngroups; i0 += 4 * NT) {
        f32x4 a[4], b[4];
#pragma unroll
        for (int u = 0; u < 4; ++u) { const size_t i = i0 + u * NT < ngroups ? i0 + u * NT : i0; a[u] = *(const GAS f32x4*)(src + 8 * i); b[u] = *(const GAS f32x4*)(src + 8 * i + 4); }
#pragma unroll
        for (int u = 0; u < 4; ++u) { const size_t i = i0 + u * NT; if (i < ngroups) { v4u o; o.x = pk2(a[u][0], a[u][1]); o.y = pk2(a[u][2], a[u][3]); o.z = pk2(b[u][0], b[u][1]); o.w = pk2(b[u][2], b[u][3]); *(GAS v4u*)(dst + 8 * i) = o; } }
    }
}

__device__ __forceinline__ void p0_prologue(Frame& F) {
    const size_t gtid = (size_t)F.vcu * (NWAVES * 64) + F.tid, NT = (size_t)F.G * (NWAVES * 64);
    { const int gwx = F.vcu * NWAVES + F.wave, NGWx = F.G * NWAVES, lane = F.lane; constexpr int U = 4;
      for (int t0 = gwx; t0 < M; t0 += NGWx * U) {
          f32x4 v[U][4]; float am[U];
#pragma unroll
          for (int u = 0; u < U; ++u) { const int t = t0 + u * NGWx < M ? t0 + u * NGWx : t0; const float* src = F.a->in[0] + (size_t)t * D + 16 * lane; am[u] = 0.f;
#pragma unroll
              for (int j = 0; j < 4; ++j) { v[u][j] = *(const GAS f32x4*)(src + 4 * j); am[u] = fmaxf(am[u], fmaxf(fmaxf(fabsf(v[u][j][0]), fabsf(v[u][j][1])), fmaxf(fabsf(v[u][j][2]), fabsf(v[u][j][3])))); } }
          wave_max_n<U>(am);
#pragma unroll
          for (int u = 0; u < U; ++u) { const int t = t0 + u * NGWx; if (t < M) { const float sc = am[u] > 0.f ? am[u] * (1.0f / 127.0f) : 1.0f, isc = 1.0f / sc; v4u o4;
#pragma unroll
              for (int j = 0; j < 4; ++j) { unsigned w = 0u;
#pragma unroll
                  for (int i = 0; i < 4; ++i) { float q = rintf(v[u][j][i] * isc); q = fminf(fmaxf(q, -127.f), 127.f); w |= ((unsigned)(int)q & 0xffu) << (8 * i); }
                  o4[j] = w; }
              *(GAS v4u*)(WSP(unsigned char, WS_XQ) + (size_t)t * D + 16 * lane) = o4; if (lane == 0) WSP(float, WS_SX)[t] = sc; } }
      }
      for (int n = gwx; n < HW; n += NGWx) { const int srcc = win_src(n); float w16[16]; float am = 0.f;
#pragma unroll
          for (int i = 0; i < 16; ++i) { w16[i] = srcc >= 0 ? F.a->in[2][(size_t)(16 * lane + i) * 4328 + srcc] : 0.f; am = fmaxf(am, fabsf(w16[i])); }
#pragma unroll
          for (int o = 1; o < 64; o <<= 1) am = fmaxf(am, __shfl_xor(am, o));
          const float sc = am > 0.f ? am * (1.0f / 127.0f) : 1.0f, isc = 1.0f / sc; v4u o4;
#pragma unroll
          for (int j = 0; j < 4; ++j) { unsigned w = 0u;
#pragma unroll
              for (int i = 0; i < 4; ++i) { float q = rintf(w16[4 * j + i] * isc); q = fminf(fmaxf(q, -127.f), 127.f); w |= ((unsigned)(int)q & 0xffu) << (8 * i); }
              o4[j] = w; }
          *(GAS v4u*)(WSP(unsigned char, WS_WIN_T) + (size_t)n * 1024 + 16 * lane) = o4; if (lane == 0) WSP(float, WS_SW)[n] = sc; }
      for (int n = gwx; n < 768; n += NGWx) { const int srcc = wq_src(n); float w16[16]; float am = 0.f;
#pragma unroll
          for (int i = 0; i < 16; ++i) { const int k = 16 * lane + i; w16[i] = lane < 48 ? F.a->in[6][(size_t)k * 768 + srcc] * F.a->in[4][k] : 0.f; am = fmaxf(am, fabsf(w16[i])); }
#pragma unroll
          for (int o = 1; o < 64; o <<= 1) am = fmaxf(am, __shfl_xor(am, o));
          const float sc = am > 0.f ? am * (1.0f / 127.0f) : 1.0f, isc = 1.0f / sc; v4u o4;
#pragma unroll
          for (int j = 0; j < 4; ++j) { unsigned w = 0u;
#pragma unroll
              for (int i = 0; i < 4; ++i) { float q = rintf(w16[4 * j + i] * isc); q = fminf(fmaxf(q, -127.f), 127.f); w |= ((unsigned)(int)q & 0xffu) << (8 * i); }
              o4[j] = w; }
          if (lane < 48) *(GAS v4u*)(WSP(unsigned char, WS_WQ_T) + (size_t)n * 768 + 16 * lane) = o4; if (lane == 0) WSP(float, WS_SW)[12288 + n] = sc; }
      for (int n = gwx; n < 2048; n += NGWx) { float w16[16]; float am = 0.f;
#pragma unroll
          for (int i = 0; i < 16; ++i) { w16[i] = F.a->in[14][(size_t)(16 * lane + i) * 2048 + n]; am = fmaxf(am, fabsf(w16[i])); }
#pragma unroll
          for (int o = 1; o < 64; o <<= 1) am = fmaxf(am, __shfl_xor(am, o));
          const float sc = am > 0.f ? am * (1.0f / 127.0f) : 1.0f, isc = 1.0f / sc; v4u o4;
#pragma unroll
          for (int j = 0; j < 4; ++j) { unsigned w = 0u;
#pragma unroll
              for (int i = 0; i < 4; ++i) { float q = rintf(w16[4 * j + i] * isc); q = fminf(fmaxf(q, -127.f), 127.f); w |= ((unsigned)(int)q & 0xffu) << (8 * i); }
              o4[j] = w; }
          *(GAS v4u*)(WSP(unsigned char, WS_WPQ_T) + (size_t)n * 1024 + 16 * lane) = o4; if (lane == 0) WSP(float, WS_SW)[8192 + n] = sc; }
    }
    conv8(F.a->in[15], WSP(bf16, WS_SUBK), (size_t)16 * 128 * 128 / 8, gtid, NT);
    for (size_t i = gtid; i < (size_t)HW; i += NT) { const int s = win_src((int)i); WSP(float, WS_BIASP)[i] = s >= 0 ? F.a->in[3][s] : 0.f; }
    for (size_t i = gtid; i < (size_t)M * 16; i += NT) { const int t = (int)(i >> 4), j = (int)(i & 15);
        const float inv = exp2f(-(float)j * 0.83048202372184059f);
        const float ang = (float)F.pos[t] * inv;
        const double tt = (double)ang * 0.15915494309189535; const float fr = (float)(tt - rint(tt));
        float2 cs; cs.x = __builtin_amdgcn_cosf(fr); cs.y = __builtin_amdgcn_sinf(fr); WSP(float2, WS_CS)[i] = cs; }
    LAS float* scr = (LAS float*)(F.lds + F.wave * 16384);
    const int gw = F.vcu * NWAVES + F.wave, NGW = F.G * NWAVES;
    constexpr int I_IN = (HW / 32) * 16, I_Q = 24 * 12, I_KV = 32 * 4, I_OA = 32 * 8, I_OUT = 32 * 16, I_PQ = 64 * 16;
    constexpr int NITEMS = I_KV + 2 * I_OA + I_OUT;
    for (int it = gw; it < NITEMS; it += NGW) {
        int r = it;
        if (r < I_KV) { transpose_item<3, true>(F.a->in[7], 1024, WSP(bf16, WS_WKV_T), 256, 32, r, F.a->in[5], scr, F.lane); continue; } r -= I_KV;
        if (r < I_OA) { transpose_item<0, true>(F.a->in[8], 1024, WSP(bf16, WS_WOA_T), 1024, 32, r, nullptr, scr, F.lane); continue; } r -= I_OA;
        if (r < I_OA) { transpose_item<0, true>(F.a->in[9], 1024, (bf16*)(F.ws + WS_WOA_T + 512), 1024, 32, r, nullptr, scr, F.lane); continue; } r -= I_OA;
        transpose_item<0, true>(F.a->in[11], 1024, WSP(bf16, WS_WOUT_T), 1024, 32, r, nullptr, scr, F.lane);
    }
}

typedef float f32x2p __attribute__((ext_vector_type(2)));
__device__ __forceinline__ v4u fp8x8_to_bf16x8(v2u w) {
    const f32x2p f0 = __builtin_amdgcn_cvt_pk_f32_fp8((int)w.x, false), f1 = __builtin_amdgcn_cvt_pk_f32_fp8((int)w.x, true), f2 = __builtin_amdgcn_cvt_pk_f32_fp8((int)w.y, false), f3 = __builtin_amdgcn_cvt_pk_f32_fp8((int)w.y, true);
    return (v4u){pk2(f0.x, f0.y), pk2(f1.x, f1.y), pk2(f2.x, f2.y), pk2(f3.x, f3.y)};
}
__device__ __forceinline__ void p2_small(Frame& F) {
    constexpr int U = 4;
    const int gw = F.vcu * NWAVES + F.wave, NGW = F.G * NWAVES, lane = F.lane;
    const bf16* Hb = WSP(bf16, WS_H);
    for (int t0 = gw; t0 < M; t0 += NGW * U) {
        v4u a[U], b[U]; v2u sm[U]; f32x4 ca[U], cb[U]; float sq[U], skv[U];
#pragma unroll
        for (int u = 0; u < U; ++u) { const int t = t0 + u * NGW < M ? t0 + u * NGW : t0; const bf16* hrow = Hb + (size_t)t * HW;
            { const v2u a8 = *(const GAS v2u*)((const unsigned char*)hrow + 8 * lane), b8 = *(const GAS v2u*)((const unsigned char*)hrow + 512 + 8 * lane);
              a[u] = fp8x8_to_bf16x8(a8); b[u] = fp8x8_to_bf16x8(b8); } sm[u] = *(const GAS v2u*)(hrow + H_KROPE + 4 * lane);
            ca[u] = *(const GAS f32x4*)(WSP(float, WS_CS) + (size_t)t * 32 + 8 * (lane & 3)); cb[u] = *(const GAS f32x4*)(WSP(float, WS_CS) + (size_t)t * 32 + 8 * (lane & 3) + 4); }
#pragma unroll
        for (int u = 0; u < U; ++u) { float sa = 0.f, sb = 0.f;
#pragma unroll
            for (int i = 0; i < 4; ++i) { const float a0 = bflo(a[u][i]), a1 = bfhi(a[u][i]), b0 = bflo(b[u][i]), b1 = bfhi(b[u][i]); sa += a0 * a0 + a1 * a1; sb += b0 * b0 + b1 * b1; }
            sq[u] = sa + (lane < 32 ? sb : 0.f); skv[u] = lane >= 32 ? sb : 0.f; }
        wave_sum_n<U>(sq); wave_sum_n<U>(skv);
        float cqm[U];
#pragma unroll
        for (int u = 0; u < U; ++u) { float ma = 0.f, mb = 0.f;
#pragma unroll
            for (int i = 0; i < 4; ++i) { ma = fmaxf(ma, fmaxf(fabsf(bflo(a[u][i])), fabsf(bfhi(a[u][i])))); mb = fmaxf(mb, fmaxf(fabsf(bflo(b[u][i])), fabsf(bfhi(b[u][i])))); }
            cqm[u] = fmaxf(ma, lane < 32 ? mb : 0.f); }
        wave_max_n<U>(cqm);
#pragma unroll
        for (int u = 0; u < U; ++u) cqm[u] = cqm[u] > 0.f ? cqm[u] : 1.0f;
        float kim[U];
#pragma unroll
        for (int u = 0; u < U; ++u) { const float m4 = fmaxf(fmaxf(fabsf(bflo(sm[u].x)), fabsf(bfhi(sm[u].x))), fmaxf(fabsf(bflo(sm[u].y)), fabsf(bfhi(sm[u].y)))); kim[u] = (lane >= 40 && lane < 56) ? m4 : 0.f; }
        wave_max_n<U>(kim);
#pragma unroll
        for (int u = 0; u < U; ++u) kim[u] = kim[u] > 0.f ? kim[u] : 1.0f;
#pragma unroll
        for (int u = 0; u < U; ++u) { const int t = t0 + u * NGW; const v2u s = sm[u];
            const float x0 = bflo(s.x), x1 = bfhi(s.x), x2 = bflo(s.y), x3 = bfhi(s.y);
            const float y0 = __shfl_down(x0, 4), y1 = __shfl_down(x1, 4), y2 = __shfl_down(x2, 4), y3 = __shfl_down(x3, 4);
            if (t < M) {
                { const float iq = 127.0f / cqm[u]; v2u qa, qb2;
#pragma unroll
                  for (int h2 = 0; h2 < 2; ++h2) { unsigned wa = 0u, wb = 0u;
#pragma unroll
                      for (int i = 0; i < 2; ++i) { const unsigned sa_ = a[u][2 * h2 + i], sb_ = b[u][2 * h2 + i];
                          float q0 = rintf(bflo(sa_) * iq), q1 = rintf(bfhi(sa_) * iq), q2 = rintf(bflo(sb_) * iq), q3 = rintf(bfhi(sb_) * iq);
                          q0 = fminf(fmaxf(q0, -127.f), 127.f); q1 = fminf(fmaxf(q1, -127.f), 127.f); q2 = fminf(fmaxf(q2, -127.f), 127.f); q3 = fminf(fmaxf(q3, -127.f), 127.f);
                          wa |= (((unsigned)(int)q0 & 0xffu) | (((unsigned)(int)q1 & 0xffu) << 8)) << (16 * i); wb |= (((unsigned)(int)q2 & 0xffu) | (((unsigned)(int)q3 & 0xffu) << 8)) << (16 * i); }
                      qa[h2] = wa; qb2[h2] = wb; }
                  *(GAS v2u*)(WSP(unsigned char, WS_XB) + (size_t)t * 768 + 8 * lane) = qa;
                  if (lane < 32) *(GAS v2u*)(WSP(unsigned char, WS_XB) + (size_t)t * 768 + 512 + 8 * lane) = qb2; }
                if (lane == 0) { WSP(float, WS_RSQ)[t] = (cqm[u] * (1.0f / 127.0f)) / sqrtf(sq[u] * (1.0f / 768.0f) + RMS_EPS); WSP(float, WS_RSKV)[t] = (1.0f / 256.0f) / sqrtf(skv[u] * (1.0f / 256.0f) + RMS_EPS); }
                if (lane >= 8 && lane < 24) { const int d0 = 4 * (lane - 8), pos0 = d0 < 32 ? 16 * (d0 >> 3) + (d0 & 7) : 16 * ((d0 - 32) >> 3) + 8 + ((d0 - 32) & 7);
                    int w8 = 0; w8 = __builtin_amdgcn_cvt_pk_fp8_f32(x0, x1, w8, false); w8 = __builtin_amdgcn_cvt_pk_fp8_f32(x2, x3, w8, true);
                    *(GAS int*)(WSP(unsigned char, WS_KB) + (size_t)t * 64 + pos0) = w8; }
                if (lane >= 24 && lane < 40) *(GAS unsigned*)(WSP(unsigned char, WS_VB) + (size_t)t * 64 + 4 * (lane - 24)) = pk4_fp8(x0, x1, x2, x3);
                if (lane >= 40 && lane < 56) { const float iq = 127.0f / kim[u]; unsigned q4 = 0u; const float xs4[4] = {x0, x1, x2, x3};
#pragma unroll
                    for (int i = 0; i < 4; ++i) { float q = rintf(xs4[i] * iq); q = fminf(fmaxf(q, -127.f), 127.f); q4 |= ((unsigned)(int)q & 0xffu) << (8 * i); }
                    *(GAS unsigned*)(WSP(unsigned char, WS_KIDX) + (size_t)t * 64 + 4 * (lane - 40)) = q4; if (lane == 40) WSP(float, WS_SW)[16384 + t] = kim[u] * (1.0f / 127.0f); }
                if (lane >= 56 && lane < 58) *(GAS f32x4*)(WSP(float, WS_WIDX) + (size_t)t * 8 + 4 * (lane - 56)) = (f32x4){bflo(s.x), bfhi(s.x), bflo(s.y), bfhi(s.y)};
                if (lane < 4) {
                    v4u o;
                    o.x = pk2(x0 * ca[u][0] - y0 * ca[u][1], x1 * ca[u][2] - y1 * ca[u][3]); o.y = pk2(x2 * cb[u][0] - y2 * cb[u][1], x3 * cb[u][2] - y3 * cb[u][3]);
                    o.z = pk2(y0 * ca[u][0] + x0 * ca[u][1], y1 * ca[u][2] + x1 * ca[u][3]); o.w = pk2(y2 * cb[u][0] + x2 * cb[u][1], y3 * cb[u][2] + x3 * cb[u][3]);
                    *(GAS v4u*)(WSP(bf16, WS_KPE) + (size_t)t * 32 + 8 * lane) = o;
                }
            } }
    }
}

constexpr int MLA_KP = 208, MLA_VP = 136;
constexpr int MLA_KOFF = 0, MLA_VOFF = 64 * MLA_KP, MLA_POFF = MLA_VOFF + 64 * MLA_VP, MLA_BUF = 22528;
static_assert(2 * MLA_BUF + 8 * 64 * MLA_KP <= MISC_OFF, "MLA LDS map");
__device__ __forceinline__ void mla_phase(Frame& F) {
    const int lane = F.lane, wave = F.wave, tid = F.tid, hh = lane >> 5, ql = lane & 31;
    const bf16* Qb = WSP(bf16, WS_Q); const bf16* KVb = WSP(bf16, WS_KV); const bf16* KPE = WSP(bf16, WS_KPE); bf16* OA = WSP(bf16, WS_XB);
    const float SC = 0.10206207261596575f * 1.4426950408889634f;
    for (int bh = F.vcu; bh < BATCH * 8; bh += F.G) {
        const int b = bh >> 3, h = bh & 7; const int* posb = F.pos + b * SEQ;
        for (int qb = 0; qb < 4; ++qb) {
            const int q0 = qb * 512 + wave * 64;
            int cq[2]; float mrun[2], lrun[2]; f32x16 o0[2], o1[2];
            LAS unsigned char* QW = F.lds + 2 * MLA_BUF + wave * (64 * MLA_KP);
#pragma unroll
            for (int qs = 0; qs < 2; ++qs) { const size_t tq = (size_t)b * SEQ + q0 + 32 * qs + ql;
#pragma unroll
                for (int s = 0; s < 4; ++s) *(LAS v4u*)(QW + (32 * qs + ql) * MLA_KP + (16 * s + 8 * hh) * 2) = fp8x8_to_bf16x8(*(const GAS v2u*)((const unsigned char*)Qb + tq * 768 + h * 64 + 16 * s + 8 * hh));
#pragma unroll
                for (int s = 0; s < 2; ++s) {
                    const v4u qw = fp8x8_to_bf16x8(*(const GAS v2u*)((const unsigned char*)Qb + tq * 768 + 512 + h * 32 + 16 * s + 8 * hh));
                    const f32x4 ca = *(const GAS f32x4*)(WSP(float, WS_CS) + tq * 32 + 8 * (2 * s + hh)), cb = *(const GAS f32x4*)(WSP(float, WS_CS) + tq * 32 + 8 * (2 * s + hh) + 4);
                    const float a0 = bflo(qw.x), a1 = bfhi(qw.x), a2 = bflo(qw.y), a3 = bfhi(qw.y), b0 = bflo(qw.z), b1 = bfhi(qw.z), b2 = bflo(qw.w), b3 = bfhi(qw.w);
                    v4u ow; ow.x = pk2(a0 * ca[0] - b0 * ca[1], a1 * ca[2] - b1 * ca[3]); ow.y = pk2(a2 * cb[0] - b2 * cb[1], a3 * cb[2] - b3 * cb[3]);
                    ow.z = pk2(b0 * ca[0] + a0 * ca[1], b1 * ca[2] + a1 * ca[3]); ow.w = pk2(b2 * cb[0] + a2 * cb[1], b3 * cb[2] + a3 * cb[3]);
                    *(LAS v4u*)(QW + (32 * qs + ql) * MLA_KP + (64 + 16 * s + 8 * hh) * 2) = ow; }
                cq[qs] = posb[q0 + 32 * qs + ql] >> 6; mrun[qs] = -1e30f; lrun[qs] = 0.f;
#pragma unroll
                for (int i = 0; i < 16; ++i) { o0[qs][i] = 0.f; o1[qs][i] = 0.f; } }
            const int cq_min = __builtin_amdgcn_readfirstlane(posb[q0] >> 6), cq_max = __builtin_amdgcn_readfirstlane(posb[q0 + 63] >> 6);
            const int cq_last = __builtin_amdgcn_readfirstlane(posb[qb * 512 + 511] >> 6), pos0 = __builtin_amdgcn_readfirstlane(posb[0]);
            int nvis = (cq_last + 1) * 64 - pos0; nvis = nvis > SEQ ? SEQ : (nvis < 1 ? 1 : nvis);
            const int ntiles = (nvis + 63) >> 6;
            const int vk = tid >> 3, vc = tid & 7, pk = tid >> 2, pc = tid & 3;
            v2u kr0_8, vr_8; v4u kr1 = (v4u){0u, 0u, 0u, 0u}; int pr = 0;
#define MLA_LOAD(t) do { const size_t tk = (size_t)b * SEQ + (t) * 64; const unsigned char* rowp_ = (const unsigned char*)KVb + (tk + vk) * 1024 + h * 64 + 8 * vc;     \
                kr0_8 = *(const GAS v2u*)(rowp_); vr_8 = *(const GAS v2u*)(rowp_ + 512); \
                if (tid < 256) kr1 = *(const GAS v4u*)(KPE + (tk + pk) * 32 + 8 * pc); if (tid < 64) pr = posb[(t) * 64 + tid]; } while (0)
#define MLA_STORE(buf) do { LAS unsigned char* B_ = F.lds + (buf) * MLA_BUF; const v4u kr0 = fp8x8_to_bf16x8(kr0_8), vr = fp8x8_to_bf16x8(vr_8); \
                *(LAS v4u*)(B_ + MLA_KOFF + vk * MLA_KP + vc * 16) = kr0; if (tid < 256) *(LAS v4u*)(B_ + MLA_KOFF + pk * MLA_KP + (8 + pc) * 16) = kr1; \
                _Pragma("unroll") for (int i_ = 0; i_ < 4; ++i_) { *(LAS unsigned short*)(B_ + MLA_VOFF + (8 * vc + 2 * i_) * MLA_VP + vk * 2) = (unsigned short)(vr[i_] & 0xffffu); \
                    *(LAS unsigned short*)(B_ + MLA_VOFF + (8 * vc + 2 * i_ + 1) * MLA_VP + vk * 2) = (unsigned short)(vr[i_] >> 16); } \
                if (tid < 64) *(LAS int*)(B_ + MLA_POFF + tid * 4) = pr; } while (0)
            __syncthreads();
            MLA_LOAD(0); MLA_STORE(0); __syncthreads();
            for (int t = 0; t < ntiles; ++t) {
                if (t + 1 < ntiles) MLA_LOAD(t + 1);
                const LAS unsigned char* Bc = F.lds + (t & 1) * MLA_BUF;
                const int ckmin = (*(const LAS int*)(Bc + MLA_POFF)) >> 6, ckmax = (*(const LAS int*)(Bc + MLA_POFF + 63 * 4)) >> 6;
                if (ckmin <= cq_max) {
                    f32x16 s0[2], s1[2];
#pragma unroll
                    for (int qs = 0; qs < 2; ++qs)
#pragma unroll
                        for (int i = 0; i < 16; ++i) { s0[qs][i] = 0.f; s1[qs][i] = 0.f; }
                    bf16x8 kf[2][2], qa_, qb_;
#define MLA_KFR(d_, s_) do { kf[d_][0] = *(const LAS bf16x8*)(Bc + MLA_KOFF + ql * MLA_KP + (16 * (s_) + 8 * hh) * 2); kf[d_][1] = *(const LAS bf16x8*)(Bc + MLA_KOFF + (32 + ql) * MLA_KP + (16 * (s_) + 8 * hh) * 2); } while (0)
                    MLA_KFR(0, 0);
#pragma unroll
                    for (int s = 0; s < 6; ++s) {
                        qa_ = *(const LAS bf16x8*)(QW + ql * MLA_KP + (16 * s + 8 * hh) * 2); qb_ = *(const LAS bf16x8*)(QW + (32 + ql) * MLA_KP + (16 * s + 8 * hh) * 2);
                        if (s + 1 < 6) MLA_KFR((s + 1) & 1, s + 1);
                        __builtin_amdgcn_sched_barrier(0);
                        s0[0] = MFMA32(kf[s & 1][0], qa_, s0[0]); s1[0] = MFMA32(kf[s & 1][1], qa_, s1[0]); s0[1] = MFMA32(kf[s & 1][0], qb_, s0[1]); s1[1] = MFMA32(kf[s & 1][1], qb_, s1[1]);
                        __builtin_amdgcn_sched_barrier(0);
                    }
#undef MLA_KFR
                    if (ckmax > cq_min) {
#pragma unroll
                        for (int rg = 0; rg < 4; ++rg) {
                            const v4u p0 = *(const LAS v4u*)(Bc + MLA_POFF + (8 * rg + 4 * hh) * 4), p1 = *(const LAS v4u*)(Bc + MLA_POFF + (32 + 8 * rg + 4 * hh) * 4);
#pragma unroll
                            for (int qs = 0; qs < 2; ++qs)
#pragma unroll
                                for (int i = 0; i < 4; ++i) { if (((int)p0[i] >> 6) > cq[qs]) s0[qs][4 * rg + i] = -1e30f; if (((int)p1[i] >> 6) > cq[qs]) s1[qs][4 * rg + i] = -1e30f; }
                        }
                    }
                    bf16x8 pf[2][2][2];
#pragma unroll
                    for (int qs = 0; qs < 2; ++qs) {
                        float mx = fmaxf(fmaxf(s0[qs][0], s0[qs][1]), s1[qs][0]);
#pragma unroll
                        for (int i = 2; i < 16; i += 2) mx = fmaxf(fmaxf(mx, s0[qs][i]), s0[qs][i + 1]);
#pragma unroll
                        for (int i = 1; i < 16; i += 2) mx = fmaxf(fmaxf(mx, s1[qs][i]), s1[qs][(i + 1) & 15]);
                        mx = xhalf_max(mx);
                        const float mcand = mx * SC;
                        if (__builtin_amdgcn_ballot_w64(mcand > mrun[qs] + 8.0f) != 0ull) {
                            const float mnew_ = fmaxf(mrun[qs], mcand); const float al = __builtin_amdgcn_exp2f(mrun[qs] - mnew_); lrun[qs] *= al; mrun[qs] = mnew_;
#pragma unroll
                            for (int i = 0; i < 16; ++i) { o0[qs][i] *= al; o1[qs][i] *= al; }
                        }
                        const float mnew = mrun[qs];
                        float ps = 0.f;
#pragma unroll
                        for (int i = 0; i < 16; ++i) { s0[qs][i] = __builtin_amdgcn_exp2f(fmaf(s0[qs][i], SC, -mnew)); s1[qs][i] = __builtin_amdgcn_exp2f(fmaf(s1[qs][i], SC, -mnew)); ps += s0[qs][i] + s1[qs][i]; }
                        lrun[qs] += ps;
#pragma unroll
                        for (int s2 = 0; s2 < 2; ++s2) {
                            v4u w0, w1;
                            w0.x = pk2(s0[qs][8 * s2 + 0], s0[qs][8 * s2 + 1]); w0.y = pk2(s0[qs][8 * s2 + 2], s0[qs][8 * s2 + 3]); w0.z = pk2(s0[qs][8 * s2 + 4], s0[qs][8 * s2 + 5]); w0.w = pk2(s0[qs][8 * s2 + 6], s0[qs][8 * s2 + 7]);
                            w1.x = pk2(s1[qs][8 * s2 + 0], s1[qs][8 * s2 + 1]); w1.y = pk2(s1[qs][8 * s2 + 2], s1[qs][8 * s2 + 3]); w1.z = pk2(s1[qs][8 * s2 + 4], s1[qs][8 * s2 + 5]); w1.w = pk2(s1[qs][8 * s2 + 6], s1[qs][8 * s2 + 7]);
                            pf[qs][0][s2] = __builtin_bit_cast(bf16x8, w0); pf[qs][1][s2] = __builtin_bit_cast(bf16x8, w1);
                        }
                    }
#pragma unroll
                    for (int kb = 0; kb < 2; ++kb)
#pragma unroll
                        for (int s2 = 0; s2 < 2; ++s2) {
                            const int ko = (32 * kb + 16 * s2 + 4 * hh) * 2;
                            const v2u a0 = *(const LAS v2u*)(Bc + MLA_VOFF + ql * MLA_VP + ko), a1 = *(const LAS v2u*)(Bc + MLA_VOFF + ql * MLA_VP + ko + 16);
                            const v2u c0 = *(const LAS v2u*)(Bc + MLA_VOFF + (32 + ql) * MLA_VP + ko), c1 = *(const LAS v2u*)(Bc + MLA_VOFF + (32 + ql) * MLA_VP + ko + 16);
                            const v4u va = (v4u){a0.x, a0.y, a1.x, a1.y}, vb = (v4u){c0.x, c0.y, c1.x, c1.y};
#pragma unroll
                            for (int qs = 0; qs < 2; ++qs) { o0[qs] = MFMA32(__builtin_bit_cast(bf16x8, va), pf[qs][kb][s2], o0[qs]); o1[qs] = MFMA32(__builtin_bit_cast(bf16x8, vb), pf[qs][kb][s2], o1[qs]); }
                        }
                }
                if (t + 1 < ntiles) MLA_STORE((t + 1) & 1);
                __syncthreads();
            }
#undef MLA_LOAD
#undef MLA_STORE
#pragma unroll
            for (int qs = 0; qs < 2; ++qs) {
                const float inv = 32.0f / xhalf_sum(lrun[qs]);
                unsigned char* orow = (unsigned char*)OA + ((size_t)b * SEQ + q0 + 32 * qs + ql) * 1024 + h * 64;
#pragma unroll
                for (int rg = 0; rg < 4; ++rg) {
                    *(GAS unsigned*)(orow + 8 * rg + 4 * hh) = pk4_fp8(o0[qs][4 * rg] * inv, o0[qs][4 * rg + 1] * inv, o0[qs][4 * rg + 2] * inv, o0[qs][4 * rg + 3] * inv);
                    *(GAS unsigned*)(orow + 32 + 8 * rg + 4 * hh) = pk4_fp8(o1[qs][4 * rg] * inv, o1[qs][4 * rg + 1] * inv, o1[qs][4 * rg + 2] * inv, o1[qs][4 * rg + 3] * inv);
                }
            }
        }
    }
}

__device__ __forceinline__ int t5_bucket(int rel) {
    const int n = rel < 0 ? -rel : rel; const int ret = rel > 0 ? 16 : 0;
    int large = 8 + (int)(log2f((float)(n < 1 ? 1 : n) * 0.125f) * 2.0f); large = large > 15 ? 15 : large;
    return ret + (n < 8 ? n : large);
}
constexpr int DSA_POS_OFF = 0, DSA_BT_OFF = 8192  , DSA_WAVE_OFF = 12288, DSA_VP = 160  , DSA_WAVE_BYTES = 18688  ,
              DSA_LIST_OFF = 16384, DSA_LIST_STRIDE = 544  , DSA_KCNT_OFF = 16384 + 2176, DSA_PBUF_OFF = 0;
constexpr int DSA_SENT = (DSA_WAVE_OFF + 8 * DSA_WAVE_BYTES) / 4;
static_assert(DSA_WAVE_OFF + 8 * DSA_WAVE_BYTES + 16 <= MISC_OFF && DSA_SENT < 65536, "DSA LDS map");
__device__ __forceinline__ int half32_sum(int v) {
    v += __builtin_amdgcn_update_dpp(0, v, 0x111, 0xf, 0xf, true);
    v += __builtin_amdgcn_update_dpp(0, v, 0x112, 0xf, 0xf, true);
    v += __builtin_amdgcn_update_dpp(0, v, 0x114, 0xf, 0xf, true);
    v += __builtin_amdgcn_update_dpp(0, v, 0x118, 0xf, 0xf, true);
    v += __builtin_amdgcn_update_dpp(0, v, 0x142, 0xa, 0xf, true);
    const int lo = __builtin_amdgcn_readlane(v, 31), hi = __builtin_amdgcn_readlane(v, 63);
    return (threadIdx.x & 32) ? hi : lo;
}
__device__ __forceinline__ void dsa_select(const unsigned (&kA)[64], int nq, int hq, int kl, LAS unsigned short* LISTQ, LAS int* KCNTQ, int nkb) {
    const int KQ = nq < 256 ? nq : 256;
    unsigned T = 0u; bool done = false; int gq = 2048;
    if (nq <= 256) { T = 0x00800000u; done = true; gq = nq; }
    for (int bit = 31; bit >= 0; --bit) {
        if (__builtin_amdgcn_ballot_w64(!done) == 0ull) break;
        const unsigned cand = T | (1u << bit); int n_ = 0;
#pragma unroll
        for (int q4 = 0; q4 < 4; ++q4) { if (16 * q4 < nkb) {
#pragma unroll
            for (int kb = 16 * q4; kb < 16 * q4 + 16; ++kb) n_ += (kA[kb] >= cand) ? 1 : 0; } }
        n_ = half32_sum(n_);
        if (!done && n_ >= KQ) { T = cand; gq = n_; done = (n_ == KQ); }
    }
                const unsigned ltmask = (1u << kl) - 1u; int base = 0;
    const bool ties = __builtin_amdgcn_ballot_w64(gq != KQ) != 0ull;
    if (!ties) {
#pragma unroll
        for (int q4 = 0; q4 < 4; ++q4) { if (16 * q4 < nkb) {
#pragma unroll
        for (int kb = 16 * q4; kb < 16 * q4 + 16; ++kb) {
            const bool sel = kA[kb] >= T;
            const unsigned long long bal = __builtin_amdgcn_ballot_w64(sel);
            const unsigned w = hq ? (unsigned)(bal >> 32) : (unsigned)bal;
            LISTQ[sel ? base + __popc(w & ltmask) : 271] = (unsigned short)(32 * kb + kl);
            base += __popc(w);
        } } }
    } else {
        int gt = 0;
#pragma unroll
        for (int kb = 0; kb < 64; ++kb) gt += (kA[kb] > T) ? 1 : 0;
        gt = half32_sum(gt);
        int rem = KQ - gt;
#pragma unroll
        for (int kb = 0; kb < 64; ++kb) {
            const unsigned long long gb_ = __builtin_amdgcn_ballot_w64(kA[kb] > T), eb_ = __builtin_amdgcn_ballot_w64(kA[kb] == T);
            unsigned e = hq ? (unsigned)(eb_ >> 32) : (unsigned)eb_; const int c = __popc(e), take = c < rem ? c : rem;
            for (int dr = c - take; dr > 0; --dr) e &= ~(0x80000000u >> __builtin_clz(e));
            rem -= take; const unsigned w = (hq ? (unsigned)(gb_ >> 32) : (unsigned)gb_) | e;
            if ((w >> kl) & 1u) LISTQ[base + __popc(w & ltmask)] = (unsigned short)(32 * kb + kl);
            base += __popc(w);
        }
    }
    for (int s_ = base + kl; s_ < 272; s_ += 32) LISTQ[s_] = (unsigned short)DSA_SENT;
    if (kl == 0) *KCNTQ = base;
}
__device__ __forceinline__ void dsa_phase(Frame& F) {
    const int lane = F.lane, wave = F.wave, tid = F.tid, hq = lane >> 5, kl = lane & 31;
    const bf16* Hb = WSP(bf16, WS_H); const unsigned char* KIDX8 = WSP(unsigned char, WS_KIDX); const float* SKI = WSP(float, WS_SW) + 16384; const unsigned char* KB8 = WSP(unsigned char, WS_KB); const bf16* VBb = WSP(bf16, WS_VB);
    const float* WIDX = WSP(float, WS_WIDX); bf16* OB = (bf16*)(F.ws + WS_XB + 512);
    LAS int* POSB = (LAS int*)(F.lds + DSA_POS_OFF); LAS _Float16* BT = (LAS _Float16*)(F.lds + DSA_BT_OFF);
    LAS unsigned char* WL = F.lds + DSA_WAVE_OFF + wave * DSA_WAVE_BYTES;
    LAS float* PBUF = (LAS float*)(WL + DSA_PBUF_OFF); LAS int* KCNT = (LAS int*)(WL + DSA_KCNT_OFF);
    __syncthreads();
    for (int i = tid; i < 2048; i += NWAVES * 64) { const int e = i >> 3; const int bk = t5_bucket(e < 255 ? e - 127 : 127); BT[i] = e < 255 ? (_Float16)F.a->in[10][bk * 8 + (i & 7)] : (_Float16)(-65504.0f); }
    if (tid == 0) POSB[DSA_SENT] = 0x3fffffff;
    const float NEG_INF = -__builtin_inff();
    for (int gid = F.vcu; gid < 2048; gid += F.G) {
        const int rr = gid >> 8, cu = gid & 255, xq = cu >> 5, jj = cu & 31, b = 4 * xq + (jj & 3), cc = jj >> 2, tile = 8 * rr + ((rr & 1) ? 7 - cc : cc);
        const int* posb = F.pos + b * SEQ;
        __syncthreads();
        *(LAS v4u*)(POSB + 4 * tid) = *(const GAS v4u*)(posb + 4 * tid);
        __syncthreads();
        const int q0 = tile * 32 + wave * 4;
        typedef int i32x16 __attribute__((ext_vector_type(16)));
        i32x4 Aq8[2]; float sqrow;
        { const int jj = kl >> 3, hhr = (kl >> 2) & 1, ii = kl & 3, qiA = 2 * hhr + (jj >> 1), hdA = 4 * (jj & 1) + ii; const size_t tA = (size_t)b * SEQ + q0 + qiA;
          float qf[2][16]; float am = 0.f;
#pragma unroll
          for (int s = 0; s < 2; ++s) { const v4u w8 = *(const GAS v4u*)((const unsigned char*)(Hb + tA * HW) + H_QIDX + hdA * 64 + 32 * s + 16 * hq);
#pragma unroll
              for (int i = 0; i < 4; ++i) { const f32x2p lo = __builtin_amdgcn_cvt_pk_f32_fp8((int)w8[i], false), hi = __builtin_amdgcn_cvt_pk_f32_fp8((int)w8[i], true);
                  qf[s][4 * i] = lo.x; qf[s][4 * i + 1] = lo.y; qf[s][4 * i + 2] = hi.x; qf[s][4 * i + 3] = hi.y; }
#pragma unroll
              for (int i = 0; i < 16; ++i) am = fmaxf(am, fabsf(qf[s][i])); }
          am = fmaxf(am, __shfl_xor(am, 32)); sqrow = am > 0.f ? am * (1.0f / 127.0f) : 1.0f; const float isq = 1.0f / sqrow;
#pragma unroll
          for (int s = 0; s < 2; ++s)
#pragma unroll
              for (int w = 0; w < 4; ++w) { unsigned q4 = 0u;
#pragma unroll
                  for (int i = 0; i < 4; ++i) { float q = rintf(qf[s][4 * w + i] * isq); q = fminf(fmaxf(q, -127.f), 127.f); q4 |= ((unsigned)(int)q & 0xffu) << (8 * i); }
                  Aq8[s][w] = (int)q4; } }
        const size_t tq0 = (size_t)b * SEQ + q0 + 2 * hq;
        float wv[16];
        { const f32x4 w0a = *(const GAS f32x4*)(WIDX + tq0 * 8), w0b = *(const GAS f32x4*)(WIDX + tq0 * 8 + 4), w1a = *(const GAS f32x4*)(WIDX + tq0 * 8 + 8), w1b = *(const GAS f32x4*)(WIDX + tq0 * 8 + 12);
          const float wb[16] = {w0a[0], w0a[1], w0a[2], w0a[3], w0b[0], w0b[1], w0b[2], w0b[3], w1a[0], w1a[1], w1a[2], w1a[3], w1b[0], w1b[1], w1b[2], w1b[3]};
#pragma unroll
          for (int v = 0; v < 16; ++v) { const int rsrc = 8 * (2 * (v >> 3) + ((v & 7) >> 2)) + 4 * hq + (v & 3); wv[v] = wb[v] * __shfl(sqrow, rsrc); } }
        const int cq0 = POSB[q0 + 2 * hq] >> 6, cq1 = POSB[q0 + 2 * hq + 1] >> 6;
        int nvis = ((POSB[q0 + 3] >> 6) + 1) * 64 - POSB[0]; nvis = nvis > SEQ ? SEQ : (nvis < 1 ? 1 : nvis);
        const int nkb = __builtin_amdgcn_readfirstlane((nvis + 31) >> 5);
        LAS unsigned* KBL = (LAS unsigned*)WL;
        unsigned kA[64]; int nA = 0, nB = 0;
        const unsigned char* kp = KIDX8 + ((size_t)b * SEQ + kl) * 64 + 16 * hq;
        const float* skp = SKI + (size_t)b * SEQ + kl;
        i32x4 kr[8][2]; float skr[8];
#pragma unroll
        for (int j = 0; j < 7; ++j) { const int jb = j < nkb ? j : nkb - 1; kr[j][0] = *(const GAS i32x4*)(kp + (size_t)jb * 2048); kr[j][1] = *(const GAS i32x4*)(kp + (size_t)jb * 2048 + 32); skr[j] = skp[jb * 32]; }
        { const int lastb = (nkb > 7 ? 6 : nkb - 1); kp += (size_t)lastb * 2048; skp += lastb * 32; }
#pragma unroll
        for (int kb = 0; kb < 64; ++kb) {
            if (kb < nkb) {
                const int key = 32 * kb + kl;
                if (kb + 7 < nkb) { kp += 2048; skp += 32; }
                kr[(kb + 7) & 7][0] = *(const GAS i32x4*)kp; kr[(kb + 7) & 7][1] = *(const GAS i32x4*)(kp + 32); skr[(kb + 7) & 7] = *skp;
                i32x16 acc;
#pragma unroll
                for (int i = 0; i < 16; ++i) acc[i] = 0;
                acc = __builtin_amdgcn_mfma_i32_32x32x32_i8(Aq8[0], kr[kb & 7][0], acc, 0, 0, 0);
                acc = __builtin_amdgcn_mfma_i32_32x32x32_i8(Aq8[1], kr[kb & 7][1], acc, 0, 0, 0);
                const int ck = POSB[key] >> 6;
                float sa = 0.f, sb = 0.f;
#pragma unroll
                for (int hd_ = 0; hd_ < 8; ++hd_) { const int a_ = acc[hd_] > 0 ? acc[hd_] : 0, b_ = acc[8 + hd_] > 0 ? acc[8 + hd_] : 0; sa += wv[hd_] * (float)a_; sb += wv[8 + hd_] * (float)b_; }
                sa *= skr[kb & 7]; sb *= skr[kb & 7];
                const bool ma = ck <= cq0, mb = ck <= cq1;
                nA += ma ? 1 : 0; nB += mb ? 1 : 0;
                const unsigned ua = __float_as_uint(ma ? sa + 0.0f : NEG_INF), ub = __float_as_uint(mb ? sb + 0.0f : NEG_INF);
                kA[kb] = ua ^ ((unsigned)((int)ua >> 31) | 0x80000000u); KBL[kb * 64 + lane] = ub ^ ((unsigned)((int)ub >> 31) | 0x80000000u);
            } else { kA[kb] = 0x007fffffu; KBL[kb * 64 + lane] = 0x007fffffu; }
        }
#pragma unroll
        for (int o = 1; o < 32; o <<= 1) { nA += __shfl_xor(nA, o); nB += __shfl_xor(nB, o); }
#if DSA_SKIP != 2
        dsa_select(kA, nA, hq, kl, (LAS unsigned short*)(WL + DSA_LIST_OFF + (2 * hq) * DSA_LIST_STRIDE), KCNT + 2 * hq, nkb);
#pragma unroll
        for (int kb = 0; kb < 64; ++kb) kA[kb] = KBL[kb * 64 + lane];
        dsa_select(kA, nB, hq, kl, (LAS unsigned short*)(WL + DSA_LIST_OFF + (2 * hq + 1) * DSA_LIST_STRIDE), KCNT + 2 * hq + 1, nkb);
#endif
#if DSA_SKIP == 0
        const int hd = lane & 15, g4 = lane >> 4;
        const unsigned char* vsrc8 = (const unsigned char*)VBb + (size_t)b * SEQ * 64;
        const int vrr = lane >> 2;
        const unsigned vx_hi = (unsigned)(((lane >> 4) & 1) << 1);
        unsigned vrd[4];
        { const int rp = (lane & 15) >> 1, keyr = rp < 4 ? 4 * g4 + rp : 16 + 4 * g4 + (rp - 4); const unsigned xk = (unsigned)(((keyr >> 4) & 1) | (((keyr >> 2) & 1) << 1));
#pragma unroll
          for (int d = 0; d < 4; ++d) vrd[d] = (unsigned)(size_t)WL + (unsigned)(keyr * 64) + ((((unsigned)d) ^ xk) << 4) + 8u * (lane & 1); }
        v4u kw[16]; v2u qwr[2];
#define DSA_KQ_LOAD(qn) do { const LAS unsigned short* LISTn_ = (const LAS unsigned short*)(WL + DSA_LIST_OFF + (qn) * DSA_LIST_STRIDE); const int nblkn_ = (__builtin_amdgcn_readfirstlane(KCNT[qn]) + 15) >> 4; \
            _Pragma("unroll") for (int c = 0; c < 2; ++c) qwr[c] = *(const GAS v2u*)((const unsigned char*)(Hb + ((size_t)b * SEQ + q0 + (qn)) * HW) + H_QB + (hd & 7) * 64 + 32 * c + 8 * g4);     \
            int kidx_[16]; _Pragma("unroll") for (int blk = 0; blk < 16; ++blk) { const int idl_ = (int)LISTn_[16 * blk + hd]; kidx_[blk] = idl_ < 2047 ? idl_ : 2047; }     \
            __builtin_amdgcn_sched_barrier(0);                             \
            _Pragma("unroll") for (int blk = 0; blk < 16; ++blk) kw[blk] = *(const GAS v4u*)(KB8 + ((size_t)b * SEQ + kidx_[blk]) * 64 + 16 * g4); } while (0)
        DSA_KQ_LOAD(0);
        for (int qq_ = 0; qq_ < 4 * DSA_REP; ++qq_) { const int q = qq_ & 3;
            const LAS unsigned short* LIST = (const LAS unsigned short*)(WL + DSA_LIST_OFF + q * DSA_LIST_STRIDE);
            const int L = __builtin_amdgcn_readfirstlane(KCNT[q]), nblk = (L + 15) >> 4, L16 = 16 * nblk;
            const size_t tq = (size_t)b * SEQ + q0 + q; const int posq = POSB[q0 + q];
            {
#pragma unroll 8
              for (int it = 0; it < 16; ++it) { const int slot_ = 16 * it + vrr; const int l_ = (int)LIST[slot_]; const int idx_ = l_ < 2047 ? l_ : 2047;
                  __builtin_amdgcn_global_load_lds((const unsigned*)(vsrc8 + (size_t)idx_ * 64 + ((((unsigned)(lane & 3)) ^ ((unsigned)(it & 1) | vx_hi)) << 4)), (LAS unsigned*)(WL + it * 1024), 16, 0, 0); } }
            long Bq8[2];
#pragma unroll
            for (int c = 0; c < 2; ++c) Bq8[c] = (long)(((unsigned long long)qwr[c].y << 32) | qwr[c].x);
            float lg[16][4]; float mx = -1e30f;
            { v2u id4s[16];
#pragma unroll
              for (int blk = 0; blk < 16; ++blk) id4s[blk] = *(const LAS v2u*)(LIST + 16 * blk + 4 * g4);
              __builtin_amdgcn_sched_barrier(0);
              int ps[16][4];
#pragma unroll
              for (int blk = 0; blk < 16; ++blk) { const v2u id4 = id4s[blk];
                  ps[blk][0] = POSB[id4.x & 0xffffu]; ps[blk][1] = POSB[id4.x >> 16]; ps[blk][2] = POSB[id4.y & 0xffffu]; ps[blk][3] = POSB[id4.y >> 16]; }
              __builtin_amdgcn_sched_barrier(0);
#pragma unroll
              for (int blk = 0; blk < 16; ++blk)
#pragma unroll
                  for (int i = 0; i < 4; ++i) { int rel = ps[blk][i] - posq; rel = rel < -127 ? -127 : (rel > 128 ? 128 : rel);
                      lg[blk][i] = (float)BT[(rel + 127) * 8 + (hd & 7)]; }
              __builtin_amdgcn_sched_barrier(0); }
#pragma unroll
            for (int blk = 0; blk < 16; ++blk) {
                f32x4 acc = (f32x4){0.f, 0.f, 0.f, 0.f};
                acc = __builtin_amdgcn_mfma_f32_16x16x32_fp8_fp8((long)(((unsigned long long)kw[blk].y << 32) | kw[blk].x), Bq8[0], acc, 0, 0, 0);
                acc = __builtin_amdgcn_mfma_f32_16x16x32_fp8_fp8((long)(((unsigned long long)kw[blk].w << 32) | kw[blk].z), Bq8[1], acc, 0, 0, 0);
#pragma unroll
                for (int i = 0; i < 4; ++i) { const float v = acc[i] * 0.125f + lg[blk][i]; lg[blk][i] = v; mx = fmaxf(mx, v); }
            }
            const bool more = qq_ + 1 < 4 * DSA_REP;
            mx = fmaxf(mx, __shfl_xor(mx, 16)); mx = xhalf_max(mx);
            const float ex0 = 8.0f - mx * 1.4426950408889634f;
            float sum = 0.f; long pf8[8];
#pragma unroll
            for (int c = 0; c < 8; ++c) {
                float e[8];
#pragma unroll
                for (int i = 0; i < 4; ++i) { e[i] = __builtin_amdgcn_exp2f(fmaf(lg[2 * c][i], 1.4426950408889634f, ex0)); e[4 + i] = __builtin_amdgcn_exp2f(fmaf(lg[2 * c + 1][i], 1.4426950408889634f, ex0)); }
                sum += ((e[0] + e[1]) + (e[2] + e[3])) + ((e[4] + e[5]) + (e[6] + e[7]));
                int plo = 0, phi = 0; plo = __builtin_amdgcn_cvt_pk_fp8_f32(e[0], e[1], plo, false); plo = __builtin_amdgcn_cvt_pk_fp8_f32(e[2], e[3], plo, true);
                phi = __builtin_amdgcn_cvt_pk_fp8_f32(e[4], e[5], phi, false); phi = __builtin_amdgcn_cvt_pk_fp8_f32(e[6], e[7], phi, true);
                pf8[c] = (long)(((unsigned long long)(unsigned)phi << 32) | (unsigned)plo);
            }
            sum += __shfl_xor(sum, 16); sum = xhalf_sum(sum);
            const float inv32 = 32.0f / sum;
            if (more) DSA_KQ_LOAD((qq_ + 1) & 3);
            f32x4 oacc[4];
#pragma unroll
            for (int d = 0; d < 4; ++d) oacc[d] = (f32x4){0.f, 0.f, 0.f, 0.f};
            if (more) asm volatile("s_waitcnt vmcnt(18)" ::: "memory"); else asm volatile("s_waitcnt vmcnt(0)" ::: "memory");
            v2u tv_[8][4];
#pragma unroll
            for (int gc = 0; gc < 8; ++gc)
                asm volatile("ds_read_b64_tr_b8 %0, %4 offset:%8\n\tds_read_b64_tr_b8 %1, %5 offset:%8\n\tds_read_b64_tr_b8 %2, %6 offset:%8\n\tds_read_b64_tr_b8 %3, %7 offset:%8"
                             : "=&v"(tv_[gc][0]), "=&v"(tv_[gc][1]), "=&v"(tv_[gc][2]), "=&v"(tv_[gc][3]) : "v"(vrd[0]), "v"(vrd[1]), "v"(vrd[2]), "v"(vrd[3]), "i"(gc * 2048) : "memory");
            asm volatile("s_waitcnt lgkmcnt(0)" : "+v"(tv_[0][0]), "+v"(tv_[0][1]), "+v"(tv_[0][2]), "+v"(tv_[0][3]), "+v"(tv_[1][0]), "+v"(tv_[1][1]), "+v"(tv_[1][2]), "+v"(tv_[1][3]) :: "memory");
            asm volatile("" : "+v"(tv_[2][0]), "+v"(tv_[2][1]), "+v"(tv_[2][2]), "+v"(tv_[2][3]), "+v"(tv_[3][0]), "+v"(tv_[3][1]), "+v"(tv_[3][2]), "+v"(tv_[3][3]) :: "memory");
            asm volatile("" : "+v"(tv_[4][0]), "+v"(tv_[4][1]), "+v"(tv_[4][2]), "+v"(tv_[4][3]), "+v"(tv_[5][0]), "+v"(tv_[5][1]), "+v"(tv_[5][2]), "+v"(tv_[5][3]) :: "memory");
            asm volatile("" : "+v"(tv_[6][0]), "+v"(tv_[6][1]), "+v"(tv_[6][2]), "+v"(tv_[6][3]), "+v"(tv_[7][0]), "+v"(tv_[7][1]), "+v"(tv_[7][2]), "+v"(tv_[7][3]) :: "memory");
#pragma unroll
            for (int gc = 0; gc < 8; ++gc) { const long pb = pf8[gc];
#pragma unroll
                for (int d = 0; d < 4; ++d) oacc[d] = __builtin_amdgcn_mfma_f32_16x16x32_fp8_fp8((long)(((unsigned long long)tv_[gc][d].y << 32) | tv_[gc][d].x), pb, oacc[d], 0, 0, 0); }
            if (hd < 8) {
#pragma unroll
                for (int d = 0; d < 4; ++d) *(GAS unsigned*)((unsigned char*)OB + tq * 1024 + hd * 64 + 16 * d + 4 * g4) = pk4_fp8(oacc[d][0] * inv32, oacc[d][1] * inv32, oacc[d][2] * inv32, oacc[d][3] * inv32);
            }
        }
#else
        { unsigned keep = 0u;
#if DSA_SKIP == 2
#pragma unroll
          for (int kb = 0; kb < 64; ++kb) keep ^= kA[kb];
          keep ^= (unsigned)(nA + nB);
#endif
          for (int q = 0; q < 4; ++q)
#pragma unroll
              for (int i = 0; i < 8; ++i) *(GAS unsigned short*)(OB + ((size_t)b * SEQ + q0 + q) * 512 + i * 64 + lane) = (unsigned short)((keep == 0x12345u) ? 1u : 0u); }
#endif
    }
}

__device__ __forceinline__ void ln1_phase(Frame& F) {
    constexpr int U = 4;
    const int gw = F.vcu * NWAVES + F.wave, NGW = F.G * NWAVES, lane = F.lane;
    const bf16* Y = WSP(bf16, WS_H);
    f32x4 g[4], bb[4];
#pragma unroll
    for (int j = 0; j < 4; ++j) { g[j] = *((const GAS f32x4*)F.a->in[12] + lane + 64 * j); bb[j] = *((const GAS f32x4*)F.a->in[13] + lane + 64 * j); }
    for (int t0 = gw; t0 < M; t0 += NGW * U) {
        f32x4 v[U][4]; float s[U], s2[U], am[U];
#pragma unroll
        for (int u = 0; u < U; ++u) { const int t = t0 + u * NGW < M ? t0 + u * NGW : t0; const GAS v2u* yr = (const GAS v2u*)(Y + (size_t)t * D) + lane;
#pragma unroll
            for (int j = 0; j < 4; ++j) { const v2u w = yr[64 * j]; v[u][j] = (f32x4){bflo(w.x), bfhi(w.x), bflo(w.y), bfhi(w.y)}; } }
#pragma unroll
        for (int u = 0; u < U; ++u) { s[u] = 0.f;
#pragma unroll
            for (int j = 0; j < 4; ++j) s[u] += (v[u][j][0] + v[u][j][1]) + (v[u][j][2] + v[u][j][3]); }
        wave_sum_n<U>(s);
#pragma unroll
        for (int u = 0; u < U; ++u) { const float mean = s[u] * (1.f / D); s2[u] = 0.f;
#pragma unroll
            for (int j = 0; j < 4; ++j) { v[u][j] = v[u][j] - mean; s2[u] += (v[u][j][0] * v[u][j][0] + v[u][j][1] * v[u][j][1]) + (v[u][j][2] * v[u][j][2] + v[u][j][3] * v[u][j][3]); } }
        wave_sum_n<U>(s2);
#pragma unroll
        for (int u = 0; u < U; ++u) { const float rstd = 1.f / sqrtf(s2[u] * (1.f / D) + LN_EPS); am[u] = 0.f;
#pragma unroll
            for (int j = 0; j < 4; ++j) { v[u][j] = v[u][j] * rstd * g[j] + bb[j]; am[u] = fmaxf(am[u], fmaxf(fmaxf(fabsf(v[u][j][0]), fabsf(v[u][j][1])), fmaxf(fabsf(v[u][j][2]), fabsf(v[u][j][3])))); } }
        wave_max_n<U>(am);
#pragma unroll
        for (int u = 0; u < U; ++u) { const int t = t0 + u * NGW; if (t < M) {
            const float xm = am[u] > 0.f ? am[u] * 1.01f : 1.0f, isq = 119.0f / xm;
#pragma unroll
            for (int j = 0; j < 4; ++j) {
                unsigned q4 = 0u;
#pragma unroll
                for (int i = 0; i < 4; ++i) { float q = rintf(v[u][j][i] * isq); q = fminf(fmaxf(q, -119.f), 119.f); q4 |= ((unsigned)(int)q & 0xffu) << (8 * i); }
                *((GAS unsigned*)(F.ws + WS_X1Q + (size_t)t * D) + lane + 64 * j) = q4; }
            if (lane == 0) WSP(float, WS_SX)[t] = xm * (1.0f / 119.0f); } }
    }
}

template <int OFF> __device__ __forceinline__ void sort16_desc(float (&x)[64]) {
#define S16_CE(i, j) { const float hi_ = fmaxf(x[OFF + (i)], x[OFF + (j)]), lo_ = fminf(x[OFF + (i)], x[OFF + (j)]); x[OFF + (i)] = hi_; x[OFF + (j)] = lo_; }
    S16_CE(0, 13) S16_CE(1, 12) S16_CE(2, 15) S16_CE(3, 14) S16_CE(4, 8) S16_CE(5, 6) S16_CE(7, 11) S16_CE(9, 10)
    S16_CE(0, 5) S16_CE(1, 7) S16_CE(2, 9) S16_CE(3, 4) S16_CE(6, 13) S16_CE(8, 14) S16_CE(10, 15) S16_CE(11, 12)
    S16_CE(0, 1) S16_CE(2, 3) S16_CE(4, 5) S16_CE(6, 8) S16_CE(7, 9) S16_CE(10, 11) S16_CE(12, 13) S16_CE(14, 15)
    S16_CE(0, 2) S16_CE(1, 3) S16_CE(4, 10) S16_CE(5, 11) S16_CE(6, 7) S16_CE(8, 9) S16_CE(12, 14) S16_CE(13, 15)
    S16_CE(1, 2) S16_CE(3, 12) S16_CE(4, 6) S16_CE(5, 7) S16_CE(8, 10) S16_CE(9, 11) S16_CE(13, 14)
    S16_CE(1, 4) S16_CE(2, 6) S16_CE(5, 8) S16_CE(7, 10) S16_CE(9, 13) S16_CE(11, 14)
    S16_CE(2, 4) S16_CE(3, 6) S16_CE(9, 12) S16_CE(11, 13)
    S16_CE(3, 5) S16_CE(6, 8) S16_CE(7, 9) S16_CE(10, 12)
    S16_CE(3, 4) S16_CE(5, 6) S16_CE(7, 8) S16_CE(9, 10) S16_CE(11, 12)
    S16_CE(6, 7) S16_CE(8, 9)
#undef S16_CE
}
template <int OFF> __device__ __forceinline__ void bitonic_merge16_desc(float (&x)[64]) {
#pragma unroll
    for (int j = 8; j > 0; j >>= 1)
#pragma unroll
        for (int i = 0; i < 16; ++i) { const int l = i ^ j; if (l > i) { const float hi = fmaxf(x[OFF + i], x[OFF + l]), lo = fminf(x[OFF + i], x[OFF + l]); x[OFF + i] = hi; x[OFF + l] = lo; } }
}
template <int OFF, int OFFB> __device__ __forceinline__ void merge_top16(float (&x)[64]) {
#pragma unroll
    for (int i = 0; i < 16; ++i) x[OFF + i] = fmaxf(x[OFF + i], x[OFFB + 15 - i]);
    bitonic_merge16_desc<OFF>(x);
}
__device__ __forceinline__ void top16_of_64(float (&x)[64]) {
    sort16_desc<0>(x); sort16_desc<16>(x); sort16_desc<32>(x); sort16_desc<48>(x);
    merge_top16<0, 16>(x); merge_top16<32, 48>(x); merge_top16<0, 32>(x);
}
__device__ __forceinline__ void route_phase(Frame& F) {
    const int lane = F.lane, hh = lane >> 5, tl = lane & 31;
    const bf16* QP = (const bf16*)(F.ws + WS_H + 256 * MiB); const bf16* SUBK = WSP(bf16, WS_SUBK);
    unsigned short* EIDX = WSP(unsigned short, WS_Q); bf16* GATE = (bf16*)(F.ws + WS_Q + 32 * MiB);
    LAS float* SCR = (LAS float*)(F.lds + F.wave * 16384);
    LAS unsigned char* TB = F.lds + F.wave * 16384;
    LAS unsigned char* CT = F.lds + 8 * 16384;
    __syncthreads();
    if (F.tid < 64) { const int c = F.tid; int a, bb;
        if (c < 16) { a = 0; bb = c; } else if (c < 24) { a = 1; bb = c - 16; } else if (c < 29) { a = 2; bb = c - 24; } else if (c < 33) { a = 3; bb = c - 29; } else if (c < 36) { a = 4; bb = c - 33; }
        else if (c < 42) { a = 5 + ((c - 36) >> 1); bb = (c - 36) & 1; } else { a = 8 + ((c - 42) & 7); bb = 0; }
        CT[c] = (unsigned char)(a | (bb << 4)); }
    __syncthreads();
    const float NEG_INF = -__builtin_inff();
    const int gw = F.vcu * NWAVES + F.wave, NGW = F.G * NWAVES;
    for (int wu = gw; wu < M / 32; wu += NGW) {
        const size_t tok = (size_t)wu * 32 + tl;
        const bf16* skp = SUBK + (size_t)tl * 128 + 8 * hh;
        bf16x8 ak[2][8];
#pragma unroll
        for (int s = 0; s < 8; ++s) ak[0][s] = *(const GAS bf16x8*)(skp + 16 * s);
        for (int h2 = 0; h2 < 4; ++h2) {
          for (int hi = 0; hi < 2; ++hi) { const int h = 2 * h2 + hi;
#pragma unroll
            for (int p = 0; p < 2; ++p) {
                const int hp = 2 * h + p;
                bf16x8 bq[8];
#pragma unroll
                for (int s = 0; s < 8; ++s) bq[s] = *(const GAS bf16x8*)(QP + tok * 2048 + hp * 128 + 16 * s + 8 * hh);
                float sc[64];
#pragma unroll
                for (int nb = 0; nb < 4; ++nb) {
                    { const int nidx = 4 * hp + nb + 1; const bf16* nx = skp + (size_t)(nidx < 64 ? nidx : 63) * (32 * 128);
#pragma unroll
                      for (int s = 0; s < 8; ++s) ak[(nb + 1) & 1][s] = *(const GAS bf16x8*)(nx + 16 * s); }
                    f32x16 acc;
#pragma unroll
                    for (int i = 0; i < 16; ++i) acc[i] = 0.f;
#pragma unroll
                    for (int s = 0; s < 8; ++s) acc = MFMA32(ak[nb & 1][s], bq[s], acc);
#pragma unroll
                    for (int v = 0; v < 16; ++v) { const int n = 32 * nb + (v & 3) + 8 * (v >> 2) + 4 * hh; sc[16 * nb + v] = __uint_as_float((__float_as_uint(acc[v]) & ~0x7fu) | (unsigned)n); }
                    asm volatile("" ::: "memory");
                }
                top16_of_64(sc);
                { float pt[16];
#pragma unroll
                  for (int i = 0; i < 16; ++i) pt[i] = __shfl_xor(sc[15 - i], 32);
#pragma unroll
                  for (int i = 0; i < 16; ++i) sc[i] = fmaxf(sc[i], pt[i]); }
                bitonic_merge16_desc<0>(sc);
#pragma unroll
                for (int k = 0; k < 16; ++k) SCR[((hi * 2 + p) * 16 + k) * 64 + lane] = sc[k];
            }
          }
            const int h = 2 * h2 + hh;
            float tv[2][16];
#pragma unroll
            for (int p = 0; p < 2; ++p)
#pragma unroll
                for (int k = 0; k < 16; ++k) tv[p][k] = SCR[((hh * 2 + p) * 16 + k) * 64 + lane];
            asm volatile("s_waitcnt lgkmcnt(0)" ::: "memory");
#pragma unroll
            for (int k = 0; k < 16; ++k) { TB[lane * 32 + k] = (unsigned char)(__float_as_uint(tv[0][k]) & 0x7fu); TB[lane * 32 + 16 + k] = (unsigned char)(__float_as_uint(tv[1][k]) & 0x7fu); }
            float cand[64];
            { int c = 0;
#pragma unroll
              for (int a = 0; a < 16; ++a)
#pragma unroll
                  for (int bb = 0; bb < 16; ++bb) if ((a + 1) * (bb + 1) <= 16) { cand[c] = __uint_as_float((__float_as_uint(tv[0][a] + tv[1][bb]) & ~0x3fu) | (unsigned)c); ++c; }
#pragma unroll
              for (int i = 50; i < 64; ++i) cand[i] = NEG_INF; }
            top16_of_64(cand);
            float top[16]; int eid[16];
            { unsigned abv[16];
#pragma unroll
              for (int k = 0; k < 16; ++k) { top[k] = cand[k]; abv[k] = CT[(int)(__float_as_uint(cand[k]) & 0x3fu)]; }
              __builtin_amdgcn_sched_barrier(0);
              unsigned e1_[16], e2_[16];
#pragma unroll
              for (int k = 0; k < 16; ++k) { e1_[k] = TB[lane * 32 + (abv[k] & 15u)]; e2_[k] = TB[lane * 32 + 16 + (abv[k] >> 4)]; }
              __builtin_amdgcn_sched_barrier(0);
#pragma unroll
              for (int k = 0; k < 16; ++k) eid[k] = (int)(e1_[k] * 128u + e2_[k]); }
            float gs = 0.f, ge[16];
#pragma unroll
            for (int k = 0; k < 16; ++k) { ge[k] = __builtin_amdgcn_exp2f((top[k] - top[0]) * 1.4426950408889634f); gs += ge[k]; }
            const float gi = 1.0f / gs;
            {
                v4u e0, e1;
                e0.x = (unsigned)eid[0] | ((unsigned)eid[1] << 16); e0.y = (unsigned)eid[2] | ((unsigned)eid[3] << 16); e0.z = (unsigned)eid[4] | ((unsigned)eid[5] << 16); e0.w = (unsigned)eid[6] | ((unsigned)eid[7] << 16);
                e1.x = (unsigned)eid[8] | ((unsigned)eid[9] << 16); e1.y = (unsigned)eid[10] | ((unsigned)eid[11] << 16); e1.z = (unsigned)eid[12] | ((unsigned)eid[13] << 16); e1.w = (unsigned)eid[14] | ((unsigned)eid[15] << 16);
                *(GAS v4u*)(EIDX + tok * 128 + h * 16) = e0; *(GAS v4u*)(EIDX + tok * 128 + h * 16 + 8) = e1;
#pragma unroll
                for (int k8 = 0; k8 < 2; ++k8) *(GAS v4u*)(GATE + tok * 128 + h * 16 + 8 * k8) = (v4u){pk2(ge[8 * k8] * gi, ge[8 * k8 + 1] * gi), pk2(ge[8 * k8 + 2] * gi, ge[8 * k8 + 3] * gi), pk2(ge[8 * k8 + 4] * gi, ge[8 * k8 + 5] * gi), pk2(ge[8 * k8 + 6] * gi, ge[8 * k8 + 7] * gi)};
            }
        }
    }
}

__device__ __forceinline__ float gelu_tanh(float x) {
    const float z = 0.7978845608028654f * (x + 0.044715f * x * x * x);
    const float e = __builtin_amdgcn_exp2f(z * 2.8853900817779268f);
    const float th = 1.0f - 2.0f * __builtin_amdgcn_rcpf(e + 1.0f);
    return 0.5f * x * (1.0f + th);
}
#define UB0(w) ((float)((w) & 0xffu))
#define UB1(w) ((float)(((w) >> 8) & 0xffu))
#define UB2(w) ((float)(((w) >> 16) & 0xffu))
#define UB3(w) ((float)((w) >> 24))
struct E1Meta { v4u xa, xb, e0, e1; };
__device__ __forceinline__ void e1_phase(Frame& F) {
    const int lane = F.lane, r = lane & 7, gi = lane >> 3, per = F.G >> 2, shard = F.vcu / (per > 0 ? per : 1) > 3 ? 3 : F.vcu / (per > 0 ? per : 1);
    const int wsh = (F.vcu - shard * per) * NWAVES + F.wave, nwsh = (shard == 3 ? F.G - 3 * per : per) * NWAVES;
    const unsigned char* X1Q = (const unsigned char*)(F.ws + WS_X1Q); const unsigned short* EIDX = WSP(unsigned short, WS_Q);
    const unsigned char* tb = WSP(unsigned char, WS_PU) + (size_t)shard * SHARD_BYTES; const unsigned roff = 16u * (unsigned)r; bf16* PART = WSP(bf16, WS_H) + (size_t)shard * M * 128;
#define E1_META(M_, tt) do { const int t_ = (tt) < M ? (tt) : wsh; \
        M_.xa = *(const GAS v4u*)(X1Q + (size_t)t_ * D + 256 * shard + 32 * r); M_.xb = *(const GAS v4u*)(X1Q + (size_t)t_ * D + 256 * shard + 32 * r + 16); \
        M_.e0 = *(const GAS v4u*)(EIDX + (size_t)t_ * 128 + 16 * gi); M_.e1 = *(const GAS v4u*)(EIDX + (size_t)t_ * 128 + 16 * gi + 8); } while (0)
#define E1_ROWS(UR_, QH_, QL_, M_) do { \
        _Pragma("unroll") for (int i = 0; i < 16; ++i) { const unsigned w_ = i < 8 ? M_.e0[i >> 1] : M_.e1[(i - 8) >> 1]; const unsigned id_ = (i & 1) ? (w_ >> 16) : (w_ & 0xffffu); UR_[i] = *(const GAS v4u*)(tb + (size_t)(id_ * 128u + roff)); } \
        _Pragma("unroll") for (int w = 0; w < 4; ++w) { const unsigned q0_ = w < 2 ? M_.xa[2 * w] : M_.xb[2 * w - 4], q1_ = w < 2 ? M_.xa[2 * w + 1] : M_.xb[2 * w - 3]; \
            const unsigned y0_ = ((q0_ ^ 0x80808080u) + 0x08080808u) ^ 0x80808080u, y1_ = ((q1_ ^ 0x80808080u) + 0x08080808u) ^ 0x80808080u; \
            QH_[w] = ((y0_ >> 4) & 0x0f0f0f0fu) | (y1_ & 0xf0f0f0f0u); QL_[w] = (q0_ & 0x0f0f0f0fu) | ((q1_ << 4) & 0xf0f0f0f0u); } } while (0)
#define E1_XOR(v, o) ((o) == 4 ? dpp_xor4(v) : ((o) == 2 ? dpp_xor2(v) : dpp_xor1(v)))
#define E1_TR(n, o) _Pragma("unroll") for (int i = 0; i < (n); ++i) { const bool up_ = (lane & (o)) != 0; \
            const float k0_ = up_ ? part[i + (n)] : part[i], s0_ = up_ ? part[i] : part[i + (n)], k1_ = up_ ? part[8 + i + (n)] : part[8 + i], s1_ = up_ ? part[8 + i] : part[8 + i + (n)]; \
            part[i] = k0_ + E1_XOR(s0_, (o)); part[8 + i] = k1_ + E1_XOR(s1_, (o)); }
#define E1_COMP(UR_, QH_, QL_, tt) do { if ((tt) < M) { float part[16]; \
        _Pragma("unroll") for (int i = 0; i < 16; ++i) { int sh_ = 0, sl_ = 0; \
            _Pragma("unroll") for (int w = 0; w < 4; ++w) { sh_ = __builtin_amdgcn_sdot8((int)UR_[i][w], (int)QH_[w], sh_, false); sl_ = __builtin_amdgcn_sdot8((int)UR_[i][w], (int)QL_[w], sl_, false); } \
            part[i] = (float)(sh_ * 16 + sl_); } \
        E1_TR(4, 4) E1_TR(2, 2) E1_TR(1, 1) \
        bf16* po_ = PART + (size_t)(tt) * 128 + 16 * gi + r; const unsigned pw_ = pk2(part[0], part[8]); po_[0] = (bf16)(pw_ & 0xffffu); po_[8] = (bf16)(pw_ >> 16); } } while (0)
    E1Meta mA, mB; v4u urA[16], urB[16]; unsigned qhA[4], qlA[4], qhB[4], qlB[4];
    int t = wsh;
    E1_META(mA, t); E1_META(mB, t + nwsh);
    E1_ROWS(urA, qhA, qlA, mA);
    for (; t < M; t += 2 * nwsh) {
        E1_META(mA, t + 2 * nwsh);
        E1_ROWS(urB, qhB, qlB, mB);
        E1_COMP(urA, qhA, qlA, t);
        E1_META(mB, t + 3 * nwsh);
        E1_ROWS(urA, qhA, qlA, mA);
        E1_COMP(urB, qhB, qlB, t + nwsh);
    }
#undef E1_META
#undef E1_ROWS
#undef E1_TR
#undef E1_XOR
#undef E1_COMP
}
__device__ __forceinline__ void er_phase(Frame& F) {
    constexpr int U = 4;
    const int gw = F.vcu * NWAVES + F.wave, NGW = F.G * NWAVES, lane = F.lane;
    const unsigned short* EIDX = WSP(unsigned short, WS_Q); const bf16* GATE = (const bf16*)(F.ws + WS_Q + 32 * MiB); unsigned char* COEF8 = (unsigned char*)(F.ws + WS_Q + 64 * MiB);
    const bf16* PART = WSP(bf16, WS_H); const float* SU = WSP(float, WS_SU); const float* SV = WSP(float, WS_SV); const float* SX = WSP(float, WS_SX);
    for (int t0 = gw; t0 < M; t0 += NGW * U) {
        float sacc[U][2], gt[U][2]; int ee[U][2];
#pragma unroll
        for (int u = 0; u < U; ++u) { const int t = t0 + u * NGW < M ? t0 + u * NGW : t0;
#pragma unroll
            for (int hs = 0; hs < 2; ++hs) { const int slot = lane + 64 * hs; float a = 0.f;
#pragma unroll
                for (int sh = 0; sh < 4; ++sh) a += bf1(PART[((size_t)sh * M + t) * 128 + slot]);
                sacc[u][hs] = a; ee[u][hs] = (int)EIDX[(size_t)t * 128 + slot]; gt[u][hs] = bf1(GATE[(size_t)t * 128 + slot]); } }
#pragma unroll
        for (int u = 0; u < U; ++u) { const int t = t0 + u * NGW < M ? t0 + u * NGW : t0; const float step0 = SX[t];
#pragma unroll
            for (int hs = 0; hs < 2; ++hs) { const float c = gt[u][hs] * gelu_tanh(SU[ee[u][hs]] * step0 * sacc[u][hs]) * SV[ee[u][hs]]; sacc[u][hs] = c; } }
#pragma unroll
        for (int u = 0; u < U; ++u) { const int t = t0 + u * NGW; if (t < M) {
#pragma unroll
            for (int hs = 0; hs < 2; ++hs) { const int k = 8 * (lane & 15) + (lane >> 4) + 4 * hs; const float cs = fminf(fmaxf(64.0f * sacc[u][hs], -448.f), 448.f);
                const int hi = __builtin_amdgcn_cvt_pk_fp8_f32(cs, 0.f, 0, false); const float rlo = 16.0f * (cs - __builtin_amdgcn_cvt_f32_fp8(hi, 0)); const int lo = __builtin_amdgcn_cvt_pk_fp8_f32(rlo, 0.f, 0, false);
                COEF8[(size_t)t * 256 + k] = (unsigned char)(hi & 0xff); COEF8[(size_t)t * 256 + 128 + k] = (unsigned char)(lo & 0xff); } } }
    }
}
struct E2Idx { v4u e0, e1; };
__device__ __forceinline__ void e2_phase(Frame& F) {
    typedef int i32x8 __attribute__((ext_vector_type(8))); typedef float f32x2s __attribute__((ext_vector_type(2)));
    const int lane = F.lane, g = lane >> 3, r = lane & 15, kb = lane >> 4, per = F.G >> 2, shard = F.vcu / (per > 0 ? per : 1) > 3 ? 3 : F.vcu / (per > 0 ? per : 1);
    const int wsh = (F.vcu - shard * per) * NWAVES + F.wave, nwsh = (shard == 3 ? F.G - 3 * per : per) * NWAVES;
    const unsigned char* X1Q = (const unsigned char*)(F.ws + WS_X1Q); const float* SX = WSP(float, WS_SX); const unsigned short* EIDX = WSP(unsigned short, WS_Q); const unsigned char* COEF8 = (const unsigned char*)(F.ws + WS_Q + 64 * MiB);
    const unsigned char* tb = WSP(unsigned char, WS_PV) + (size_t)shard * SHARD_BYTES; bf16* Y2 = (bf16*)(F.ws + WS_H + 256 * MiB);
    LAS unsigned char* LB = F.lds + F.wave * 16384;
    const unsigned roff = (unsigned)(((lane & 7) ^ g) << 4);
    const unsigned rdbase = (unsigned)(size_t)LB + (unsigned)((32 * kb + r) * 128);
    __syncthreads();
#define E2_IDX(E_, tt) do { const int t_ = (tt) < M ? (tt) : wsh; \
        E_.e0 = *(const GAS v4u*)(EIDX + (size_t)t_ * 128 + 16 * g); E_.e1 = *(const GAS v4u*)(EIDX + (size_t)t_ * 128 + 16 * g + 8); } while (0)
#define E2_GATHER(E_) do { _Pragma("unroll") for (int j = 0; j < 16; ++j) { const unsigned w_ = j < 8 ? E_.e0[j >> 1] : E_.e1[(j - 8) >> 1]; const unsigned id_ = (j & 1) ? (w_ >> 16) : (w_ & 0xffffu); \
            __builtin_amdgcn_global_load_lds((const unsigned*)(tb + (size_t)(id_ * 128u + roff)), (LAS unsigned*)(LB + j * 1024), 16, 0, 0); } } while (0)
#define E2_UNIT(ECUR_, ENXT_, tt) do { const int t_ = (tt) < M ? (tt) : wsh;     \
        v4u a0_ = (v4u){0u, 0u, 0u, 0u}, a1_ = a0_, xq_ = a0_; float sx_ = 0.f; \
        if (r < 2) { \
            if (E2_ALAY == 1) { a0_ = *(const GAS v4u*)(COEF8 + (size_t)t_ * 256 + r * 128 + 16 * kb); a1_ = *(const GAS v4u*)(COEF8 + (size_t)t_ * 256 + r * 128 + 64 + 16 * kb); }     \
            else if (E2_ALAY == 2) { const v2u p0_ = *(const GAS v2u*)(COEF8 + (size_t)t_ * 256 + r * 128 + 8 * kb), p1_ = *(const GAS v2u*)(COEF8 + (size_t)t_ * 256 + r * 128 + 32 + 8 * kb), p2_ = *(const GAS v2u*)(COEF8 + (size_t)t_ * 256 + r * 128 + 64 + 8 * kb), p3_ = *(const GAS v2u*)(COEF8 + (size_t)t_ * 256 + r * 128 + 96 + 8 * kb); \
                a0_ = (v4u){p0_.x, p0_.y, p1_.x, p1_.y}; a1_ = (v4u){p2_.x, p2_.y, p3_.x, p3_.y}; }     \
            else { a0_ = *(const GAS v4u*)(COEF8 + (size_t)t_ * 256 + r * 128 + 32 * kb); a1_ = *(const GAS v4u*)(COEF8 + (size_t)t_ * 256 + r * 128 + 32 * kb + 16); } } \
        if (lane < 16) { xq_ = *(const GAS v4u*)(X1Q + (size_t)t_ * D + 256 * shard + 16 * lane); sx_ = ALPHA * SX[t_]; }     \
        asm volatile("s_waitcnt vmcnt(0)" ::: "memory");                  \
        v2u bq_[16][2]; \
        _Pragma("unroll") for (int q = 0; q < 8; ++q) { const unsigned ad_ = rdbase + (unsigned)((q ^ (r & 7)) << 4); \
            asm volatile("ds_read_b64_tr_b4 %0, %4\n\tds_read_b64_tr_b4 %1, %4 offset:2048\n\tds_read_b64_tr_b4 %2, %4 offset:8\n\tds_read_b64_tr_b4 %3, %4 offset:2056" \
                         : "=&v"(bq_[2 * q][0]), "=&v"(bq_[2 * q][1]), "=&v"(bq_[2 * q + 1][0]), "=&v"(bq_[2 * q + 1][1]) : "v"(ad_) : "memory"); } \
        asm volatile("s_waitcnt lgkmcnt(0)" : "+v"(bq_[0][0]), "+v"(bq_[0][1]), "+v"(bq_[1][0]), "+v"(bq_[1][1]), "+v"(bq_[2][0]), "+v"(bq_[2][1]), "+v"(bq_[3][0]), "+v"(bq_[3][1]) :: "memory");     \
        asm volatile("" : "+v"(bq_[4][0]), "+v"(bq_[4][1]), "+v"(bq_[5][0]), "+v"(bq_[5][1]), "+v"(bq_[6][0]), "+v"(bq_[6][1]), "+v"(bq_[7][0]), "+v"(bq_[7][1]) :: "memory"); \
        asm volatile("" : "+v"(bq_[8][0]), "+v"(bq_[8][1]), "+v"(bq_[9][0]), "+v"(bq_[9][1]), "+v"(bq_[10][0]), "+v"(bq_[10][1]), "+v"(bq_[11][0]), "+v"(bq_[11][1]) :: "memory"); \
        asm volatile("" : "+v"(bq_[12][0]), "+v"(bq_[12][1]), "+v"(bq_[13][0]), "+v"(bq_[13][1]), "+v"(bq_[14][0]), "+v"(bq_[14][1]), "+v"(bq_[15][0]), "+v"(bq_[15][1]) :: "memory"); \
        E2_GATHER(ENXT_);                                                \
        E2_IDX(ECUR_, (tt) + 2 * nwsh); \
        const i32x8 a8_ = (i32x8){(int)a0_.x, (int)a0_.y, (int)a0_.z, (int)a0_.w, (int)a1_.x, (int)a1_.y, (int)a1_.z, (int)a1_.w}; float val_[16]; \
        _Pragma("unroll") for (int nb = 0; nb < 16; ++nb) { const i32x8 b8_ = (i32x8){(int)bq_[nb][0].x, (int)bq_[nb][0].y, (int)bq_[nb][1].x, (int)bq_[nb][1].y, 0, 0, 0, 0}; \
            const f32x4 d_ = __builtin_amdgcn_mfma_scale_f32_16x16x128_f8f6f4(a8_, b8_, (f32x4){0.f, 0.f, 0.f, 0.f}, 0  , 4  , 0, 0, 0, 0); \
            val_[nb] = (d_[0] + d_[1] * 0.0625f) * (1.0f / 64.0f); } \
        if (lane < 16) { v4u o0_, o1_; float xr_[16]; \
            _Pragma("unroll") for (int i = 0; i < 16; ++i) xr_[i] = sx_ * (float)(((int)(xq_[i >> 2] << (24 - 8 * (i & 3)))) >> 24); \
            o0_.x = pk2(xr_[0] + val_[0], xr_[1] + val_[1]); o0_.y = pk2(xr_[2] + val_[2], xr_[3] + val_[3]); o0_.z = pk2(xr_[4] + val_[4], xr_[5] + val_[5]); o0_.w = pk2(xr_[6] + val_[6], xr_[7] + val_[7]); \
            o1_.x = pk2(xr_[8] + val_[8], xr_[9] + val_[9]); o1_.y = pk2(xr_[10] + val_[10], xr_[11] + val_[11]); o1_.z = pk2(xr_[12] + val_[12], xr_[13] + val_[13]); o1_.w = pk2(xr_[14] + val_[14], xr_[15] + val_[15]); \
            *(GAS v4u*)(Y2 + (size_t)t_ * D + 256 * shard + 16 * lane) = o0_; *(GAS v4u*)(Y2 + (size_t)t_ * D + 256 * shard + 16 * lane + 8) = o1_; } } while (0)
    E2Idx eA, eB;
    int t = wsh;
    E2_IDX(eA, t); E2_IDX(eB, t + nwsh);
    E2_GATHER(eA);
    for (; t < M; t += 2 * nwsh) {
        E2_UNIT(eA, eB, t);
        E2_UNIT(eB, eA, t + nwsh);
    }
    asm volatile("s_waitcnt vmcnt(0)" ::: "memory");
    __syncthreads();
#undef E2_IDX
#undef E2_GATHER
#undef E2_UNIT
}
__device__ __forceinline__ void ln2_phase(Frame& F) {
    constexpr int U = 4;
    const int gw = F.vcu * NWAVES + F.wave, NGW = F.G * NWAVES, lane = F.lane;
    const bf16* Y = (const bf16*)(F.ws + WS_H + 256 * MiB);
    f32x4 g[4], bb[4];
#pragma unroll
    for (int j = 0; j < 4; ++j) { g[j] = *((const GAS f32x4*)F.a->in[18] + lane + 64 * j); bb[j] = *((const GAS f32x4*)F.a->in[19] + lane + 64 * j); }
    for (int t0 = gw; t0 < M; t0 += NGW * U) {
        f32x4 v[U][4]; float s[U], s2[U];
#pragma unroll
        for (int u = 0; u < U; ++u) { const int t = t0 + u * NGW < M ? t0 + u * NGW : t0; const GAS v2u* yr = (const GAS v2u*)(Y + (size_t)t * D) + lane;
#pragma unroll
            for (int j = 0; j < 4; ++j) { const v2u w = yr[64 * j]; v[u][j] = (f32x4){bflo(w.x), bfhi(w.x), bflo(w.y), bfhi(w.y)}; } }
#pragma unroll
        for (int u = 0; u < U; ++u) { s[u] = 0.f;
#pragma unroll
            for (int j = 0; j < 4; ++j) s[u] += (v[u][j][0] + v[u][j][1]) + (v[u][j][2] + v[u][j][3]); }
        wave_sum_n<U>(s);
#pragma unroll
        for (int u = 0; u < U; ++u) { const float mean = s[u] * (1.f / D); s2[u] = 0.f;
#pragma unroll
            for (int j = 0; j < 4; ++j) { v[u][j] = v[u][j] - mean; s2[u] += (v[u][j][0] * v[u][j][0] + v[u][j][1] * v[u][j][1]) + (v[u][j][2] * v[u][j][2] + v[u][j][3] * v[u][j][3]); } }
        wave_sum_n<U>(s2);
#pragma unroll
        for (int u = 0; u < U; ++u) { const int t = t0 + u * NGW; const float rstd = 1.f / sqrtf(s2[u] * (1.f / D) + LN_EPS); if (t < M) {
#pragma unroll
            for (int j = 0; j < 4; ++j) *((GAS f32x4*)(F.out + (size_t)t * D) + lane + 64 * j) = v[u][j] * rstd * g[j] + bb[j]; } }
    }
}

__device__ __forceinline__ void ph1_inproj(Frame& F) {
    pg8::Gemm g{WSP(bf16, WS_XQ), WSP(bf16, WS_WIN_T), M, HW, 512, 512, 512}; pg8::StaticOrder S; S.init(M, HW, F.G, (int)blockIdx.x);
    pg8::EpiI8G E{WSP(bf16, WS_H), HW, WSP(float, WS_SX), WSP(float, WS_SW), WSP(float, WS_BIASP), H_GA, H_GB + 1024, 2048};
    pg8::gemm_phase<pg8::EpiI8G, pg8::StaticOrder, true, true, 1>(F.lds, g, S, E);
}
__device__ __forceinline__ void ph3_up(Frame& F) {
    { pg8::Gemm g{WSP(bf16, WS_XB), WSP(bf16, WS_WQ_T), M, 768, 384, 384, 384}; pg8::StaticOrder S; S.init(M, 768, F.G, (int)blockIdx.x);
      pg8::EpiI8F8 E{WSP(unsigned char, WS_Q), 768, WSP(float, WS_RSQ), WSP(float, WS_SW) + 12288};
      pg8::gemm_phase<pg8::EpiI8F8, pg8::StaticOrder, true, true, 1>(F.lds, g, S, E); }
    __syncthreads();
    { pg8::Gemm g{(const bf16*)((const unsigned char*)WSP(bf16, WS_H) + H_CKV), WSP(bf16, WS_WKV_T), M, 1024, 128, HW, 128};     pg8::StaticOrder S; S.init(M, 1024, F.G, (int)blockIdx.x);
      pg8::EpiScaleF8 E{WSP(unsigned char, WS_KV), 1024, WSP(float, WS_RSKV)};
      pg8::gemm_phase<pg8::EpiScaleF8, pg8::StaticOrder, true, true, 2>(F.lds, g, S, E); }
}
__device__ __forceinline__ void peer_tables_convert(Frame& F) {
    { const int gwq = F.vcu * NWAVES + F.wave, NGWq = F.G * NWAVES, lane = F.lane;
      for (int r = gwq; r < 2 * 16384; r += NGWq) {
          const int tb = r >> 14, row = r & 16383; const float* srow = (tb ? F.a->in[17] : F.a->in[16]) + (size_t)row * 1024;
          float x[16]; float ss = 0.f;
          if (tb) {
#pragma unroll
              for (int n = 0; n < 16; ++n) x[n] = srow[256 * (lane >> 4) + 16 * n + (lane & 15)];
          } else {
#pragma unroll
              for (int j = 0; j < 4; ++j) { const f32x4 v = *(const GAS f32x4*)(srow + 16 * lane + 4 * j); x[4 * j] = v[0]; x[4 * j + 1] = v[1]; x[4 * j + 2] = v[2]; x[4 * j + 3] = v[3]; }
          }
#pragma unroll
          for (int n = 0; n < 16; ++n) ss += x[n] * x[n];
#pragma unroll
          for (int o = 1; o < 64; o <<= 1) ss += __shfl_xor(ss, o);
          const float rms = sqrtf(ss * (1.0f / 1024.0f));
          const float sc = rms > 0.f ? (tb ? rms * (1.0f / 2.1f) : rms * 0.335f) : 1.0f, isc = 1.0f / sc;
          v2u o2;
#pragma unroll
          for (int h = 0; h < 2; ++h) { unsigned w = 0u;
#pragma unroll
              for (int i = 0; i < 8; ++i) { const float xs = x[8 * h + i] * isc; unsigned c; int pos;
                  if (tb) { const float a = fabsf(xs); c = (unsigned)((a > 0.25f) + (a > 0.75f) + (a > 1.25f) + (a > 1.75f) + (a > 2.5f) + (a > 3.5f) + (a > 5.0f)) | (xs < 0.f ? 8u : 0u); pos = 4 * i; }
                  else { float q = rintf(xs); q = fminf(fmaxf(q, -8.f), 7.f); c = (unsigned)(int)q & 0xfu; pos = 8 * (i & 3) + 4 * (i >> 2); }
                  w |= c << pos; }
              if (h == 0) o2.x = w; else o2.y = w; }
          *(GAS v2u*)((unsigned char*)(F.ws + (tb ? WS_PV : WS_PU)) + (size_t)(lane >> 4) * SHARD_BYTES + (size_t)row * 128 + 8 * (lane & 15)) = o2;
          if (lane == 0) ((float*)(F.ws + (tb ? WS_SV : WS_SU)))[row] = sc;
      } }
}
__device__ __forceinline__ void ph4_attn(Frame& F) {
#if !EXP_NOMIX && !EXP_NOMLA
    if ((PHASE_MASK >> 17) & 1) { mla_phase(F); int t_ = threadIdx.x; asm volatile("" : "+v"(t_)); F.tid = t_; F.lane = t_ & 63; }
#endif
#if !EXP_NOMIX && !EXP_NODSA
    if ((PHASE_MASK >> 16) & 1) dsa_phase(F);
#endif
    peer_tables_convert(F);
}
__device__ __forceinline__ void ph5_merge(Frame& F) {
#if EXP_NOMIX
    { const size_t gtid = (size_t)F.vcu * (NWAVES * 64) + F.tid, NT = (size_t)F.G * (NWAVES * 64); for (size_t i = gtid; i < (size_t)M * 1024 / 8; i += NT) *(GAS v4u*)(WSP(bf16, WS_Q) + 8 * i) = (v4u){0u, 0u, 0u, 0u}; }
#else
    { pg8::Gemm g{WSP(bf16, WS_XB), WSP(bf16, WS_WOA_T), M, 1024, 512, 512, 512}; pg8::StaticOrder S; S.init(M, 1024, F.G, (int)blockIdx.x);
      pg8::EpiGate2 E{(unsigned char*)(F.ws + WS_Q), 1024, (const unsigned char*)(WSP(bf16, WS_H) + H_GA), 2 * HW, 1.0f / 8192.0f};
      pg8::gemm_phase<pg8::EpiGate2, pg8::StaticOrder, true, true, 2>(F.lds, g, S, E); }
#endif
}
__device__ __forceinline__ void ph6_out(Frame& F) {
    pg8::Gemm g{(const bf16*)(F.ws + WS_Q), WSP(bf16, WS_WOUT_T), M, 1024, 512, 512, 512}; pg8::StaticOrder S; S.init(M, 1024, F.G, (int)blockIdx.x);
    pg8::EpiResF32 E{WSP(bf16, WS_H), F.a->in[0], 1024, ALPHA, 1.0f / 8192.0f};
    pg8::gemm_phase<pg8::EpiResF32, pg8::StaticOrder, true, true, 2>(F.lds, g, S, E);
}
__device__ __forceinline__ void ph8_peerq(Frame& F) {
    pg8::Gemm g{WSP(bf16, WS_X1Q), WSP(bf16, WS_WPQ_T), M, 2048, 512, 512, 512}; pg8::StaticOrder S; S.init(M, 2048, F.G, (int)blockIdx.x);
    pg8::EpiI8 E{(bf16*)(F.ws + WS_H + 256 * MiB), 2048, WSP(float, WS_SX), WSP(float, WS_SW) + 8192, nullptr};
    pg8::gemm_phase<pg8::EpiI8, pg8::StaticOrder, true, true, 1>(F.lds, g, S, E);
}

__global__ void __launch_bounds__(NWAVES * 64, 2) fwd_kernel(Args args) {
    extern __shared__ __attribute__((aligned(16))) unsigned char lds[];
    Frame F;
    F.lds = (LAS unsigned char*)lds;
    F.tid = threadIdx.x; F.lane = F.tid & 63; F.wave = __builtin_amdgcn_readfirstlane(F.tid >> 6);
    F.G = gridDim.x; { const int bx = blockIdx.x; F.vcu = (F.G % 8 == 0) ? (bx % 8) * (F.G / 8) + bx / 8 : bx; }
    F.a = &args; F.pos = (const int*)args.in[1]; F.out = args.out; F.ws = args.ws;
    volatile LAS unsigned* MISC = (volatile LAS unsigned*)(F.lds + MISC_OFF);
    if (F.tid < 32) MISC[F.tid] = 0u;
    __syncthreads();
    XcdBarrier bar = xcd_barrier_post((unsigned*)(F.ws + WS_CTL) + CW_BAR, MISC + 8);
    const int lo = args.ph_lo, hi = args.ph_hi;
#define IN(k) (lo <= (k) && (k) < hi && ((PHASE_MASK >> (k)) & 1))
#define SEAM(k) do { if (IN(k) && IN((k) + 1)) xcd_barrier(bar); } while (0)

#define RUNPH(k, call) do { if (IN(k)) { call; if ((REPEAT_MASK >> (k)) & 1) { xcd_barrier(bar); call; } } } while (0)
    RUNPH(0, p0_prologue(F)); SEAM(0);
    RUNPH(1, ph1_inproj(F)); SEAM(1);
    RUNPH(2, p2_small(F)); SEAM(2);
    RUNPH(3, ph3_up(F)); SEAM(3);
    RUNPH(4, ph4_attn(F)); SEAM(4);
    RUNPH(5, ph5_merge(F)); SEAM(5);
    RUNPH(6, ph6_out(F)); SEAM(6);
    RUNPH(7, ln1_phase(F)); SEAM(7);
    RUNPH(8, ph8_peerq(F)); SEAM(8);
    RUNPH(9, route_phase(F)); SEAM(9);
    RUNPH(10, e1_phase(F)); SEAM(10);
    RUNPH(11, er_phase(F)); SEAM(11);
    RUNPH(12, e2_phase(F)); SEAM(12);
    RUNPH(13, ln2_phase(F));
#undef RUNPH
#undef IN
#undef SEAM
}

extern "C" void kernel_launch(void* const* d_in, const int* in_sizes, int n_in, void* d_out, int out_size, void* d_ws, size_t ws_size, hipStream_t stream) {
    static int grid = 0;
    if (grid == 0) {
        if (n_in != 20 || out_size != M * D || ws_size < WS_END) { fprintf(stderr, "kernel_launch: unexpected shapes (n_in %d out %d ws %zu)\n", n_in, out_size, ws_size); grid = -1; return; }
        int dev = 0, cus = 0, per_cu = 0;
        if (hipGetDevice(&dev) != hipSuccess || hipDeviceGetAttribute(&cus, hipDeviceAttributeMultiprocessorCount, dev) != hipSuccess) { grid = -1; return; }
        if (hipFuncSetAttribute((const void*)fwd_kernel, hipFuncAttributeMaxDynamicSharedMemorySize, LDS_BYTES) != hipSuccess) { grid = -1; return; }
        if (hipOccupancyMaxActiveBlocksPerMultiprocessor(&per_cu, (const void*)fwd_kernel, NWAVES * 64, LDS_BYTES) != hipSuccess || per_cu < 1) { fprintf(stderr, "kernel_launch: occupancy query says %d\n", per_cu); }
        (void)hipGetLastError();
        grid = cus;
    }
    if (grid < 0) return;
    (void)hipMemsetAsync((char*)d_ws + WS_CTL, 0, CTL_ZERO_BYTES, stream);
    Args a{};
    for (int i = 0; i < 20; ++i) a.in[i] = (const float*)d_in[i];
    a.out = (float*)d_out; a.ws = (unsigned char*)d_ws; a.ph_lo = 0; a.ph_hi = NPHASES;
    hipLaunchKernelGGL(fwd_kernel, dim3(grid), dim3(NWAVES * 64), LDS_BYTES, stream, a);
}
```

```cpp
#include <hip/hip_runtime.h>
#include <cstdio>
#include <cstdint>
namespace pg8 {
#define PG8_LAS __attribute__((address_space(3)))
typedef unsigned short bf16_t;
typedef short bf16x8 __attribute__((ext_vector_type(8)));
typedef float f32x4 __attribute__((ext_vector_type(4)));
typedef unsigned u32x4 __attribute__((ext_vector_type(4)));
constexpr int BM = 256, BK = 64, HALF = 128, HTB = HALF * BK * 2  , STAGE_BYTES = 8 * HTB, NXCD = 8, WGM = 8;

__host__ __device__ __forceinline__ int lds_byte(int r, int c) { const int st = (r >> 4) * 2 + (c >> 5), rr = r & 15, cc = c & 31, ob = rr * 64 + cc * 2; return st * 1024 + (ob ^ (((ob >> 9) & 1) << 5)); }
__host__ __device__ __forceinline__ void stage_rc(int b, int& R, int& C) { const int st = b / 1024, sb = b % 1024, swz = sb ^ (((sb >> 9) & 1) << 5); R = (st >> 1) * 16 + swz / 64; C = (st & 1) * 32 + (swz % 64) / 2; }
__host__ __device__ __forceinline__ int perm32(int rho) { const int n = rho >> 4, i = rho & 15; return 8 * (i >> 2) + 4 * n + (i & 3); }

struct Unit { int pm, pn; };
struct Gemm { const bf16_t* A; const bf16_t* Bt; int M, N, K, lda, ldb; };

struct StaticOrder {
    int nM, nN, nwg, G, c;
    __host__ __device__ void init(int M, int N, int G_, int c_) { nM = M / BM; nN = N / BM; nwg = nM * nN; G = G_; c = c_; }
    __host__ __device__ bool next(int i, Unit& u) const {
        const long L = (long)i * G + c; if (L >= nwg) return false;
        int wgid = (int)L; { const int q = nwg / NXCD, r = nwg % NXCD, xcd = wgid % NXCD, off = wgid / NXCD; wgid = (xcd < r ? xcd * (q + 1) : r * (q + 1) + (xcd - r) * q) + off; }
        const int nig = WGM * nN, gid = wgid / nig, fm = gid * WGM, gsz = (nM - fm) < WGM ? (nM - fm) : WGM;
        u.pm = fm + ((wgid % nig) % gsz); u.pn = (wgid % nig) / gsz; return true;
    }
    __device__ __forceinline__ void a_ready(const Unit&) const {}
    __device__ __forceinline__ void done(const Unit&) const {}
};
__device__ __forceinline__ unsigned cvt_pk_bf16(float lo, float hi) { unsigned r; asm volatile("v_cvt_pk_bf16_f32 %0, %1, %2" : "=v"(r) : "v"(lo), "v"(hi)); return r; }
__device__ __forceinline__ float bflo(unsigned w) { return __uint_as_float(w << 16); }
__device__ __forceinline__ float bfhi(unsigned w) { return __uint_as_float(w & 0xffff0000u); }
typedef int i32x4 __attribute__((ext_vector_type(4)));
struct EpiBf16 { typedef f32x4 AccT;
    static constexpr bool PERM = true, AFTER_DRAIN = false, HAS_MID = false;
    bf16_t* O; int ldc; const float* bias;
    __device__ __forceinline__ void operator()(const f32x4 (&acc)[2][2][4][2], const Unit& u, int wr, int wc, int fr, int fq) const {
        const int row0 = u.pm * BM + wr * 64 + fr, col0 = u.pn * BM + wc * 32 + 8 * fq;
        f32x4 bv[2][2];
#pragma unroll
        for (int bj = 0; bj < 2; ++bj)
#pragma unroll
            for (int n = 0; n < 2; ++n) bv[bj][n] = bias ? *(const f32x4*)(bias + col0 + bj * HALF + 4 * n) : (f32x4){0.f, 0.f, 0.f, 0.f};
#pragma unroll
        for (int ai = 0; ai < 2; ++ai)
#pragma unroll
            for (int m = 0; m < 4; ++m) { bf16_t* rowp = O + (size_t)(row0 + ai * HALF + m * 16) * ldc + col0;
#pragma unroll
                for (int bj = 0; bj < 2; ++bj) { const f32x4 v0 = acc[ai][bj][m][0] + bv[bj][0], v1 = acc[ai][bj][m][1] + bv[bj][1];
                    u32x4 w; w.x = cvt_pk_bf16(v0[0], v0[1]); w.y = cvt_pk_bf16(v0[2], v0[3]); w.z = cvt_pk_bf16(v1[0], v1[1]); w.w = cvt_pk_bf16(v1[2], v1[3]);
                    *(u32x4*)(rowp + bj * HALF) = w; } }
    }
};
struct EpiI8 { typedef i32x4 AccT;
    static constexpr bool PERM = true, AFTER_DRAIN = false, HAS_MID = false;
    bf16_t* O; int ldc; const float* sa; const float* sb; const float* bias;
    __device__ __forceinline__ void operator()(const i32x4 (&acc)[2][2][4][2], const Unit& u, int wr, int wc, int fr, int fq) const {
        const int row0 = u.pm * BM + wr * 64 + fr, col0 = u.pn * BM + wc * 32 + 8 * fq;
        f32x4 bv[2][2], sv[2][2];
#pragma unroll
        for (int bj = 0; bj < 2; ++bj)
#pragma unroll
            for (int n = 0; n < 2; ++n) { bv[bj][n] = bias ? *(const f32x4*)(bias + col0 + bj * HALF + 4 * n) : (f32x4){0.f, 0.f, 0.f, 0.f}; sv[bj][n] = *(const f32x4*)(sb + col0 + bj * HALF + 4 * n); }
#pragma unroll
        for (int ai = 0; ai < 2; ++ai)
#pragma unroll
            for (int m = 0; m < 4; ++m) { const int row = row0 + ai * HALF + m * 16; const float sr = sa[row]; bf16_t* rowp = O + (size_t)row * ldc + col0;
#pragma unroll
                for (int bj = 0; bj < 2; ++bj) { f32x4 v0, v1;
#pragma unroll
                    for (int i = 0; i < 4; ++i) { v0[i] = (float)acc[ai][bj][m][0][i] * (sr * sv[bj][0][i]) + bv[bj][0][i]; v1[i] = (float)acc[ai][bj][m][1][i] * (sr * sv[bj][1][i]) + bv[bj][1][i]; }
                    u32x4 w; w.x = cvt_pk_bf16(v0[0], v0[1]); w.y = cvt_pk_bf16(v0[2], v0[3]); w.z = cvt_pk_bf16(v1[0], v1[1]); w.w = cvt_pk_bf16(v1[2], v1[3]);
                    *(u32x4*)(rowp + bj * HALF) = w; } }
    }
};
struct EpiI8G { typedef i32x4 AccT;
    static constexpr bool PERM = true, AFTER_DRAIN = false, HAS_MID = false;
    bf16_t* O; int ldc; const float* sa; const float* sb; const float* bias; int glo, ghi, f8hi;
    __device__ __forceinline__ void operator()(const i32x4 (&acc)[2][2][4][2], const Unit& u, int wr, int wc, int fr, int fq) const {
        const int row0 = u.pm * BM + wr * 64 + fr, col0 = u.pn * BM + wc * 32 + 8 * fq; const bool gate = (u.pn * BM >= glo) && (u.pn * BM < ghi), f8 = u.pn * BM < f8hi;
        f32x4 bv[2][2], sv[2][2];
#pragma unroll
        for (int bj = 0; bj < 2; ++bj)
#pragma unroll
            for (int n = 0; n < 2; ++n) { bv[bj][n] = *(const f32x4*)(bias + col0 + bj * HALF + 4 * n); sv[bj][n] = *(const f32x4*)(sb + col0 + bj * HALF + 4 * n); }
#pragma unroll
        for (int ai = 0; ai < 2; ++ai)
#pragma unroll
            for (int m = 0; m < 4; ++m) { const int row = row0 + ai * HALF + m * 16; const float sr = sa[row]; bf16_t* rowp = O + (size_t)row * ldc + col0;
                unsigned char* growp = (unsigned char*)(O + (size_t)row * ldc + glo) + (col0 - glo);
#pragma unroll
                for (int bj = 0; bj < 2; ++bj) { f32x4 v0, v1;
#pragma unroll
                    for (int i = 0; i < 4; ++i) { v0[i] = (float)acc[ai][bj][m][0][i] * (sr * sv[bj][0][i]) + bv[bj][0][i]; v1[i] = (float)acc[ai][bj][m][1][i] * (sr * sv[bj][1][i]) + bv[bj][1][i]; }
                    if (gate) { unsigned w4 = 0u;
#pragma unroll
                        for (int i = 0; i < 4; ++i) { const float s0 = 15.0f * __builtin_amdgcn_rcpf(1.0f + __builtin_amdgcn_exp2f(-1.44269504f * v0[i])), s1 = 15.0f * __builtin_amdgcn_rcpf(1.0f + __builtin_amdgcn_exp2f(-1.44269504f * v1[i]));
                            w4 |= ((unsigned)__builtin_rintf(s0) << (4 * i)) | ((unsigned)__builtin_rintf(s1) << (16 + 4 * i)); }
                        *(unsigned*)((unsigned char*)(O + (size_t)row * ldc + glo) + ((col0 - glo + bj * HALF) >> 1)) = w4; }
                    else if (f8) { int w0 = 0, w1 = 0;
#pragma unroll
                        for (int i = 0; i < 4; ++i) { v0[i] = __builtin_fminf(__builtin_fmaxf(v0[i], -448.0f), 448.0f); v1[i] = __builtin_fminf(__builtin_fmaxf(v1[i], -448.0f), 448.0f); }
                        w0 = __builtin_amdgcn_cvt_pk_fp8_f32(v0[0], v0[1], w0, false); w0 = __builtin_amdgcn_cvt_pk_fp8_f32(v0[2], v0[3], w0, true);
                        w1 = __builtin_amdgcn_cvt_pk_fp8_f32(v1[0], v1[1], w1, false); w1 = __builtin_amdgcn_cvt_pk_fp8_f32(v1[2], v1[3], w1, true);
                        typedef unsigned u32x2 __attribute__((ext_vector_type(2))); u32x2 w; w.x = (unsigned)w0; w.y = (unsigned)w1; *(u32x2*)((unsigned char*)(O + (size_t)row * ldc) + col0 + bj * HALF) = w; }
                    else { u32x4 w; w.x = cvt_pk_bf16(v0[0], v0[1]); w.y = cvt_pk_bf16(v0[2], v0[3]); w.z = cvt_pk_bf16(v1[0], v1[1]); w.w = cvt_pk_bf16(v1[2], v1[3]);
                        *(u32x4*)(rowp + bj * HALF) = w; } } }
    }
};
struct EpiI8F8 { typedef i32x4 AccT;
    static constexpr bool PERM = true, AFTER_DRAIN = false, HAS_MID = false;
    unsigned char* O; int ldc; const float* sa; const float* sb;
    __device__ __forceinline__ void operator()(const i32x4 (&acc)[2][2][4][2], const Unit& u, int wr, int wc, int fr, int fq) const {
        const int row0 = u.pm * BM + wr * 64 + fr, col0 = u.pn * BM + wc * 32 + 8 * fq; typedef unsigned u32x2 __attribute__((ext_vector_type(2)));
        f32x4 sv[2][2];
#pragma unroll
        for (int bj = 0; bj < 2; ++bj)
#pragma unroll
            for (int n = 0; n < 2; ++n) sv[bj][n] = *(const f32x4*)(sb + col0 + bj * HALF + 4 * n);
#pragma unroll
        for (int ai = 0; ai < 2; ++ai)
#pragma unroll
            for (int m = 0; m < 4; ++m) { const int row = row0 + ai * HALF + m * 16; const float sr = sa[row];
#pragma unroll
                for (int bj = 0; bj < 2; ++bj) { float v[8];
#pragma unroll
                    for (int i = 0; i < 4; ++i) { v[i] = __builtin_fminf(__builtin_fmaxf((float)acc[ai][bj][m][0][i] * (sr * sv[bj][0][i]), -448.0f), 448.0f); v[4 + i] = __builtin_fminf(__builtin_fmaxf((float)acc[ai][bj][m][1][i] * (sr * sv[bj][1][i]), -448.0f), 448.0f); }
                    int w0 = 0, w1 = 0;
                    w0 = __builtin_amdgcn_cvt_pk_fp8_f32(v[0], v[1], w0, false); w0 = __builtin_amdgcn_cvt_pk_fp8_f32(v[2], v[3], w0, true);
                    w1 = __builtin_amdgcn_cvt_pk_fp8_f32(v[4], v[5], w1, false); w1 = __builtin_amdgcn_cvt_pk_fp8_f32(v[6], v[7], w1, true);
                    u32x2 w; w.x = (unsigned)w0; w.y = (unsigned)w1; *(u32x2*)(O + (unsigned)(row * ldc + col0 + bj * HALF)) = w; } }
    }
};
struct EpiScaleF8 { typedef f32x4 AccT;
    static constexpr bool PERM = true, AFTER_DRAIN = false, HAS_MID = false;
    unsigned char* O; int ldc; const float* rs;
    __device__ __forceinline__ void operator()(const f32x4 (&acc)[2][2][4][2], const Unit& u, int wr, int wc, int fr, int fq) const {
        const int row0 = u.pm * BM + wr * 64 + fr, col0 = u.pn * BM + wc * 32 + 8 * fq; typedef unsigned u32x2 __attribute__((ext_vector_type(2)));
#pragma unroll
        for (int ai = 0; ai < 2; ++ai)
#pragma unroll
            for (int m = 0; m < 4; ++m) { const int row = row0 + ai * HALF + m * 16; const float s = rs[row];
#pragma unroll
                for (int bj = 0; bj < 2; ++bj) { float v[8];
#pragma unroll
                    for (int i = 0; i < 4; ++i) { v[i] = __builtin_fminf(__builtin_fmaxf(acc[ai][bj][m][0][i] * s, -448.0f), 448.0f); v[4 + i] = __builtin_fminf(__builtin_fmaxf(acc[ai][bj][m][1][i] * s, -448.0f), 448.0f); }
                    int w0 = 0, w1 = 0;
                    w0 = __builtin_amdgcn_cvt_pk_fp8_f32(v[0], v[1], w0, false); w0 = __builtin_amdgcn_cvt_pk_fp8_f32(v[2], v[3], w0, true);
                    w1 = __builtin_amdgcn_cvt_pk_fp8_f32(v[4], v[5], w1, false); w1 = __builtin_amdgcn_cvt_pk_fp8_f32(v[6], v[7], w1, true);
                    u32x2 w; w.x = (unsigned)w0; w.y = (unsigned)w1; *(u32x2*)(O + (unsigned)(row * ldc + col0 + bj * HALF)) = w; } }
    }
};
struct EpiScaleRope { typedef f32x4 AccT;
    static constexpr bool PERM = true, AFTER_DRAIN = false, HAS_MID = false;
    bf16_t* O; int ldc; const float* rs; const float* cs; int rope_pn;
    __device__ __forceinline__ void operator()(const f32x4 (&acc)[2][2][4][2], const Unit& u, int wr, int wc, int fr, int fq) const {
        const int row0 = u.pm * BM + wr * 64 + fr, col0 = u.pn * BM + wc * 32 + 8 * fq; const bool rope = (u.pn == rope_pn);
#pragma unroll
        for (int ai = 0; ai < 2; ++ai)
#pragma unroll
            for (int m = 0; m < 4; ++m) { const int row = row0 + ai * HALF + m * 16; const float s = rs[row]; bf16_t* rowp = O + (size_t)row * ldc + col0;
                f32x4 ca = (f32x4){1.f, 0.f, 1.f, 0.f}, cb = ca;
                if (rope) { ca = *(const f32x4*)(cs + (size_t)row * 32 + 8 * fq); cb = *(const f32x4*)(cs + (size_t)row * 32 + 8 * fq + 4); }
#pragma unroll
                for (int bj = 0; bj < 2; ++bj) { const f32x4 a = acc[ai][bj][m][0] * s, b = acc[ai][bj][m][1] * s; f32x4 o0, o1;
                    o0[0] = a[0] * ca[0] - b[0] * ca[1]; o1[0] = b[0] * ca[0] + a[0] * ca[1];
                    o0[1] = a[1] * ca[2] - b[1] * ca[3]; o1[1] = b[1] * ca[2] + a[1] * ca[3];
                    o0[2] = a[2] * cb[0] - b[2] * cb[1]; o1[2] = b[2] * cb[0] + a[2] * cb[1];
                    o0[3] = a[3] * cb[2] - b[3] * cb[3]; o1[3] = b[3] * cb[2] + a[3] * cb[3];
                    u32x4 w; w.x = cvt_pk_bf16(o0[0], o0[1]); w.y = cvt_pk_bf16(o0[2], o0[3]); w.z = cvt_pk_bf16(o1[0], o1[1]); w.w = cvt_pk_bf16(o1[2], o1[3]);
                    *(u32x4*)(rowp + bj * HALF) = w; } }
    }
};
struct EpiScaleRopeI8 { typedef i32x4 AccT;
    static constexpr bool PERM = true, AFTER_DRAIN = false, HAS_MID = false;
    bf16_t* O; int ldc; const float* rs; const float* sb; const float* cs; int rope_pn;
    __device__ __forceinline__ void operator()(const i32x4 (&acc)[2][2][4][2], const Unit& u, int wr, int wc, int fr, int fq) const {
        const int row0 = u.pm * BM + wr * 64 + fr, col0 = u.pn * BM + wc * 32 + 8 * fq; const bool rope = (u.pn == rope_pn);
#pragma unroll
        for (int ai = 0; ai < 2; ++ai)
#pragma unroll
            for (int m = 0; m < 4; ++m) { const int row = row0 + ai * HALF + m * 16; const float s = rs[row]; bf16_t* rowp = O + (size_t)row * ldc + col0;
                f32x4 ca = (f32x4){1.f, 0.f, 1.f, 0.f}, cb = ca;
                if (rope) { ca = *(const f32x4*)(cs + (size_t)row * 32 + 8 * fq); cb = *(const f32x4*)(cs + (size_t)row * 32 + 8 * fq + 4); }
#pragma unroll
                for (int bj = 0; bj < 2; ++bj) { const f32x4 sv0 = *(const f32x4*)(sb + col0 + bj * HALF) * s, sv1 = *(const f32x4*)(sb + col0 + bj * HALF + 4) * s; f32x4 a, b, o0, o1;
#pragma unroll
                    for (int i = 0; i < 4; ++i) { a[i] = (float)acc[ai][bj][m][0][i] * sv0[i]; b[i] = (float)acc[ai][bj][m][1][i] * sv1[i]; }
                    o0[0] = a[0] * ca[0] - b[0] * ca[1]; o1[0] = b[0] * ca[0] + a[0] * ca[1];
                    o0[1] = a[1] * ca[2] - b[1] * ca[3]; o1[1] = b[1] * ca[2] + a[1] * ca[3];
                    o0[2] = a[2] * cb[0] - b[2] * cb[1]; o1[2] = b[2] * cb[0] + a[2] * cb[1];
                    o0[3] = a[3] * cb[2] - b[3] * cb[3]; o1[3] = b[3] * cb[2] + a[3] * cb[3];
                    u32x4 w; w.x = cvt_pk_bf16(o0[0], o0[1]); w.y = cvt_pk_bf16(o0[2], o0[3]); w.z = cvt_pk_bf16(o1[0], o1[1]); w.w = cvt_pk_bf16(o1[2], o1[3]);
                    *(u32x4*)(rowp + bj * HALF) = w; }
                asm volatile("" ::: "memory"); }
    }
};
template <bool OUT8>
struct EpiGate { typedef f32x4 AccT;
    static constexpr bool PERM = true, AFTER_DRAIN = false, HAS_MID = false;
    void* O; int ldc; const unsigned char* G; int ldg; const bf16_t* T; int ldt; float cs;
    __device__ __forceinline__ void operator()(const f32x4 (&acc)[2][2][4][2], const Unit& u, int wr, int wc, int fr, int fq) const {
        const int row0 = u.pm * BM + wr * 64 + fr, col0 = u.pn * BM + wc * 32 + 8 * fq; const float gs = cs * (1.0f / 255.0f);
        typedef unsigned u32x2 __attribute__((ext_vector_type(2)));
#pragma unroll
        for (int ai = 0; ai < 2; ++ai)
#pragma unroll
            for (int m = 0; m < 4; ++m) { const int row = row0 + ai * HALF + m * 16;
#pragma unroll
                for (int bj = 0; bj < 2; ++bj) { const int col = col0 + bj * HALF;
                    const u32x2 g = *(const u32x2*)(G + (size_t)row * ldg + col); u32x4 t = (u32x4){0u, 0u, 0u, 0u}; if (T) t = *(const u32x4*)(T + (size_t)row * ldt + col);
                    const f32x4 a = acc[ai][bj][m][0], b = acc[ai][bj][m][1];
                    float gv[8] = {(float)(g.x & 0xffu), (float)((g.x >> 8) & 0xffu), (float)((g.x >> 16) & 0xffu), (float)(g.x >> 24), (float)(g.y & 0xffu), (float)((g.y >> 8) & 0xffu), (float)((g.y >> 16) & 0xffu), (float)(g.y >> 24)};
                    float tv[8] = {bflo(t.x), bfhi(t.x), bflo(t.y), bfhi(t.y), bflo(t.z), bfhi(t.z), bflo(t.w), bfhi(t.w)}; float o[8];
#pragma unroll
                    for (int i = 0; i < 8; ++i) o[i] = tv[i] + (gv[i] * gs) * (i < 4 ? a[i & 3] : b[i & 3]);
                    if constexpr (OUT8) { int w0 = 0, w1 = 0;
#pragma unroll
                        for (int i = 0; i < 8; ++i) o[i] = __builtin_fminf(__builtin_fmaxf(o[i] * 32.0f, -448.0f), 448.0f);
                        w0 = __builtin_amdgcn_cvt_pk_fp8_f32(o[0], o[1], w0, false); w0 = __builtin_amdgcn_cvt_pk_fp8_f32(o[2], o[3], w0, true);
                        w1 = __builtin_amdgcn_cvt_pk_fp8_f32(o[4], o[5], w1, false); w1 = __builtin_amdgcn_cvt_pk_fp8_f32(o[6], o[7], w1, true);
                        u32x2 w; w.x = (unsigned)w0; w.y = (unsigned)w1; *(u32x2*)((unsigned char*)O + (size_t)row * ldc + col) = w; }
                    else { u32x4 w; w.x = cvt_pk_bf16(o[0], o[1]); w.y = cvt_pk_bf16(o[2], o[3]); w.z = cvt_pk_bf16(o[4], o[5]); w.w = cvt_pk_bf16(o[6], o[7]);
                        *(u32x4*)((bf16_t*)O + (size_t)row * ldc + col) = w; } } }
    }
};
struct EpiGate2 { typedef f32x4 AccT;
    static constexpr bool PERM = true, AFTER_DRAIN = false, HAS_MID = true;
    unsigned char* O; int ldc; const unsigned char* G; int ldg; float cs;
    typedef unsigned u32x2 __attribute__((ext_vector_type(2)));
    __device__ __forceinline__ void mid(f32x4 (&acc)[2][2][4][2], const Unit& u, int wr, int wc, int fr, int fq) const {
        asm volatile("" : "+v"(fr), "+v"(fq));
        const int row0 = u.pm * BM + wr * 64 + fr, col0 = u.pn * BM + wc * 32 + 8 * fq;
#pragma unroll
        for (int ai = 0; ai < 2; ++ai)
#pragma unroll
            for (int m = 0; m < 4; ++m) { const int row = row0 + ai * HALF + m * 16;
#pragma unroll
                for (int bj = 0; bj < 2; ++bj) { const int col = col0 + bj * HALF;
                    const unsigned go = (unsigned)(row * ldg + (col >> 1)); const unsigned ga = *(const unsigned*)(G + go), gb = *(const unsigned*)(G + go + 512u);
#pragma unroll
                    for (int i = 0; i < 4; ++i) { const float a0 = (float)((ga >> (4 * i)) & 0xfu), a1 = (float)((ga >> (16 + 4 * i)) & 0xfu);
                        const float b0 = __builtin_fmaxf((float)((gb >> (4 * i)) & 0xfu), 1.0f), b1 = __builtin_fmaxf((float)((gb >> (16 + 4 * i)) & 0xfu), 1.0f);
                        acc[ai][bj][m][0][i] *= a0 * __builtin_amdgcn_rcpf(b0); acc[ai][bj][m][1][i] *= a1 * __builtin_amdgcn_rcpf(b1); } }
                asm volatile("" ::: "memory"); }
    }
    __device__ __forceinline__ void operator()(const f32x4 (&acc)[2][2][4][2], const Unit& u, int wr, int wc, int fr, int fq) const {
        const int row0 = u.pm * BM + wr * 64 + fr, col0 = u.pn * BM + wc * 32 + 8 * fq; const float gs = cs * (32.0f / 15.0f);
#pragma unroll
        for (int ai = 0; ai < 2; ++ai)
#pragma unroll
            for (int m = 0; m < 4; ++m) { const int row = row0 + ai * HALF + m * 16;
#pragma unroll
                for (int bj = 0; bj < 2; ++bj) { const int col = col0 + bj * HALF;
                    const unsigned gb = *(const unsigned*)(G + (unsigned)(row * ldg + (col >> 1)) + 512u); float o[8];
#pragma unroll
                    for (int i = 0; i < 4; ++i) { const float b0 = __builtin_fmaxf((float)((gb >> (4 * i)) & 0xfu), 1.0f), b1 = __builtin_fmaxf((float)((gb >> (16 + 4 * i)) & 0xfu), 1.0f);
                        o[i] = __builtin_fminf(__builtin_fmaxf(acc[ai][bj][m][0][i] * (b0 * gs), -448.0f), 448.0f); o[4 + i] = __builtin_fminf(__builtin_fmaxf(acc[ai][bj][m][1][i] * (b1 * gs), -448.0f), 448.0f); }
                    int w0 = 0, w1 = 0;
                    w0 = __builtin_amdgcn_cvt_pk_fp8_f32(o[0], o[1], w0, false); w0 = __builtin_amdgcn_cvt_pk_fp8_f32(o[2], o[3], w0, true);
                    w1 = __builtin_amdgcn_cvt_pk_fp8_f32(o[4], o[5], w1, false); w1 = __builtin_amdgcn_cvt_pk_fp8_f32(o[6], o[7], w1, true);
                    u32x2 w; w.x = (unsigned)w0; w.y = (unsigned)w1; *(u32x2*)(O + (unsigned)(row * ldc + col)) = w; } }
    }
};
struct EpiResF32 { typedef f32x4 AccT;
    static constexpr bool PERM = false, AFTER_DRAIN = false, HAS_MID = false;
    bf16_t* Y; const float* X; int ldc; float alpha, cs;
    __device__ __forceinline__ void operator()(const f32x4 (&acc)[2][2][4][2], const Unit& u, int wr, int wc, int fr, int fq) const {
        const int row0 = u.pm * BM + wr * 64 + fr, col0 = u.pn * BM + wc * 32 + 4 * fq;
#pragma unroll
        for (int ai = 0; ai < 2; ++ai)
#pragma unroll
            for (int m = 0; m < 4; ++m) { const size_t off = (size_t)(row0 + ai * HALF + m * 16) * ldc + col0;
#pragma unroll
                for (int bj = 0; bj < 2; ++bj)
#pragma unroll
                    for (int n = 0; n < 2; ++n) { const f32x4 xv = *(const f32x4*)(X + off + bj * HALF + n * 16); const f32x4 y = xv * alpha + acc[ai][bj][m][n] * cs;
                        typedef unsigned u32x2 __attribute__((ext_vector_type(2))); u32x2 w; w.x = cvt_pk_bf16(y[0], y[1]); w.y = cvt_pk_bf16(y[2], y[3]); *(u32x2*)(Y + off + bj * HALF + n * 16) = w; } }
    }
};
template <class Epi, class Sched, bool ALIGN_EPI = false, bool SP2 = false, int I8 = 0>
__device__ __forceinline__ void gemm_phase(PG8_LAS unsigned char* lds, const Gemm g, const Sched& S, const Epi& E) {
    int tid_ = threadIdx.x; asm volatile("" : "+v"(tid_));
    const int tid = tid_, wid = __builtin_amdgcn_readfirstlane(tid >> 6), lane = tid & 63, wr = wid >> 2, wc = wid & 3, fr = lane & 15, fq = lane >> 4;
    const int K = g.K, nt = K / BK;
    unsigned voffA[2], voffB[2];
#pragma unroll
    for (int i = 0; i < 2; ++i) { int R, C; stage_rc(tid * 16 + i * 8192, R, C); const int Rb = Epi::PERM ? ((R & ~31) + perm32(R & 31)) : R;
        voffA[i] = (unsigned)(R * g.lda + C) * 2u; voffB[i] = (unsigned)(Rb * g.ldb + C) * 2u; }
    const size_t kstep = (size_t)(BK * 2);
    const size_t hstepA = (size_t)HALF * g.lda * 2, hstepB = (size_t)HALF * g.ldb * 2;
    const size_t tstepA = 2 * hstepA, tstepB = 2 * hstepB;
    const unsigned ldsw = (unsigned)wid * 1024u;
    const int aoff = lds_byte(wr * 64 + fr, fq * 8), boff = lds_byte(wc * 32 + fr, fq * 8);
#define PG8_SA(b, h) (((b) * 2 + (h)) * HTB)
#define PG8_SB(b, h) ((4 + (b) * 2 + (h)) * HTB)
#define PG8_STAGE(bufoff, gbase, voff) do { _Pragma("unroll") for (int _i = 0; _i < 2; ++_i) \
        __builtin_amdgcn_global_load_lds((const unsigned*)((const char*)(gbase) + (voff)[_i]), (PG8_LAS unsigned*)(lds + (bufoff) + ldsw + _i * 8192), 16, 0, 0); } while (0)
#define PG8_LDA(dst, b, h) do { _Pragma("unroll") for (int m = 0; m < 4; ++m) _Pragma("unroll") for (int k = 0; k < 2; ++k) dst[m][k] = *(const PG8_LAS bf16x8*)(lds + PG8_SA(b, h) + aoff + m * 2048 + k * 1024); } while (0)
#define PG8_LDB(dst, b, h) do { _Pragma("unroll") for (int n = 0; n < 2; ++n) _Pragma("unroll") for (int k = 0; k < 2; ++k) dst[n][k] = *(const PG8_LAS bf16x8*)(lds + PG8_SB(b, h) + boff + n * 2048 + k * 1024); } while (0)
#define PG8_MMA(ai, bj, At, Bt) do { __builtin_amdgcn_s_setprio(1); _Pragma("unroll") for (int m = 0; m < 4; ++m) _Pragma("unroll") for (int n = 0; n < 2; ++n) _Pragma("unroll") for (int k = 0; k < 2; ++k) \
        { if constexpr (I8 == 2) { if (k == 0) { typedef int i32x8 __attribute__((ext_vector_type(8))); \
              const i32x8 b8_ = __builtin_shufflevector(__builtin_bit_cast(i32x4, Bt[n][0]), __builtin_bit_cast(i32x4, Bt[n][1]), 0, 1, 2, 3, 4, 5, 6, 7), a8_ = __builtin_shufflevector(__builtin_bit_cast(i32x4, At[m][0]), __builtin_bit_cast(i32x4, At[m][1]), 0, 1, 2, 3, 4, 5, 6, 7); \
              asm volatile("v_mfma_f32_16x16x128_f8f6f4 %0, %1, %2, %0" : "+v"(acc[ai][bj][m][n]) : "v"(b8_), "v"(a8_)); } } \
          else if constexpr (I8 == 1) acc[ai][bj][m][n] = __builtin_bit_cast(AccT, __builtin_amdgcn_mfma_i32_16x16x64_i8(__builtin_bit_cast(i32x4, Bt[n][k]), __builtin_bit_cast(i32x4, At[m][k]), __builtin_bit_cast(i32x4, acc[ai][bj][m][n]), 0, 0, 0)); \
          else acc[ai][bj][m][n] = __builtin_bit_cast(AccT, __builtin_amdgcn_mfma_f32_16x16x32_bf16(Bt[n][k], At[m][k], __builtin_bit_cast(f32x4, acc[ai][bj][m][n]), 0, 0, 0)); } __builtin_amdgcn_s_setprio(0); } while (0)
#define PG8_WAIT_V(n) asm volatile("s_waitcnt vmcnt(" #n ")" ::: "memory")
#define PG8_WAIT_L(n) asm volatile("s_waitcnt lgkmcnt(" #n ")" ::: "memory")
#define PG8_BAR __builtin_amdgcn_s_barrier()
#define PG8_SCHED __builtin_amdgcn_sched_barrier(0)
    Unit cur, nxt; int ui = 0;
    if (!S.next(0, cur)) return;
    typedef typename Epi::AccT AccT;
    AccT acc[2][2][4][2];
#pragma unroll
    for (int a = 0; a < 2; ++a)
#pragma unroll
        for (int b = 0; b < 2; ++b)
#pragma unroll
            for (int m = 0; m < 4; ++m)
#pragma unroll
                for (int n = 0; n < 2; ++n) acc[a][b][m][n] = (AccT){0, 0, 0, 0};
    bf16x8 At[4][2], B0[2][2], B1[2][2];
    const char* cA = (const char*)g.A + (size_t)cur.pm * tstepA; const char* cB = (const char*)g.Bt + (size_t)cur.pn * tstepB;
    S.a_ready(cur);
    if constexpr (SP2) {
        PG8_STAGE(PG8_SB(0, 0), cB, voffB); PG8_STAGE(PG8_SB(0, 1), cB + hstepB, voffB); PG8_STAGE(PG8_SA(0, 0), cA, voffA); PG8_STAGE(PG8_SA(0, 1), cA + hstepA, voffA);
        if (wr == 1) PG8_BAR;
        PG8_WAIT_V(2); PG8_BAR;
        PG8_STAGE(PG8_SB(1, 0), cB + kstep, voffB); PG8_STAGE(PG8_SA(1, 0), cA + kstep, voffA); PG8_STAGE(PG8_SB(1, 1), cB + hstepB + kstep, voffB);
        PG8_WAIT_V(6); PG8_BAR;
    } else {
        PG8_STAGE(PG8_SB(0, 0), cB, voffB); PG8_STAGE(PG8_SA(0, 0), cA, voffA); PG8_STAGE(PG8_SB(0, 1), cB + hstepB, voffB); PG8_STAGE(PG8_SA(0, 1), cA + hstepA, voffA);
        if (wr == 1) PG8_BAR;
        PG8_WAIT_V(4); PG8_BAR;
        PG8_STAGE(PG8_SB(1, 0), cB + kstep, voffB); PG8_STAGE(PG8_SA(1, 0), cA + kstep, voffA); PG8_STAGE(PG8_SB(1, 1), cB + hstepB + kstep, voffB);
        PG8_WAIT_V(6); PG8_BAR;
    }
    for (;;) {
        const bool has_next = S.next(ui + 1, nxt);
        const char* nA = has_next ? (const char*)g.A + (size_t)nxt.pm * tstepA : cA; const char* nB = has_next ? (const char*)g.Bt + (size_t)nxt.pn * tstepB : cB;
#pragma nounroll
        for (int t = 0; t < nt; t += 2) {
            if constexpr (Epi::HAS_MID) { if (t == (nt >> 1)) { if constexpr (I8 == 2) { asm volatile("s_nop 15\n\ts_nop 15" ::: "memory"); PG8_SCHED; } E.mid(acc, cur, wr, wc, fr, fq); asm volatile("s_nop 7" ::: "memory"); PG8_SCHED; } }
            const bool last = (t == nt - 2);
            const char* a1 = cA + (size_t)(t + 1) * kstep;
            const char* a2 = last ? nA : cA + (size_t)(t + 2) * kstep; const char* b2 = last ? nB : cB + (size_t)(t + 2) * kstep;
            const char* a3 = a2 + kstep; const char* b3 = b2 + kstep;
            if (last && has_next) S.a_ready(nxt);
            if constexpr (SP2) {
            PG8_LDB(B0, 0, 0); PG8_LDB(B1, 0, 1); PG8_SCHED; PG8_LDA(At, 0, 0); PG8_STAGE(PG8_SA(1, 1), a1 + hstepA, voffA);
            PG8_WAIT_V(8); PG8_WAIT_L(0); PG8_BAR; PG8_MMA(0, 0, At, B0); PG8_MMA(0, 1, At, B1); PG8_BAR; PG8_SCHED;
            PG8_LDA(At, 0, 1); PG8_STAGE(PG8_SB(0, 0), b2, voffB); PG8_STAGE(PG8_SB(0, 1), b2 + hstepB, voffB); PG8_STAGE(PG8_SA(0, 0), a2, voffA);
            PG8_WAIT_V(8); PG8_WAIT_L(0); PG8_BAR; PG8_MMA(1, 0, At, B0); PG8_MMA(1, 1, At, B1); PG8_BAR; PG8_SCHED;
            PG8_LDB(B0, 1, 0); PG8_LDB(B1, 1, 1); PG8_SCHED; PG8_LDA(At, 1, 0); PG8_STAGE(PG8_SA(0, 1), a2 + hstepA, voffA);
            PG8_WAIT_V(8); PG8_WAIT_L(0); PG8_BAR; PG8_MMA(0, 0, At, B0); PG8_MMA(0, 1, At, B1); PG8_BAR; PG8_SCHED;
            PG8_LDA(At, 1, 1); PG8_STAGE(PG8_SB(1, 0), b3, voffB); PG8_STAGE(PG8_SB(1, 1), b3 + hstepB, voffB); PG8_STAGE(PG8_SA(1, 0), a3, voffA);
            PG8_WAIT_V(8); PG8_WAIT_L(0); PG8_BAR; PG8_MMA(1, 0, At, B0); PG8_MMA(1, 1, At, B1); PG8_BAR; PG8_SCHED;
            } else {
            PG8_LDB(B0, 0, 0); PG8_SCHED; PG8_LDA(At, 0, 0); PG8_STAGE(PG8_SA(1, 1), a1 + hstepA, voffA);
            PG8_WAIT_L(8); PG8_BAR; PG8_WAIT_L(0); PG8_MMA(0, 0, At, B0); PG8_BAR; PG8_SCHED;
            PG8_LDB(B1, 0, 1); PG8_STAGE(PG8_SB(0, 0), b2, voffB);
            PG8_BAR; PG8_WAIT_L(0); PG8_MMA(0, 1, At, B1); PG8_BAR;
            PG8_LDA(At, 0, 1); PG8_STAGE(PG8_SA(0, 0), a2, voffA);
            PG8_BAR; PG8_WAIT_L(0); PG8_MMA(1, 0, At, B0); PG8_BAR; PG8_SCHED;
            PG8_STAGE(PG8_SB(0, 1), b2 + hstepB, voffB);
            PG8_WAIT_V(6); PG8_BAR; PG8_MMA(1, 1, At, B1); PG8_BAR;
            PG8_LDB(B0, 1, 0); PG8_SCHED; PG8_LDA(At, 1, 0); PG8_STAGE(PG8_SA(0, 1), a2 + hstepA, voffA);
            PG8_WAIT_L(8); PG8_BAR; PG8_WAIT_L(0); PG8_MMA(0, 0, At, B0); PG8_BAR; PG8_SCHED;
            PG8_LDB(B1, 1, 1); PG8_STAGE(PG8_SB(1, 0), b3, voffB);
            PG8_BAR; PG8_WAIT_L(0); PG8_MMA(0, 1, At, B1); PG8_BAR;
            PG8_LDA(At, 1, 1); PG8_STAGE(PG8_SA(1, 0), a3, voffA);
            PG8_BAR; PG8_WAIT_L(0); PG8_MMA(1, 0, At, B0); PG8_BAR; PG8_SCHED;
            PG8_STAGE(PG8_SB(1, 1), b3 + hstepB, voffB);
            PG8_WAIT_V(6); PG8_BAR; PG8_MMA(1, 1, At, B1); PG8_BAR;
            }
        }
        if constexpr (I8 == 2) { asm volatile("s_nop 15\n\ts_nop 15" ::: "memory"); PG8_SCHED; }
        if constexpr (ALIGN_EPI) { if (wr == 0) PG8_BAR; }
        if constexpr (!Epi::AFTER_DRAIN) { E(acc, cur, wr, wc, fr, fq); S.done(cur); }
        if (!has_next) break;
#pragma unroll
        for (int a = 0; a < 2; ++a)
#pragma unroll
            for (int b = 0; b < 2; ++b)
#pragma unroll
                for (int m = 0; m < 4; ++m)
#pragma unroll
                    for (int n = 0; n < 2; ++n) acc[a][b][m][n] = (AccT){0, 0, 0, 0};
        cur = nxt; cA = nA; cB = nB; ++ui;
        if constexpr (ALIGN_EPI) { if (wr == 1) PG8_BAR; }
    }
    PG8_WAIT_V(0);
    if constexpr (!ALIGN_EPI) { if (wr == 0) PG8_BAR; }
    PG8_BAR;
    if constexpr (Epi::AFTER_DRAIN) { E.fused(acc, cur, wr, wc, fr, fq, lds, wid, lane); S.done(cur); }
#undef PG8_SA
#undef PG8_SB
#undef PG8_STAGE
#undef PG8_LDA
#undef PG8_LDB
#undef PG8_MMA
#undef PG8_WAIT_V
#undef PG8_WAIT_L
#undef PG8_BAR
#undef PG8_SCHED
}
}

#define GAS __attribute__((address_space(1)))
#define LAS __attribute__((address_space(3)))
typedef unsigned short bf16;
typedef unsigned v4u __attribute__((ext_vector_type(4)));
typedef unsigned v2u __attribute__((ext_vector_type(2)));
typedef float f32x4 __attribute__((ext_vector_type(4)));
typedef float f32x16 __attribute__((ext_vector_type(16)));
typedef int i32x4 __attribute__((ext_vector_type(4)));
typedef short bf16x8 __attribute__((ext_vector_type(8)));
typedef __bf16 bf16x2v __attribute__((ext_vector_type(2)));
typedef GAS unsigned gu32;
#define RLX_AGENT __ATOMIC_RELAXED, __HIP_MEMORY_SCOPE_AGENT
#define LDS_WAIT() asm volatile("s_waitcnt lgkmcnt(0)" ::: "memory")
#define VM_WAIT() asm volatile("s_waitcnt vmcnt(0)" ::: "memory")
#define XB_TMO      128
#define XB_XCNT(j)  (256  + 64 * (j))
#define XB_XSUB(j)  (1280 + 64 * (j))
#define XB_XGEN(j)  (2304 + 64 * (j))
#define XB_TOP      3328
#define XB_TOPGEN   3392
#define XCD_BAR_WORDS 3456
#define XB_SPIN_CAP (1u << 18)

__device__ __forceinline__ unsigned xb_ld(unsigned* p)              { return __hip_atomic_load(p, __ATOMIC_RELAXED, __HIP_MEMORY_SCOPE_AGENT); }
__device__ __forceinline__ unsigned xb_add(unsigned* p, unsigned v) { return __hip_atomic_fetch_add(p, v, __ATOMIC_RELAXED, __HIP_MEMORY_SCOPE_AGENT); }
__device__ __forceinline__ unsigned xb_xcc_id() { return (unsigned)__builtin_amdgcn_s_getreg((3 << 11) | 20) & 0xFu; }
#define XB_SPIN(cond, bar) do { unsigned _sp = 0; while (cond) { __builtin_amdgcn_s_sleep(1); \
    if ((++_sp & 255u) == 0u) { if (xb_ld(&(bar)[XB_TMO])) break; if (_sp > XB_SPIN_CAP) { atomicAdd(&(bar)[XB_TMO], 1u); break; } } } } while (0)

struct XcdBarrier {
    unsigned* bar; unsigned x;
    volatile LAS unsigned* st;
};

__device__ __forceinline__ XcdBarrier xcd_barrier_post(unsigned* bar, volatile LAS unsigned* st) {
    XcdBarrier b; b.bar = bar; b.x = xb_xcc_id(); b.st = st;
    if (threadIdx.x == 0) (void)xb_add(&bar[XB_XCNT(b.x)], 1u);
    return b;
}
__device__ __forceinline__ void xcd_barrier_complete(unsigned* bar, unsigned x, unsigned& nloc, unsigned& nx) {
    const unsigned G = gridDim.x * gridDim.y * gridDim.z;
    unsigned sum, cnt, mine, sp = 0u;
    for (;;) {
        sum = 0u; cnt = 0u; mine = 0u;
#pragma unroll
        for (unsigned j = 0; j < 16; ++j) { const unsigned c = xb_ld(&bar[XB_XCNT(j)]); sum += c; cnt += (c > 0u) ? 1u : 0u; mine = (j == x) ? c : mine; }
        if (sum == G) break;
        __builtin_amdgcn_s_sleep(1);
        if ((++sp & 255u) == 0u) { if (xb_ld(&bar[XB_TMO])) break; if (sp > XB_SPIN_CAP) { atomicAdd(&bar[XB_TMO], 1u); break; } }
    }
    nloc = mine > 0u ? mine : 1u; nx = cnt > 0u ? cnt : 1u;
}

__device__ __forceinline__ void xcd_barrier(const XcdBarrier& b) {
    asm volatile("s_waitcnt vmcnt(0)" ::: "memory");
    __syncthreads();
    if (threadIdx.x == 0) {
        unsigned* bar = b.bar;
        __builtin_amdgcn_s_waitcnt(0);
        unsigned nloc = b.st[0], nx = b.st[1];
        if (nloc == 0u) { xcd_barrier_complete(bar, b.x, nloc, nx); b.st[0] = nloc; b.st[1] = nx; }
        const unsigned old = xb_add(&bar[XB_XSUB(b.x)], 1u);
        const unsigned gen = old / nloc;
        if (old + 1u == (gen + 1u) * nloc) {
            __builtin_amdgcn_fence(__ATOMIC_RELEASE, "agent");
            asm volatile("s_waitcnt vmcnt(0)" ::: "memory");
            const unsigned og = xb_add(&bar[XB_TOP], 1u);
            const unsigned tg = og / nx;
            if (og + 1u == (tg + 1u) * nx) xb_add(&bar[XB_TOPGEN], 1u);
            else XB_SPIN(xb_ld(&bar[XB_TOPGEN]) == tg, bar);
            __builtin_amdgcn_fence(__ATOMIC_ACQUIRE, "agent");
            xb_add(&bar[XB_XGEN(b.x)], 1u);
            asm volatile("s_waitcnt vmcnt(0)" ::: "memory");
        } else {
            XB_SPIN(xb_ld(&bar[XB_XGEN(b.x)]) == gen, bar);
            __builtin_amdgcn_fence(__ATOMIC_ACQUIRE, "agent");
            asm volatile("s_waitcnt vmcnt(0)" ::: "memory");
        }
    }
    __syncthreads();
}

constexpr int NWAVES = 8;
constexpr int BATCH = 32, SEQ = 2048, D = 1024, M = BATCH * SEQ;
constexpr int HW = 4352;
constexpr int H_CQ = 0, H_CKV = 768, H_QB = 1024, H_QIDX = 1536, H_GA = 2048, H_GB = 3072, H_KROPE = 4096, H_KB = 4128, H_VB = 4192, H_KIDX = 4256, H_WIDX = 4320;
constexpr float ALPHA = 1.189207115002721f;
constexpr float LN_EPS = 1e-5f, RMS_EPS = 1e-6f;
constexpr int NPHASES = 14;
constexpr size_t SHARD_BYTES = (size_t)16384 * 128;
#ifndef E2_ALAY
#define E2_ALAY 1
#endif
#ifndef DSA_REP
#define DSA_REP 1
#endif
#ifndef E2_TEST
#define E2_TEST 0
#endif
#ifndef REPEAT_MASK
#define REPEAT_MASK 0
#endif
#ifndef PHASE_MASK
#define PHASE_MASK 0x33fff
#endif
#ifndef EXP_NOMIX
#define EXP_NOMIX 0
#endif
#ifndef MLA_PROBE
#define MLA_PROBE 0
#endif
#ifndef DSA_SKIP
#define DSA_SKIP 0
#endif
#ifndef EXP_NODSA
#define EXP_NODSA 0
#endif
#ifndef EXP_NOMLA
#define EXP_NOMLA 0
#endif

constexpr size_t MiB = 1u << 20;
constexpr size_t WS_CTL = 0, CTL_ZERO_BYTES = 1 * MiB;
constexpr size_t WS_BIASP = 1 * MiB, WS_RSQ = 2 * MiB, WS_RSKV = 2 * MiB + 512 * 1024, WS_WIDX = 3 * MiB, WS_CS = 5 * MiB, WS_KPE = 13 * MiB, WS_KIDX = 17 * MiB, WS_KB = 25 * MiB, WS_VB = 33 * MiB;
constexpr size_t WS_WIN_T = 41 * MiB, WS_WQ_T = 50 * MiB, WS_WKV_T = 52 * MiB, WS_WOA_T = 53 * MiB, WS_WOB_T = 54 * MiB, WS_WOUT_T = 55 * MiB, WS_WPQ_T = 57 * MiB, WS_SUBK = 61 * MiB, WS_PU = 62 * MiB  , WS_PV = 78 * MiB, WS_SU = 94 * MiB  , WS_SV = 95 * MiB, WS_XMAX = 96 * MiB  , WS_CSUM = 97 * MiB  ,
                 WS_SX = 98 * MiB  , WS_SW = 99 * MiB  ;
constexpr size_t WS_XB = 128 * MiB;
constexpr size_t WS_XQ = 256 * MiB;
constexpr size_t WS_X1Q = 384 * MiB;
constexpr size_t WS_Q = 256 * MiB, WS_KV = 352 * MiB;
constexpr size_t WS_H = 480 * MiB;
constexpr size_t WS_END = 1024 * MiB;
constexpr int CW_BAR = 4096;

constexpr int LDS_BYTES = 163840;
constexpr int MISC_OFF = LDS_BYTES - 256;

typedef float f32x2v __attribute__((ext_vector_type(2)));
__device__ __forceinline__ unsigned pk4_fp8(float a, float b, float c, float d) {
    a = fminf(fmaxf(a, -448.f), 448.f); b = fminf(fmaxf(b, -448.f), 448.f); c = fminf(fmaxf(c, -448.f), 448.f); d = fminf(fmaxf(d, -448.f), 448.f);
    int w = 0; w = __builtin_amdgcn_cvt_pk_fp8_f32(a, b, w, false); w = __builtin_amdgcn_cvt_pk_fp8_f32(c, d, w, true); return (unsigned)w; }
__device__ __forceinline__ unsigned pk2(float lo, float hi) { const f32x2v v = {lo, hi}; return __builtin_bit_cast(unsigned, __builtin_convertvector(v, bf16x2v)); }
__device__ __forceinline__ float bflo(unsigned w) { return __uint_as_float(w << 16); }
__device__ __forceinline__ float bfhi(unsigned w) { return __uint_as_float(w & 0xffff0000u); }
__device__ __forceinline__ float bf1(unsigned short w) { return __uint_as_float(((unsigned)w) << 16); }
__device__ __forceinline__ float wave_sum(float v) {
#pragma unroll
    for (int o = 1; o < 64; o <<= 1) v += __shfl_xor(v, o);
    return v;
}
__device__ __forceinline__ float xhalf_max(float x) { const auto r = __builtin_amdgcn_permlane32_swap(__float_as_uint(x), __float_as_uint(x), false, false); return fmaxf(__uint_as_float(r[0]), __uint_as_float(r[1])); }
__device__ __forceinline__ float dpp_xor1(float x) { return __int_as_float(__builtin_amdgcn_update_dpp(0, __float_as_int(x), 0xB1, 0xf, 0xf, true)); }
__device__ __forceinline__ float dpp_xor2(float x) { return __int_as_float(__builtin_amdgcn_update_dpp(0, __float_as_int(x), 0x4E, 0xf, 0xf, true)); }
__device__ __forceinline__ float dpp_xor4(float x) { int r = __builtin_amdgcn_update_dpp(0, __float_as_int(x), 0x104, 0xf, 0x5, false); r = __builtin_amdgcn_update_dpp(r, __float_as_int(x), 0x114, 0xf, 0xa, false); return __int_as_float(r); }
__device__ __forceinline__ float xhalf_sum(float x) { const auto r = __builtin_amdgcn_permlane32_swap(__float_as_uint(x), __float_as_uint(x), false, false); return __uint_as_float(r[0]) + __uint_as_float(r[1]); }
__device__ __forceinline__ float dpp_xor8(float x) { return __int_as_float(__builtin_amdgcn_update_dpp(0, __float_as_int(x), 0x128, 0xf, 0xf, true)); }
__device__ __forceinline__ float xrow_max(float x) { const auto r = __builtin_amdgcn_permlane16_swap(__float_as_uint(x), __float_as_uint(x), false, false); return fmaxf(__uint_as_float(r[0]), __uint_as_float(r[1])); }
__device__ __forceinline__ float xrow_sum(float x) { const auto r = __builtin_amdgcn_permlane16_swap(__float_as_uint(x), __float_as_uint(x), false, false); return __uint_as_float(r[0]) + __uint_as_float(r[1]); }
template <int U> __device__ __forceinline__ void wave_sum_n(float (&v)[U]) {
#pragma unroll
    for (int u = 0; u < U; ++u) { float x = v[u]; x += dpp_xor1(x); x += dpp_xor2(x); x += dpp_xor4(x); x += dpp_xor8(x); x = xrow_sum(x); v[u] = xhalf_sum(x); }
}
template <int U> __device__ __forceinline__ void wave_max_n(float (&v)[U]) {
#pragma unroll
    for (int u = 0; u < U; ++u) { float x = v[u]; x = fmaxf(x, dpp_xor1(x)); x = fmaxf(x, dpp_xor2(x)); x = fmaxf(x, dpp_xor4(x)); x = fmaxf(x, dpp_xor8(x)); x = xrow_max(x); v[u] = xhalf_max(x); }
}
__device__ __forceinline__ float dot2bf(unsigned a, unsigned b, float c) { return __builtin_amdgcn_fdot2_f32_bf16(__builtin_bit_cast(bf16x2v, a), __builtin_bit_cast(bf16x2v, b), c, false); }
#define MFMA32(a, b, c) __builtin_amdgcn_mfma_f32_32x32x16_bf16((a), (b), (c), 0, 0, 0)
#define MFMA16(a, b, c) __builtin_amdgcn_mfma_f32_16x16x32_bf16((a), (b), (c), 0, 0, 0)

struct Args { const float* in[20]; float* out; unsigned char* ws; int ph_lo, ph_hi; };
struct Frame {
    LAS unsigned char* lds;
    int tid, lane, wave, vcu, G;
    const struct Args* a; const int* pos; float* out; unsigned char* ws;
};
#define WSP(T, off) ((T*)(F.ws + (off)))

__device__ __forceinline__ int win_src(int n) {
    if (n < 1024) return n;
    if (n < 1536) return 1056 + (n - 1024);
    if (n < 2048) return 1696 + (n - 1536);
    if (n < 3072) return 2280 + (n - 2048);
    if (n < 4096) return 3304 + (n - 3072);
    if (n < 4128) return 1024 + (n - 4096);
    if (n < 4192) return 1568 + (n - 4128);
    if (n < 4256) return 1632 + (n - 4192);
    if (n < 4320) return 2208 + (n - 4256);
    if (n < 4328) return 2272 + (n - 4320);
    return -1;
}
__device__ __forceinline__ int wq_src(int n) {
    if (n < 512) return (n >> 6) * 96 + (n & 63);
    const int p = n - 512, hd = p >> 5, pp = p & 31, f = pp >> 3, r = pp & 7, j = 4 * f + (r & 3);
    return hd * 96 + 64 + (r < 4 ? j : 16 + j);
}
__device__ __forceinline__ int wkv_src(int n) { return n < 512 ? (n >> 6) * 128 + (n & 63) : ((n - 512) >> 6) * 128 + 64 + ((n - 512) & 63); }

template <int MAP, bool OUT8 = false>
__device__ __forceinline__ void transpose_item(const float* W, int ldw, bf16* WT, int K, int nblk, int item, const float* kscale, LAS float* scr, int lane) {
    const int kb = item / nblk, nb = item % nblk, k0 = 64 * kb, n0 = 32 * nb;
    const int nd = n0 + (lane & 31);
    const int sc = MAP == 0 ? nd : (MAP == 1 ? win_src(nd) : (MAP == 2 ? wq_src(nd) : wkv_src(nd)));
#pragma unroll 8
    for (int i = 0; i < 32; ++i) { const int kk = 2 * i + (lane >> 5); float v = 0.f; if (sc >= 0) { v = W[(size_t)(k0 + kk) * ldw + sc]; if (kscale) v *= kscale[k0 + kk]; } scr[kk * 33 + (lane & 31)] = v; }
    LDS_WAIT(); asm volatile("" ::: "memory");
    const int c = lane & 7;
#pragma unroll
    for (int j = 0; j < 4; ++j) { const int n = (lane >> 3) + 8 * j; const LAS float* s = scr + (8 * c) * 33 + n;
        if constexpr (OUT8) { int w0 = 0, w1 = 0;
            w0 = __builtin_amdgcn_cvt_pk_fp8_f32(256.f * s[0 * 33], 256.f * s[1 * 33], w0, false); w0 = __builtin_amdgcn_cvt_pk_fp8_f32(256.f * s[2 * 33], 256.f * s[3 * 33], w0, true);
            w1 = __builtin_amdgcn_cvt_pk_fp8_f32(256.f * s[4 * 33], 256.f * s[5 * 33], w1, false); w1 = __builtin_amdgcn_cvt_pk_fp8_f32(256.f * s[6 * 33], 256.f * s[7 * 33], w1, true);
            v2u o; o.x = (unsigned)w0; o.y = (unsigned)w1; *(GAS v2u*)((unsigned char*)WT + (size_t)(n0 + n) * K + k0 + 8 * c) = o; }
        else { v4u o; o.x = pk2(s[0 * 33], s[1 * 33]); o.y = pk2(s[2 * 33], s[3 * 33]); o.z = pk2(s[4 * 33], s[5 * 33]); o.w = pk2(s[6 * 33], s[7 * 33]);
            *(GAS v4u*)(WT + (size_t)(n0 + n) * K + k0 + 8 * c) = o; } }
    LDS_WAIT(); asm volatile("" ::: "memory");
}
__device__ __forceinline__ void conv8(const float* src, bf16* dst, size_t ngroups, size_t gtid, size_t NT) {
    for (size_t i0 = gtid; i0 < ngroups; i0 += 4 * NT) {
        f32x4 a[4], b[4];
#pragma unroll
        for (int u = 0; u < 4; ++u) { const size_t i = i0 + u * NT < ngroups ? i0 + u * NT : i0; a[u] = *(const GAS f32x4*)(src + 8 * i); b[u] = *(const GAS f32x4*)(src + 8 * i + 4); }
#pragma unroll
        for (int u = 0; u < 4; ++u) { const size_t i = i0 + u * NT; if (i < ngroups) { v4u o; o.x = pk2(a[u][0], a[u][1]); o.y = pk2(a[u][2], a[u][3]); o.z = pk2(b[u][0], b[u][1]); o.w = pk2(b[u][2], b[u][3]); *(GAS v4u*)(dst + 8 * i) = o; } }
    }
}

__device__ __forceinline__ void p0_prologue(Frame& F) {
    const size_t gtid = (size_t)F.vcu * (NWAVES * 64) + F.tid, NT = (size_t)F.G * (NWAVES * 64);
    { const int gwx = F.vcu * NWAVES + F.wave, NGWx = F.G * NWAVES, lane = F.lane; constexpr int U = 4;
      for (int t0 = gwx; t0 < M; t0 += NGWx * U) {
          f32x4 v[U][4]; float am[U];
#pragma unroll
          for (int u = 0; u < U; ++u) { const int t = t0 + u * NGWx < M ? t0 + u * NGWx : t0; const float* src = F.a->in[0] + (size_t)t * D + 16 * lane; am[u] = 0.f;
#pragma unroll
              for (int j = 0; j < 4; ++j) { v[u][j] = *(const GAS f32x4*)(src + 4 * j); am[u] = fmaxf(am[u], fmaxf(fmaxf(fabsf(v[u][j][0]), fabsf(v[u][j][1])), fmaxf(fabsf(v[u][j][2]), fabsf(v[u][j][3])))); } }
          wave_max_n<U>(am);
#pragma unroll
          for (int u = 0; u < U; ++u) { const int t = t0 + u * NGWx; if (t < M) { const float sc = am[u] > 0.f ? am[u] * (1.0f / 127.0f) : 1.0f, isc = 1.0f / sc; v4u o4;
#pragma unroll
              for (int j = 0; j < 4; ++j) { unsigned w = 0u;
#pragma unroll
                  for (int i = 0; i < 4; ++i) { float q = rintf(v[u][j][i] * isc); q = fminf(fmaxf(q, -127.f), 127.f); w |= ((unsigned)(int)q & 0xffu) << (8 * i); }
                  o4[j] = w; }
              *(GAS v4u*)(WSP(unsigned char, WS_XQ) + (size_t)t * D + 16 * lane) = o4; if (lane == 0) WSP(float, WS_SX)[t] = sc; } }
      }
      for (int n = gwx; n < HW; n += NGWx) { const int srcc = win_src(n); float w16[16]; float am = 0.f;
#pragma unroll
          for (int i = 0; i < 16; ++i) { w16[i] = srcc >= 0 ? F.a->in[2][(size_t)(16 * lane + i) * 4328 + srcc] : 0.f; am = fmaxf(am, fabsf(w16[i])); }
#pragma unroll
          for (int o = 1; o < 64; o <<= 1) am = fmaxf(am, __shfl_xor(am, o));
          const float sc = am > 0.f ? am * (1.0f / 127.0f) : 1.0f, isc = 1.0f / sc; v4u o4;
#pragma unroll
          for (int j = 0; j < 4; ++j) { unsigned w = 0u;
#pragma unroll
              for (int i = 0; i < 4; ++i) { float q = rintf(w16[4 * j + i] * isc); q = fminf(fmaxf(q, -127.f), 127.f); w |= ((unsigned)(int)q & 0xffu) << (8 * i); }
              o4[j] = w; }
          *(GAS v4u*)(WSP(unsigned char, WS_WIN_T) + (size_t)n * 1024 + 16 * lane) = o4; if (lane == 0) WSP(float, WS_SW)[n] = sc; }
      for (int n = gwx; n < 768; n += NGWx) { const int srcc = wq_src(n); float w16[16]; float am = 0.f;
#pragma unroll
          for (int i = 0; i < 16; ++i) { const int k = 16 * lane + i; w16[i] = lane < 48 ? F.a->in[6][(size_t)k * 768 + srcc] * F.a->in[4][k] : 0.f; am = fmaxf(am, fabsf(w16[i])); }
#pragma unroll
          for (int o = 1; o < 64; o <<= 1) am = fmaxf(am, __shfl_xor(am, o));
          const float sc = am > 0.f ? am * (1.0f / 127.0f) : 1.0f, isc = 1.0f / sc; v4u o4;
#pragma unroll
          for (int j = 0; j < 4; ++j) { unsigned w = 0u;
#pragma unroll
              for (int i = 0; i < 4; ++i) { float q = rintf(w16[4 * j + i] * isc); q = fminf(fmaxf(q, -127.f), 127.f); w |= ((unsigned)(int)q & 0xffu) << (8 * i); }
              o4[j] = w; }
          if (lane < 48) *(GAS v4u*)(WSP(unsigned char, WS_WQ_T) + (size_t)n * 768 + 16 * lane) = o4; if (lane == 0) WSP(float, WS_SW)[12288 + n] = sc; }
      for (int n = gwx; n < 2048; n += NGWx) { float w16[16]; float am = 0.f;
#pragma unroll
          for (int i = 0; i < 16; ++i) { w16[i] = F.a->in[14][(size_t)(16 * lane + i) * 2048 + n]; am = fmaxf(am, fabsf(w16[i])); }
#pragma unroll
          for (int o = 1; o < 64; o <<= 1) am = fmaxf(am, __shfl_xor(am, o));
          const float sc = am > 0.f ? am * (1.0f / 127.0f) : 1.0f, isc = 1.0f / sc; v4u o4;
#pragma unroll
          for (int j = 0; j < 4; ++j) { unsigned w = 0u;
#pragma unroll
              for (int i = 0; i < 4; ++i) { float q = rintf(w16[4 * j + i] * isc); q = fminf(fmaxf(q, -127.f), 127.f); w |= ((unsigned)(int)q & 0xffu) << (8 * i); }
              o4[j] = w; }
          *(GAS v4u*)(WSP(unsigned char, WS_WPQ_T) + (size_t)n * 1024 + 16 * lane) = o4; if (lane == 0) WSP(float, WS_SW)[8192 + n] = sc; }
    }
    conv8(F.a->in[15], WSP(bf16, WS_SUBK), (size_t)16 * 128 * 128 / 8, gtid, NT);
    for (size_t i = gtid; i < (size_t)HW; i += NT) { const int s = win_src((int)i); WSP(float, WS_BIASP)[i] = s >= 0 ? F.a->in[3][s] : 0.f; }
    for (size_t i = gtid; i < (size_t)M * 16; i += NT) { const int t = (int)(i >> 4), j = (int)(i & 15);
        const float inv = exp2f(-(float)j * 0.83048202372184059f);
        const float ang = (float)F.pos[t] * inv;
        const double tt = (double)ang * 0.15915494309189535; const float fr = (float)(tt - rint(tt));
        float2 cs; cs.x = __builtin_amdgcn_cosf(fr); cs.y = __builtin_amdgcn_sinf(fr); WSP(float2, WS_CS)[i] = cs; }
    LAS float* scr = (LAS float*)(F.lds + F.wave * 16384);
    const int gw = F.vcu * NWAVES + F.wave, NGW = F.G * NWAVES;
    constexpr int I_IN = (HW / 32) * 16, I_Q = 24 * 12, I_KV = 32 * 4, I_OA = 32 * 8, I_OUT = 32 * 16, I_PQ = 64 * 16;
    constexpr int NITEMS = I_KV + 2 * I_OA + I_OUT;
    for (int it = gw; it < NITEMS; it += NGW) {
        int r = it;
        if (r < I_KV) { transpose_item<3, true>(F.a->in[7], 1024, WSP(bf16, WS_WKV_T), 256, 32, r, F.a->in[5], scr, F.lane); continue; } r -= I_KV;
        if (r < I_OA) { transpose_item<0, true>(F.a->in[8], 1024, WSP(bf16, WS_WOA_T), 1024, 32, r, nullptr, scr, F.lane); continue; } r -= I_OA;
        if (r < I_OA) { transpose_item<0, true>(F.a->in[9], 1024, (bf16*)(F.ws + WS_WOA_T + 512), 1024, 32, r, nullptr, scr, F.lane); continue; } r -= I_OA;
        transpose_item<0, true>(F.a->in[11], 1024, WSP(bf16, WS_WOUT_T), 1024, 32, r, nullptr, scr, F.lane);
    }
}

typedef float f32x2p __attribute__((ext_vector_type(2)));
__device__ __forceinline__ v4u fp8x8_to_bf16x8(v2u w) {
    const f32x2p f0 = __builtin_amdgcn_cvt_pk_f32_fp8((int)w.x, false), f1 = __builtin_amdgcn_cvt_pk_f32_fp8((int)w.x, true), f2 = __builtin_amdgcn_cvt_pk_f32_fp8((int)w.y, false), f3 = __builtin_amdgcn_cvt_pk_f32_fp8((int)w.y, true);
    return (v4u){pk2(f0.x, f0.y), pk2(f1.x, f1.y), pk2(f2.x, f2.y), pk2(f3.x, f3.y)};
}
__device__ __forceinline__ void p2_small(Frame& F) {
    constexpr int U = 4;
    const int gw = F.vcu * NWAVES + F.wave, NGW = F.G * NWAVES, lane = F.lane;
    const bf16* Hb = WSP(bf16, WS_H);
    for (int t0 = gw; t0 < M; t0 += NGW * U) {
        v4u a[U], b[U]; v2u sm[U]; f32x4 ca[U], cb[U]; float sq[U], skv[U];
#pragma unroll
        for (int u = 0; u < U; ++u) { const int t = t0 + u * NGW < M ? t0 + u * NGW : t0; const bf16* hrow = Hb + (size_t)t * HW;
            { const v2u a8 = *(const GAS v2u*)((const unsigned char*)hrow + 8 * lane), b8 = *(const GAS v2u*)((const unsigned char*)hrow + 512 + 8 * lane);
              a[u] = fp8x8_to_bf16x8(a8); b[u] = fp8x8_to_bf16x8(b8); } sm[u] = *(const GAS v2u*)(hrow + H_KROPE + 4 * lane);
            ca[u] = *(const GAS f32x4*)(WSP(float, WS_CS) + (size_t)t * 32 + 8 * (lane & 3)); cb[u] = *(const GAS f32x4*)(WSP(float, WS_CS) + (size_t)t * 32 + 8 * (lane & 3) + 4); }
#pragma unroll
        for (int u = 0; u < U; ++u) { float sa = 0.f, sb = 0.f;
#pragma unroll
            for (int i = 0; i < 4; ++i) { const float a0 = bflo(a[u][i]), a1 = bfhi(a[u][i]), b0 = bflo(b[u][i]), b1 = bfhi(b[u][i]); sa += a0 * a0 + a1 * a1; sb += b0 * b0 + b1 * b1; }
            sq[u] = sa + (lane < 32 ? sb : 0.f); skv[u] = lane >= 32 ? sb : 0.f; }
        wave_sum_n<U>(sq); wave_sum_n<U>(skv);
        float cqm[U];
#pragma unroll
        for (int u = 0; u < U; ++u) { float ma = 0.f, mb = 0.f;
#pragma unroll
            for (int i = 0; i < 4; ++i) { ma = fmaxf(ma, fmaxf(fabsf(bflo(a[u][i])), fabsf(bfhi(a[u][i])))); mb = fmaxf(mb, fmaxf(fabsf(bflo(b[u][i])), fabsf(bfhi(b[u][i])))); }
            cqm[u] = fmaxf(ma, lane < 32 ? mb : 0.f); }
        wave_max_n<U>(cqm);
#pragma unroll
        for (int u = 0; u < U; ++u) cqm[u] = cqm[u] > 0.f ? cqm[u] : 1.0f;
        float kim[U];
#pragma unroll
        for (int u = 0; u < U; ++u) { const float m4 = fmaxf(fmaxf(fabsf(bflo(sm[u].x)), fabsf(bfhi(sm[u].x))), fmaxf(fabsf(bflo(sm[u].y)), fabsf(bfhi(sm[u].y)))); kim[u] = (lane >= 40 && lane < 56) ? m4 : 0.f; }
        wave_max_n<U>(kim);
#pragma unroll
        for (int u = 0; u < U; ++u) kim[u] = kim[u] > 0.f ? kim[u] : 1.0f;
#pragma unroll
        for (int u = 0; u < U; ++u) { const int t = t0 + u * NGW; const v2u s = sm[u];
            const float x0 = bflo(s.x), x1 = bfhi(s.x), x2 = bflo(s.y), x3 = bfhi(s.y);
            const float y0 = __shfl_down(x0, 4), y1 = __shfl_down(x1, 4), y2 = __shfl_down(x2, 4), y3 = __shfl_down(x3, 4);
            if (t < M) {
                { const float iq = 127.0f / cqm[u]; v2u qa, qb2;
#pragma unroll
                  for (int h2 = 0; h2 < 2; ++h2) { unsigned wa = 0u, wb = 0u;
#pragma unroll
                      for (int i = 0; i < 2; ++i) { const unsigned sa_ = a[u][2 * h2 + i], sb_ = b[u][2 * h2 + i];
                          float q0 = rintf(bflo(sa_) * iq), q1 = rintf(bfhi(sa_) * iq), q2 = rintf(bflo(sb_) * iq), q3 = rintf(bfhi(sb_) * iq);
                          q0 = fminf(fmaxf(q0, -127.f), 127.f); q1 = fminf(fmaxf(q1, -127.f), 127.f); q2 = fminf(fmaxf(q2, -127.f), 127.f); q3 = fminf(fmaxf(q3, -127.f), 127.f);
                          wa |= (((unsigned)(int)q0 & 0xffu) | (((unsigned)(int)q1 & 0xffu) << 8)) << (16 * i); wb |= (((unsigned)(int)q2 & 0xffu) | (((unsigned)(int)q3 & 0xffu) << 8)) << (16 * i); }
                      qa[h2] = wa; qb2[h2] = wb; }
                  *(GAS v2u*)(WSP(unsigned char, WS_XB) + (size_t)t * 768 + 8 * lane) = qa;
                  if (lane < 32) *(GAS v2u*)(WSP(unsigned char, WS_XB) + (size_t)t * 768 + 512 + 8 * lane) = qb2; }
                if (lane == 0) { WSP(float, WS_RSQ)[t] = (cqm[u] * (1.0f / 127.0f)) / sqrtf(sq[u] * (1.0f / 768.0f) + RMS_EPS); WSP(float, WS_RSKV)[t] = (1.0f / 256.0f) / sqrtf(skv[u] * (1.0f / 256.0f) + RMS_EPS); }
                if (lane >= 8 && lane < 24) { const int d0 = 4 * (lane - 8), pos0 = d0 < 32 ? 16 * (d0 >> 3) + (d0 & 7) : 16 * ((d0 - 32) >> 3) + 8 + ((d0 - 32) & 7);
                    int w8 = 0; w8 = __builtin_amdgcn_cvt_pk_fp8_f32(x0, x1, w8, false); w8 = __builtin_amdgcn_cvt_pk_fp8_f32(x2, x3, w8, true);
                    *(GAS int*)(WSP(unsigned char, WS_KB) + (size_t)t * 64 + pos0) = w8; }
                if (lane >= 24 && lane < 40) *(GAS unsigned*)(WSP(unsigned char, WS_VB) + (size_t)t * 64 + 4 * (lane - 24)) = pk4_fp8(x0, x1, x2, x3);
                if (lane >= 40 && lane < 56) { const float iq = 127.0f / kim[u]; unsigned q4 = 0u; const float xs4[4] = {x0, x1, x2, x3};
#pragma unroll
                    for (int i = 0; i < 4; ++i) { float q = rintf(xs4[i] * iq); q = fminf(fmaxf(q, -127.f), 127.f); q4 |= ((unsigned)(int)q & 0xffu) << (8 * i); }
                    *(GAS unsigned*)(WSP(unsigned char, WS_KIDX) + (size_t)t * 64 + 4 * (lane - 40)) = q4; if (lane == 40) WSP(float, WS_SW)[16384 + t] = kim[u] * (1.0f / 127.0f); }
                if (lane >= 56 && lane < 58) *(GAS f32x4*)(WSP(float, WS_WIDX) + (size_t)t * 8 + 4 * (lane - 56)) = (f32x4){bflo(s.x), bfhi(s.x), bflo(s.y), bfhi(s.y)};
                if (lane < 4) {
                    v4u o;
                    o.x = pk2(x0 * ca[u][0] - y0 * ca[u][1], x1 * ca[u][2] - y1 * ca[u][3]); o.y = pk2(x2 * cb[u][0] - y2 * cb[u][1], x3 * cb[u][2] - y3 * cb[u][3]);
                    o.z = pk2(y0 * ca[u][0] + x0 * ca[u][1], y1 * ca[u][2] + x1 * ca[u][3]); o.w = pk2(y2 * cb[u][0] + x2 * cb[u][1], y3 * cb[u][2] + x3 * cb[u][3]);
                    *(GAS v4u*)(WSP(bf16, WS_KPE) + (size_t)t * 32 + 8 * lane) = o;
                }
            } }
    }
}

constexpr int MLA_KP = 208, MLA_VP = 136;
constexpr int MLA_KOFF = 0, MLA_VOFF = 64 * MLA_KP, MLA_POFF = MLA_VOFF + 64 * MLA_VP, MLA_BUF = 22528;
static_assert(2 * MLA_BUF + 8 * 64 * MLA_KP <= MISC_OFF, "MLA LDS map");
__device__ __forceinline__ void mla_phase(Frame& F) {
    const int lane = F.lane, wave = F.wave, tid = F.tid, hh = lane >> 5, ql = lane & 31;
    const bf16* Qb = WSP(bf16, WS_Q); const bf16* KVb = WSP(bf16, WS_KV); const bf16* KPE = WSP(bf16, WS_KPE); bf16* OA = WSP(bf16, WS_XB);
    const float SC = 0.10206207261596575f * 1.4426950408889634f;
    for (int bh = F.vcu; bh < BATCH * 8; bh += F.G) {
        const int b = bh >> 3, h = bh & 7; const int* posb = F.pos + b * SEQ;
        for (int qb = 0; qb < 4; ++qb) {
            const int q0 = qb * 512 + wave * 64;
            int cq[2]; float mrun[2], lrun[2]; f32x16 o0[2], o1[2];
            LAS unsigned char* QW = F.lds + 2 * MLA_BUF + wave * (64 * MLA_KP);
#pragma unroll
            for (int qs = 0; qs < 2; ++qs) { const size_t tq = (size_t)b * SEQ + q0 + 32 * qs + ql;
#pragma unroll
                for (int s = 0; s < 4; ++s) *(LAS v4u*)(QW + (32 * qs + ql) * MLA_KP + (16 * s + 8 * hh) * 2) = fp8x8_to_bf16x8(*(const GAS v2u*)((const unsigned char*)Qb + tq * 768 + h * 64 + 16 * s + 8 * hh));
#pragma unroll
                for (int s = 0; s < 2; ++s) {
                    const v4u qw = fp8x8_to_bf16x8(*(const GAS v2u*)((const unsigned char*)Qb + tq * 768 + 512 + h * 32 + 16 * s + 8 * hh));
                    const f32x4 ca = *(const GAS f32x4*)(WSP(float, WS_CS) + tq * 32 + 8 * (2 * s + hh)), cb = *(const GAS f32x4*)(WSP(float, WS_CS) + tq * 32 + 8 * (2 * s + hh) + 4);
                    const float a0 = bflo(qw.x), a1 = bfhi(qw.x), a2 = bflo(qw.y), a3 = bfhi(qw.y), b0 = bflo(qw.z), b1 = bfhi(qw.z), b2 = bflo(qw.w), b3 = bfhi(qw.w);
                    v4u ow; ow.x = pk2(a0 * ca[0] - b0 * ca[1], a1 * ca[2] - b1 * ca[3]); ow.y = pk2(a2 * cb[0] - b2 * cb[1], a3 * cb[2] - b3 * cb[3]);
                    ow.z = pk2(b0 * ca[0] + a0 * ca[1], b1 * ca[2] + a1 * ca[3]); ow.w = pk2(b2 * cb[0] + a2 * cb[1], b3 * cb[2] + a3 * cb[3]);
                    *(LAS v4u*)(QW + (32 * qs + ql) * MLA_KP + (64 + 16 * s + 8 * hh) * 2) = ow; }
                cq[qs] = posb[q0 + 32 * qs + ql] >> 6; mrun[qs] = -1e30f; lrun[qs] = 0.f;
#pragma unroll
                for (int i = 0; i < 16; ++i) { o0[qs][i] = 0.f; o1[qs][i] = 0.f; } }
            const int cq_min = __builtin_amdgcn_readfirstlane(posb[q0] >> 6), cq_max = __builtin_amdgcn_readfirstlane(posb[q0 + 63] >> 6);
            const int cq_last = __builtin_amdgcn_readfirstlane(posb[qb * 512 + 511] >> 6), pos0 = __builtin_amdgcn_readfirstlane(posb[0]);
            int nvis = (cq_last + 1) * 64 - pos0; nvis = nvis > SEQ ? SEQ : (nvis < 1 ? 1 : nvis);
            const int ntiles = (nvis + 63) >> 6;
            const int vk = tid >> 3, vc = tid & 7, pk = tid >> 2, pc = tid & 3;
            v2u kr0_8, vr_8; v4u kr1 = (v4u){0u, 0u, 0u, 0u}; int pr = 0;
#define MLA_LOAD(t) do { const size_t tk = (size_t)b * SEQ + (t) * 64; const unsigned char* rowp_ = (const unsigned char*)KVb + (tk + vk) * 1024 + h * 64 + 8 * vc;     \
                kr0_8 = *(const GAS v2u*)(rowp_); vr_8 = *(const GAS v2u*)(rowp_ + 512); \
                if (tid < 256) kr1 = *(const GAS v4u*)(KPE + (tk + pk) * 32 + 8 * pc); if (tid < 64) pr = posb[(t) * 64 + tid]; } while (0)
#define MLA_STORE(buf) do { LAS unsigned char* B_ = F.lds + (buf) * MLA_BUF; const v4u kr0 = fp8x8_to_bf16x8(kr0_8), vr = fp8x8_to_bf16x8(vr_8); \
                *(LAS v4u*)(B_ + MLA_KOFF + vk * MLA_KP + vc * 16) = kr0; if (tid < 256) *(LAS v4u*)(B_ + MLA_KOFF + pk * MLA_KP + (8 + pc) * 16) = kr1; \
                _Pragma("unroll") for (int i_ = 0; i_ < 4; ++i_) { *(LAS unsigned short*)(B_ + MLA_VOFF + (8 * vc + 2 * i_) * MLA_VP + vk * 2) = (unsigned short)(vr[i_] & 0xffffu); \
                    *(LAS unsigned short*)(B_ + MLA_VOFF + (8 * vc + 2 * i_ + 1) * MLA_VP + vk * 2) = (unsigned short)(vr[i_] >> 16); } \
                if (tid < 64) *(LAS int*)(B_ + MLA_POFF + tid * 4) = pr; } while (0)
            __syncthreads();
            MLA_LOAD(0); MLA_STORE(0); __syncthreads();
            for (int t = 0; t < ntiles; ++t) {
                if (t + 1 < ntiles) MLA_LOAD(t + 1);
                const LAS unsigned char* Bc = F.lds + (t & 1) * MLA_BUF;
                const int ckmin = (*(const LAS int*)(Bc + MLA_POFF)) >> 6, ckmax = (*(const LAS int*)(Bc + MLA_POFF + 63 * 4)) >> 6;
                if (ckmin <= cq_max) {
                    f32x16 s0[2], s1[2];
#pragma unroll
                    for (int qs = 0; qs < 2; ++qs)
#pragma unroll
                        for (int i = 0; i < 16; ++i) { s0[qs][i] = 0.f; s1[qs][i] = 0.f; }
                    bf16x8 kf[2][2], qa_, qb_;
#define MLA_KFR(d_, s_) do { kf[d_][0] = *(const LAS bf16x8*)(Bc + MLA_KOFF + ql * MLA_KP + (16 * (s_) + 8 * hh) * 2); kf[d_][1] = *(const LAS bf16x8*)(Bc + MLA_KOFF + (32 + ql) * MLA_KP + (16 * (s_) + 8 * hh) * 2); } while (0)
                    MLA_KFR(0, 0);
#pragma unroll
                    for (int s = 0; s < 6; ++s) {
                        qa_ = *(const LAS bf16x8*)(QW + ql * MLA_KP + (16 * s + 8 * hh) * 2); qb_ = *(const LAS bf16x8*)(QW + (32 + ql) * MLA_KP + (16 * s + 8 * hh) * 2);
                        if (s + 1 < 6) MLA_KFR((s + 1) & 1, s + 1);
                        __builtin_amdgcn_sched_barrier(0);
                        s0[0] = MFMA32(kf[s & 1][0], qa_, s0[0]); s1[0] = MFMA32(kf[s & 1][1], qa_, s1[0]); s0[1] = MFMA32(kf[s & 1][0], qb_, s0[1]); s1[1] = MFMA32(kf[s & 1][1], qb_, s1[1]);
                        __builtin_amdgcn_sched_barrier(0);
                    }
#undef MLA_KFR
                    if (ckmax > cq_min) {
#pragma unroll
                        for (int rg = 0; rg < 4; ++rg) {
                            const v4u p0 = *(const LAS v4u*)(Bc + MLA_POFF + (8 * rg + 4 * hh) * 4), p1 = *(const LAS v4u*)(Bc + MLA_POFF + (32 + 8 * rg + 4 * hh) * 4);
#pragma unroll
                            for (int qs = 0; qs < 2; ++qs)
#pragma unroll
                                for (int i = 0; i < 4; ++i) { if (((int)p0[i] >> 6) > cq[qs]) s0[qs][4 * rg + i] = -1e30f; if (((int)p1[i] >> 6) > cq[qs]) s1[qs][4 * rg + i] = -1e30f; }
                        }
                    }
                    bf16x8 pf[2][2][2];
#pragma unroll
                    for (int qs = 0; qs < 2; ++qs) {
                        float mx = fmaxf(fmaxf(s0[qs][0], s0[qs][1]), s1[qs][0]);
#pragma unroll
                        for (int i = 2; i < 16; i += 2) mx = fmaxf(fmaxf(mx, s0[qs][i]), s0[qs][i + 1]);
#pragma unroll
                        for (int i = 1; i < 16; i += 2) mx = fmaxf(fmaxf(mx, s1[qs][i]), s1[qs][(i + 1) & 15]);
                        mx = xhalf_max(mx);
                        const float mcand = mx * SC;
                        if (__builtin_amdgcn_ballot_w64(mcand > mrun[qs] + 8.0f) != 0ull) {
                            const float mnew_ = fmaxf(mrun[qs], mcand); const float al = __builtin_amdgcn_exp2f(mrun[qs] - mnew_); lrun[qs] *= al; mrun[qs] = mnew_;
#pragma unroll
                            for (int i = 0; i < 16; ++i) { o0[qs][i] *= al; o1[qs][i] *= al; }
                        }
                        const float mnew = mrun[qs];
                        float ps = 0.f;
#pragma unroll
                        for (int i = 0; i < 16; ++i) { s0[qs][i] = __builtin_amdgcn_exp2f(fmaf(s0[qs][i], SC, -mnew)); s1[qs][i] = __builtin_amdgcn_exp2f(fmaf(s1[qs][i], SC, -mnew)); ps += s0[qs][i] + s1[qs][i]; }
                        lrun[qs] += ps;
#pragma unroll
                        for (int s2 = 0; s2 < 2; ++s2) {
                            v4u w0, w1;
                            w0.x = pk2(s0[qs][8 * s2 + 0], s0[qs][8 * s2 + 1]); w0.y = pk2(s0[qs][8 * s2 + 2], s0[qs][8 * s2 + 3]); w0.z = pk2(s0[qs][8 * s2 + 4], s0[qs][8 * s2 + 5]); w0.w = pk2(s0[qs][8 * s2 + 6], s0[qs][8 * s2 + 7]);
                            w1.x = pk2(s1[qs][8 * s2 + 0], s1[qs][8 * s2 + 1]); w1.y = pk2(s1[qs][8 * s2 + 2], s1[qs][8 * s2 + 3]); w1.z = pk2(s1[qs][8 * s2 + 4], s1[qs][8 * s2 + 5]); w1.w = pk2(s1[qs][8 * s2 + 6], s1[qs][8 * s2 + 7]);
                            pf[qs][0][s2] = __builtin_bit_cast(bf16x8, w0); pf[qs][1][s2] = __builtin_bit_cast(bf16x8, w1);
                        }
                    }
#pragma unroll
                    for (int kb = 0; kb < 2; ++kb)
#pragma unroll
                        for (int s2 = 0; s2 < 2; ++s2) {
                            const int ko = (32 * kb + 16 * s2 + 4 * hh) * 2;
                            const v2u a0 = *(const LAS v2u*)(Bc + MLA_VOFF + ql * MLA_VP + ko), a1 = *(const LAS v2u*)(Bc + MLA_VOFF + ql * MLA_VP + ko + 16);
                            const v2u c0 = *(const LAS v2u*)(Bc + MLA_VOFF + (32 + ql) * MLA_VP + ko), c1 = *(const LAS v2u*)(Bc + MLA_VOFF + (32 + ql) * MLA_VP + ko + 16);
                            const v4u va = (v4u){a0.x, a0.y, a1.x, a1.y}, vb = (v4u){c0.x, c0.y, c1.x, c1.y};
#pragma unroll
                            for (int qs = 0; qs < 2; ++qs) { o0[qs] = MFMA32(__builtin_bit_cast(bf16x8, va), pf[qs][kb][s2], o0[qs]); o1[qs] = MFMA32(__builtin_bit_cast(bf16x8, vb), pf[qs][kb][s2], o1[qs]); }
                        }
                }
                if (t + 1 < ntiles) MLA_STORE((t + 1) & 1);
                __syncthreads();
            }
#undef MLA_LOAD
#undef MLA_STORE
#pragma unroll
            for (int qs = 0; qs < 2; ++qs) {
                const float inv = 32.0f / xhalf_sum(lrun[qs]);
                unsigned char* orow = (unsigned char*)OA + ((size_t)b * SEQ + q0 + 32 * qs + ql) * 1024 + h * 64;
#pragma unroll
                for (int rg = 0; rg < 4; ++rg) {
                    *(GAS unsigned*)(orow + 8 * rg + 4 * hh) = pk4_fp8(o0[qs][4 * rg] * inv, o0[qs][4 * rg + 1] * inv, o0[qs][4 * rg + 2] * inv, o0[qs][4 * rg + 3] * inv);
                    *(GAS unsigned*)(orow + 32 + 8 * rg + 4 * hh) = pk4_fp8(o1[qs][4 * rg] * inv, o1[qs][4 * rg + 1] * inv, o1[qs][4 * rg + 2] * inv, o1[qs][4 * rg + 3] * inv);
                }
            }
        }
    }
}

__device__ __forceinline__ int t5_bucket(int rel) {
    const int n = rel < 0 ? -rel : rel; const int ret = rel > 0 ? 16 : 0;
    int large = 8 + (int)(log2f((float)(n < 1 ? 1 : n) * 0.125f) * 2.0f); large = large > 15 ? 15 : large;
    return ret + (n < 8 ? n : large);
}
constexpr int DSA_POS_OFF = 0, DSA_BT_OFF = 8192  , DSA_WAVE_OFF = 12288, DSA_VP = 160  , DSA_WAVE_BYTES = 18688  ,
              DSA_LIST_OFF = 16384, DSA_LIST_STRIDE = 544  , DSA_KCNT_OFF = 16384 + 2176, DSA_PBUF_OFF = 0;
constexpr int DSA_SENT = (DSA_WAVE_OFF + 8 * DSA_WAVE_BYTES) / 4;
static_assert(DSA_WAVE_OFF + 8 * DSA_WAVE_BYTES + 16 <= MISC_OFF && DSA_SENT < 65536, "DSA LDS map");
__device__ __forceinline__ int half32_sum(int v) {
    v += __builtin_amdgcn_update_dpp(0, v, 0x111, 0xf, 0xf, true);
    v += __builtin_amdgcn_update_dpp(0, v, 0x112, 0xf, 0xf, true);
    v += __builtin_amdgcn_update_dpp(0, v, 0x114, 0xf, 0xf, true);
    v += __builtin_amdgcn_update_dpp(0, v, 0x118, 0xf, 0xf, true);
    v += __builtin_amdgcn_update_dpp(0, v, 0x142, 0xa, 0xf, true);
    const int lo = __builtin_amdgcn_readlane(v, 31), hi = __builtin_amdgcn_readlane(v, 63);
    return (threadIdx.x & 32) ? hi : lo;
}
__device__ __forceinline__ void dsa_select(const unsigned (&kA)[64], int nq, int hq, int kl, LAS unsigned short* LISTQ, LAS int* KCNTQ, int nkb) {
    const int KQ = nq < 256 ? nq : 256;
    unsigned T = 0u; bool done = false; int gq = 2048;
    if (nq <= 256) { T = 0x00800000u; done = true; gq = nq; }
    for (int bit = 31; bit >= 0; --bit) {
        if (__builtin_amdgcn_ballot_w64(!done) == 0ull) break;
        const unsigned cand = T | (1u << bit); int n_ = 0;
#pragma unroll
        for (int q4 = 0; q4 < 4; ++q4) { if (16 * q4 < nkb) {
#pragma unroll
            for (int kb = 16 * q4; kb < 16 * q4 + 16; ++kb) n_ += (kA[kb] >= cand) ? 1 : 0; } }
        n_ = half32_sum(n_);
        if (!done && n_ >= KQ) { T = cand; gq = n_; done = (n_ == KQ); }
    }
                const unsigned ltmask = (1u << kl) - 1u; int base = 0;
    const bool ties = __builtin_amdgcn_ballot_w64(gq != KQ) != 0ull;
    if (!ties) {
#pragma unroll
        for (int q4 = 0; q4 < 4; ++q4) { if (16 * q4 < nkb) {
#pragma unroll
        for (int kb = 16 * q4; kb < 16 * q4 + 16; ++kb) {
            const bool sel = kA[kb] >= T;
            const unsigned long long bal = __builtin_amdgcn_ballot_w64(sel);
            const unsigned w = hq ? (unsigned)(bal >> 32) : (unsigned)bal;
            LISTQ[sel ? base + __popc(w & ltmask) : 271] = (unsigned short)(32 * kb + kl);
            base += __popc(w);
        } } }
    } else {
        int gt = 0;
#pragma unroll
        for (int kb = 0; kb < 64; ++kb) gt += (kA[kb] > T) ? 1 : 0;
        gt = half32_sum(gt);
        int rem = KQ - gt;
#pragma unroll
        for (int kb = 0; kb < 64; ++kb) {
            const unsigned long long gb_ = __builtin_amdgcn_ballot_w64(kA[kb] > T), eb_ = __builtin_amdgcn_ballot_w64(kA[kb] == T);
            unsigned e = hq ? (unsigned)(eb_ >> 32) : (unsigned)eb_; const int c = __popc(e), take = c < rem ? c : rem;
            for (int dr = c - take; dr > 0; --dr) e &= ~(0x80000000u >> __builtin_clz(e));
            rem -= take; const unsigned w = (hq ? (unsigned)(gb_ >> 32) : (unsigned)gb_) | e;
            if ((w >> kl) & 1u) LISTQ[base + __popc(w & ltmask)] = (unsigned short)(32 * kb + kl);
            base += __popc(w);
        }
    }
    for (int s_ = base + kl; s_ < 272; s_ += 32) LISTQ[s_] = (unsigned short)DSA_SENT;
    if (kl == 0) *KCNTQ = base;
}
__device__ __forceinline__ void dsa_phase(Frame& F) {
    const int lane = F.lane, wave = F.wave, tid = F.tid, hq = lane >> 5, kl = lane & 31;
    const bf16* Hb = WSP(bf16, WS_H); const unsigned char* KIDX8 = WSP(unsigned char, WS_KIDX); const float* SKI = WSP(float, WS_SW) + 16384; const unsigned char* KB8 = WSP(unsigned char, WS_KB); const bf16* VBb = WSP(bf16, WS_VB);
    const float* WIDX = WSP(float, WS_WIDX); bf16* OB = (bf16*)(F.ws + WS_XB + 512);
    LAS int* POSB = (LAS int*)(F.lds + DSA_POS_OFF); LAS _Float16* BT = (LAS _Float16*)(F.lds + DSA_BT_OFF);
    LAS unsigned char* WL = F.lds + DSA_WAVE_OFF + wave * DSA_WAVE_BYTES;
    LAS float* PBUF = (LAS float*)(WL + DSA_PBUF_OFF); LAS int* KCNT = (LAS int*)(WL + DSA_KCNT_OFF);
    __syncthreads();
    for (int i = tid; i < 2048; i += NWAVES * 64) { const int e = i >> 3; const int bk = t5_bucket(e < 255 ? e - 127 : 127); BT[i] = e < 255 ? (_Float16)F.a->in[10][bk * 8 + (i & 7)] : (_Float16)(-65504.0f); }
    if (tid == 0) POSB[DSA_SENT] = 0x3fffffff;
    const float NEG_INF = -__builtin_inff();
    for (int gid = F.vcu; gid < 2048; gid += F.G) {
        const int rr = gid >> 8, cu = gid & 255, xq = cu >> 5, jj = cu & 31, b = 4 * xq + (jj & 3), cc = jj >> 2, tile = 8 * rr + ((rr & 1) ? 7 - cc : cc);
        const int* posb = F.pos + b * SEQ;
        __syncthreads();
        *(LAS v4u*)(POSB + 4 * tid) = *(const GAS v4u*)(posb + 4 * tid);
        __syncthreads();
        const int q0 = tile * 32 + wave * 4;
        typedef int i32x16 __attribute__((ext_vector_type(16)));
        i32x4 Aq8[2]; float sqrow;
        { const int jj = kl >> 3, hhr = (kl >> 2) & 1, ii = kl & 3, qiA = 2 * hhr + (jj >> 1), hdA = 4 * (jj & 1) + ii; const size_t tA = (size_t)b * SEQ + q0 + qiA;
          float qf[2][16]; float am = 0.f;
#pragma unroll
          for (int s = 0; s < 2; ++s) { const v4u w8 = *(const GAS v4u*)((const unsigned char*)(Hb + tA * HW) + H_QIDX + hdA * 64 + 32 * s + 16 * hq);
#pragma unroll
              for (int i = 0; i < 4; ++i) { const f32x2p lo = __builtin_amdgcn_cvt_pk_f32_fp8((int)w8[i], false), hi = __builtin_amdgcn_cvt_pk_f32_fp8((int)w8[i], true);
                  qf[s][4 * i] = lo.x; qf[s][4 * i + 1] = lo.y; qf[s][4 * i + 2] = hi.x; qf[s][4 * i + 3] = hi.y; }
#pragma unroll
              for (int i = 0; i < 16; ++i) am = fmaxf(am, fabsf(qf[s][i])); }
          am = fmaxf(am, __shfl_xor(am, 32)); sqrow = am > 0.f ? am * (1.0f / 127.0f) : 1.0f; const float isq = 1.0f / sqrow;
#pragma unroll
          for (int s = 0; s < 2; ++s)
#pragma unroll
              for (int w = 0; w < 4; ++w) { unsigned q4 = 0u;
#pragma unroll
                  for (int i = 0; i < 4; ++i) { float q = rintf(qf[s][4 * w + i] * isq); q = fminf(fmaxf(q, -127.f), 127.f); q4 |= ((unsigned)(int)q & 0xffu) << (8 * i); }
                  Aq8[s][w] = (int)q4; } }
        const size_t tq0 = (size_t)b * SEQ + q0 + 2 * hq;
        float wv[16];
        { const f32x4 w0a = *(const GAS f32x4*)(WIDX + tq0 * 8), w0b = *(const GAS f32x4*)(WIDX + tq0 * 8 + 4), w1a = *(const GAS f32x4*)(WIDX + tq0 * 8 + 8), w1b = *(const GAS f32x4*)(WIDX + tq0 * 8 + 12);
          const float wb[16] = {w0a[0], w0a[1], w0a[2], w0a[3], w0b[0], w0b[1], w0b[2], w0b[3], w1a[0], w1a[1], w1a[2], w1a[3], w1b[0], w1b[1], w1b[2], w1b[3]};
#pragma unroll
          for (int v = 0; v < 16; ++v) { const int rsrc = 8 * (2 * (v >> 3) + ((v & 7) >> 2)) + 4 * hq + (v & 3); wv[v] = wb[v] * __shfl(sqrow, rsrc); } }
        const int cq0 = POSB[q0 + 2 * hq] >> 6, cq1 = POSB[q0 + 2 * hq + 1] >> 6;
        int nvis = ((POSB[q0 + 3] >> 6) + 1) * 64 - POSB[0]; nvis = nvis > SEQ ? SEQ : (nvis < 1 ? 1 : nvis);
        const int nkb = __builtin_amdgcn_readfirstlane((nvis + 31) >> 5);
        LAS unsigned* KBL = (LAS unsigned*)WL;
        unsigned kA[64]; int nA = 0, nB = 0;
        const unsigned char* kp = KIDX8 + ((size_t)b * SEQ + kl) * 64 + 16 * hq;
        const float* skp = SKI + (size_t)b * SEQ + kl;
        i32x4 kr[8][2]; float skr[8];
#pragma unroll
        for (int j = 0; j < 7; ++j) { const int jb = j < nkb ? j : nkb - 1; kr[j][0] = *(const GAS i32x4*)(kp + (size_t)jb * 2048); kr[j][1] = *(const GAS i32x4*)(kp + (size_t)jb * 2048 + 32); skr[j] = skp[jb * 32]; }
        { const int lastb = (nkb > 7 ? 6 : nkb - 1); kp += (size_t)lastb * 2048; skp += lastb * 32; }
#pragma unroll
        for (int kb = 0; kb < 64; ++kb) {
            if (kb < nkb) {
                const int key = 32 * kb + kl;
                if (kb + 7 < nkb) { kp += 2048; skp += 32; }
                kr[(kb + 7) & 7][0] = *(const GAS i32x4*)kp; kr[(kb + 7) & 7][1] = *(const GAS i32x4*)(kp + 32); skr[(kb + 7) & 7] = *skp;
                i32x16 acc;
#pragma unroll
                for (int i = 0; i < 16; ++i) acc[i] = 0;
                acc = __builtin_amdgcn_mfma_i32_32x32x32_i8(Aq8[0], kr[kb & 7][0], acc, 0, 0, 0);
                acc = __builtin_amdgcn_mfma_i32_32x32x32_i8(Aq8[1], kr[kb & 7][1], acc, 0, 0, 0);
                const int ck = POSB[key] >> 6;
                float sa = 0.f, sb = 0.f;
#pragma unroll
                for (int hd_ = 0; hd_ < 8; ++hd_) { const int a_ = acc[hd_] > 0 ? acc[hd_] : 0, b_ = acc[8 + hd_] > 0 ? acc[8 + hd_] : 0; sa += wv[hd_] * (float)a_; sb += wv[8 + hd_] * (float)b_; }
                sa *= skr[kb & 7]; sb *= skr[kb & 7];
                const bool ma = ck <= cq0, mb = ck <= cq1;
                nA += ma ? 1 : 0; nB += mb ? 1 : 0;
                const unsigned ua = __float_as_uint(ma ? sa + 0.0f : NEG_INF), ub = __float_as_uint(mb ? sb + 0.0f : NEG_INF);
                kA[kb] = ua ^ ((unsigned)((int)ua >> 31) | 0x80000000u); KBL[kb * 64 + lane] = ub ^ ((unsigned)((int)ub >> 31) | 0x80000000u);
            } else { kA[kb] = 0x007fffffu; KBL[kb * 64 + lane] = 0x007fffffu; }
        }
#pragma unroll
        for (int o = 1; o < 32; o <<= 1) { nA += __shfl_xor(nA, o); nB += __shfl_xor(nB, o); }
#if DSA_SKIP != 2
        dsa_select(kA, nA, hq, kl, (LAS unsigned short*)(WL + DSA_LIST_OFF + (2 * hq) * DSA_LIST_STRIDE), KCNT + 2 * hq, nkb);
#pragma unroll
        for (int kb = 0; kb < 64; ++kb) kA[kb] = KBL[kb * 64 + lane];
        dsa_select(kA, nB, hq, kl, (LAS unsigned short*)(WL + DSA_LIST_OFF + (2 * hq + 1) * DSA_LIST_STRIDE), KCNT + 2 * hq + 1, nkb);
#endif
#if DSA_SKIP == 0
        const int hd = lane & 15, g4 = lane >> 4;
        const unsigned char* vsrc8 = (const unsigned char*)VBb + (size_t)b * SEQ * 64;
        const int vrr = lane >> 2;
        const unsigned vx_hi = (unsigned)(((lane >> 4) & 1) << 1);
        unsigned vrd[4];
        { const int rp = (lane & 15) >> 1, keyr = rp < 4 ? 4 * g4 + rp : 16 + 4 * g4 + (rp - 4); const unsigned xk = (unsigned)(((keyr >> 4) & 1) | (((keyr >> 2) & 1) << 1));
#pragma unroll
          for (int d = 0; d < 4; ++d) vrd[d] = (unsigned)(size_t)WL + (unsigned)(keyr * 64) + ((((unsigned)d) ^ xk) << 4) + 8u * (lane & 1); }
        v4u kw[16]; v2u qwr[2];
#define DSA_KQ_LOAD(qn) do { const LAS unsigned short* LISTn_ = (const LAS unsigned short*)(WL + DSA_LIST_OFF + (qn) * DSA_LIST_STRIDE); const int nblkn_ = (__builtin_amdgcn_readfirstlane(KCNT[qn]) + 15) >> 4; \
            _Pragma("unroll") for (int c = 0; c < 2; ++c) qwr[c] = *(const GAS v2u*)((const unsigned char*)(Hb + ((size_t)b * SEQ + q0 + (qn)) * HW) + H_QB + (hd & 7) * 64 + 32 * c + 8 * g4);     \
            int kidx_[16]; _Pragma("unroll") for (int blk = 0; blk < 16; ++blk) { const int idl_ = (int)LISTn_[16 * blk + hd]; kidx_[blk] = idl_ < 2047 ? idl_ : 2047; }     \
            __builtin_amdgcn_sched_barrier(0);                             \
            _Pragma("unroll") for (int blk = 0; blk < 16; ++blk) kw[blk] = *(const GAS v4u*)(KB8 + ((size_t)b * SEQ + kidx_[blk]) * 64 + 16 * g4); } while (0)
        DSA_KQ_LOAD(0);
        for (int qq_ = 0; qq_ < 4 * DSA_REP; ++qq_) { const int q = qq_ & 3;
            const LAS unsigned short* LIST = (const LAS unsigned short*)(WL + DSA_LIST_OFF + q * DSA_LIST_STRIDE);
            const int L = __builtin_amdgcn_readfirstlane(KCNT[q]), nblk = (L + 15) >> 4, L16 = 16 * nblk;
            const size_t tq = (size_t)b * SEQ + q0 + q; const int posq = POSB[q0 + q];
            {
#pragma unroll 8
              for (int it = 0; it < 16; ++it) { const int slot_ = 16 * it + vrr; const int l_ = (int)LIST[slot_]; const int idx_ = l_ < 2047 ? l_ : 2047;
                  __builtin_amdgcn_global_load_lds((const unsigned*)(vsrc8 + (size_t)idx_ * 64 + ((((unsigned)(lane & 3)) ^ ((unsigned)(it & 1) | vx_hi)) << 4)), (LAS unsigned*)(WL + it * 1024), 16, 0, 0); } }
            long Bq8[2];
#pragma unroll
            for (int c = 0; c < 2; ++c) Bq8[c] = (long)(((unsigned long long)qwr[c].y << 32) | qwr[c].x);
            float lg[16][4]; float mx = -1e30f;
            { v2u id4s[16];
#pragma unroll
              for (int blk = 0; blk < 16; ++blk) id4s[blk] = *(const LAS v2u*)(LIST + 16 * blk + 4 * g4);
              __builtin_amdgcn_sched_barrier(0);
              int ps[16][4];
#pragma unroll
              for (int blk = 0; blk < 16; ++blk) { const v2u id4 = id4s[blk];
                  ps[blk][0] = POSB[id4.x & 0xffffu]; ps[blk][1] = POSB[id4.x >> 16]; ps[blk][2] = POSB[id4.y & 0xffffu]; ps[blk][3] = POSB[id4.y >> 16]; }
              __builtin_amdgcn_sched_barrier(0);
#pragma unroll
              for (int blk = 0; blk < 16; ++blk)
#pragma unroll
                  for (int i = 0; i < 4; ++i) { int rel = ps[blk][i] - posq; rel = rel < -127 ? -127 : (rel > 128 ? 128 : rel);
                      lg[blk][i] = (float)BT[(rel + 127) * 8 + (hd & 7)]; }
              __builtin_amdgcn_sched_barrier(0); }
#pragma unroll
            for (int blk = 0; blk < 16; ++blk) {
                f32x4 acc = (f32x4){0.f, 0.f, 0.f, 0.f};
                acc = __builtin_amdgcn_mfma_f32_16x16x32_fp8_fp8((long)(((unsigned long long)kw[blk].y << 32) | kw[blk].x), Bq8[0], acc, 0, 0, 0);
                acc = __builtin_amdgcn_mfma_f32_16x16x32_fp8_fp8((long)(((unsigned long long)kw[blk].w << 32) | kw[blk].z), Bq8[1], acc, 0, 0, 0);
#pragma unroll
                for (int i = 0; i < 4; ++i) { const float v = acc[i] * 0.125f + lg[blk][i]; lg[blk][i] = v; mx = fmaxf(mx, v); }
            }
            const bool more = qq_ + 1 < 4 * DSA_REP;
            mx = fmaxf(mx, __shfl_xor(mx, 16)); mx = xhalf_max(mx);
            const float ex0 = 8.0f - mx * 1.4426950408889634f;
            long pf8[8];
#pragma unroll
            for (int c = 0; c < 8; ++c) {
                float e[8];
#pragma unroll
                for (int i = 0; i < 4; ++i) { e[i] = __builtin_amdgcn_exp2f(fmaf(lg[2 * c][i], 1.4426950408889634f, ex0)); e[4 + i] = __builtin_amdgcn_exp2f(fmaf(lg[2 * c + 1][i], 1.4426950408889634f, ex0)); }
                int plo = 0, phi = 0; plo = __builtin_amdgcn_cvt_pk_fp8_f32(e[0], e[1], plo, false); plo = __builtin_amdgcn_cvt_pk_fp8_f32(e[2], e[3], plo, true);
                phi = __builtin_amdgcn_cvt_pk_fp8_f32(e[4], e[5], phi, false); phi = __builtin_amdgcn_cvt_pk_fp8_f32(e[6], e[7], phi, true);
                pf8[c] = (long)(((unsigned long long)(unsigned)phi << 32) | (unsigned)plo);
            }
            if (more) DSA_KQ_LOAD((qq_ + 1) & 3);
            f32x4 oacc[4], osum = (f32x4){0.f, 0.f, 0.f, 0.f};
#pragma unroll
            for (int d = 0; d < 4; ++d) oacc[d] = (f32x4){0.f, 0.f, 0.f, 0.f};
            if (more) asm volatile("s_waitcnt vmcnt(18)" ::: "memory"); else asm volatile("s_waitcnt vmcnt(0)" ::: "memory");
            v2u tv_[8][4];
#pragma unroll
            for (int gc = 0; gc < 8; ++gc)
                asm volatile("ds_read_b64_tr_b8 %0, %4 offset:%8\n\tds_read_b64_tr_b8 %1, %5 offset:%8\n\tds_read_b64_tr_b8 %2, %6 offset:%8\n\tds_read_b64_tr_b8 %3, %7 offset:%8"
                             : "=&v"(tv_[gc][0]), "=&v"(tv_[gc][1]), "=&v"(tv_[gc][2]), "=&v"(tv_[gc][3]) : "v"(vrd[0]), "v"(vrd[1]), "v"(vrd[2]), "v"(vrd[3]), "i"(gc * 2048) : "memory");
            asm volatile("s_waitcnt lgkmcnt(0)" : "+v"(tv_[0][0]), "+v"(tv_[0][1]), "+v"(tv_[0][2]), "+v"(tv_[0][3]), "+v"(tv_[1][0]), "+v"(tv_[1][1]), "+v"(tv_[1][2]), "+v"(tv_[1][3]) :: "memory");
            asm volatile("" : "+v"(tv_[2][0]), "+v"(tv_[2][1]), "+v"(tv_[2][2]), "+v"(tv_[2][3]), "+v"(tv_[3][0]), "+v"(tv_[3][1]), "+v"(tv_[3][2]), "+v"(tv_[3][3]) :: "memory");
            asm volatile("" : "+v"(tv_[4][0]), "+v"(tv_[4][1]), "+v"(tv_[4][2]), "+v"(tv_[4][3]), "+v"(tv_[5][0]), "+v"(tv_[5][1]), "+v"(tv_[5][2]), "+v"(tv_[5][3]) :: "memory");
            asm volatile("" : "+v"(tv_[6][0]), "+v"(tv_[6][1]), "+v"(tv_[6][2]), "+v"(tv_[6][3]), "+v"(tv_[7][0]), "+v"(tv_[7][1]), "+v"(tv_[7][2]), "+v"(tv_[7][3]) :: "memory");
#pragma unroll
            for (int gc = 0; gc < 8; ++gc) { const long pb = pf8[gc];
                osum = __builtin_amdgcn_mfma_f32_16x16x32_fp8_fp8((long)0x3838383838383838ll, pb, osum, 0, 0, 0);
#pragma unroll
                for (int d = 0; d < 4; ++d) oacc[d] = __builtin_amdgcn_mfma_f32_16x16x32_fp8_fp8((long)(((unsigned long long)tv_[gc][d].y << 32) | tv_[gc][d].x), pb, oacc[d], 0, 0, 0); }
            const float inv32 = 32.0f / osum[0];
            if (hd < 8) {
#pragma unroll
                for (int d = 0; d < 4; ++d) *(GAS unsigned*)((unsigned char*)OB + tq * 1024 + hd * 64 + 16 * d + 4 * g4) = pk4_fp8(oacc[d][0] * inv32, oacc[d][1] * inv32, oacc[d][2] * inv32, oacc[d][3] * inv32);
            }
        }
#else
        { unsigned keep = 0u;
#if DSA_SKIP == 2
#pragma unroll
          for (int kb = 0; kb < 64; ++kb) keep ^= kA[kb];
          keep ^= (unsigned)(nA + nB);
#endif
          for (int q = 0; q < 4; ++q)
#pragma unroll
              for (int i = 0; i < 8; ++i) *(GAS unsigned short*)(OB + ((size_t)b * SEQ + q0 + q) * 512 + i * 64 + lane) = (unsigned short)((keep == 0x12345u) ? 1u : 0u); }
#endif
    }
}

__device__ __forceinline__ void ln1_phase(Frame& F) {
    constexpr int U = 4;
    const int gw = F.vcu * NWAVES + F.wave, NGW = F.G * NWAVES, lane = F.lane;
    const bf16* Y = WSP(bf16, WS_H);
    f32x4 g[4], bb[4];
#pragma unroll
    for (int j = 0; j < 4; ++j) { g[j] = *((const GAS f32x4*)F.a->in[12] + lane + 64 * j); bb[j] = *((const GAS f32x4*)F.a->in[13] + lane + 64 * j); }
    for (int t0 = gw; t0 < M; t0 += NGW * U) {
        f32x4 v[U][4]; float s[U], s2[U], am[U];
#pragma unroll
        for (int u = 0; u < U; ++u) { const int t = t0 + u * NGW < M ? t0 + u * NGW : t0; const GAS v2u* yr = (const GAS v2u*)(Y + (size_t)t * D) + lane;
#pragma unroll
            for (int j = 0; j < 4; ++j) { const v2u w = yr[64 * j]; v[u][j] = (f32x4){bflo(w.x), bfhi(w.x), bflo(w.y), bfhi(w.y)}; } }
#pragma unroll
        for (int u = 0; u < U; ++u) { s[u] = 0.f;
#pragma unroll
            for (int j = 0; j < 4; ++j) s[u] += (v[u][j][0] + v[u][j][1]) + (v[u][j][2] + v[u][j][3]); }
        wave_sum_n<U>(s);
#pragma unroll
        for (int u = 0; u < U; ++u) { const float mean = s[u] * (1.f / D); s2[u] = 0.f;
#pragma unroll
            for (int j = 0; j < 4; ++j) { v[u][j] = v[u][j] - mean; s2[u] += (v[u][j][0] * v[u][j][0] + v[u][j][1] * v[u][j][1]) + (v[u][j][2] * v[u][j][2] + v[u][j][3] * v[u][j][3]); } }
        wave_sum_n<U>(s2);
#pragma unroll
        for (int u = 0; u < U; ++u) { const float rstd = 1.f / sqrtf(s2[u] * (1.f / D) + LN_EPS); am[u] = 0.f;
#pragma unroll
            for (int j = 0; j < 4; ++j) { v[u][j] = v[u][j] * rstd * g[j] + bb[j]; am[u] = fmaxf(am[u], fmaxf(fmaxf(fabsf(v[u][j][0]), fabsf(v[u][j][1])), fmaxf(fabsf(v[u][j][2]), fabsf(v[u][j][3])))); } }
        wave_max_n<U>(am);
#pragma unroll
        for (int u = 0; u < U; ++u) { const int t = t0 + u * NGW; if (t < M) {
            const float xm = am[u] > 0.f ? am[u] * 1.01f : 1.0f, isq = 119.0f / xm;
#pragma unroll
            for (int j = 0; j < 4; ++j) {
                unsigned q4 = 0u;
#pragma unroll
                for (int i = 0; i < 4; ++i) { float q = rintf(v[u][j][i] * isq); q = fminf(fmaxf(q, -119.f), 119.f); q4 |= ((unsigned)(int)q & 0xffu) << (8 * i); }
                *((GAS unsigned*)(F.ws + WS_X1Q + (size_t)t * D) + lane + 64 * j) = q4; }
            if (lane == 0) WSP(float, WS_SX)[t] = xm * (1.0f / 119.0f); } }
    }
}

template <int OFF> __device__ __forceinline__ void sort16_desc(float (&x)[64]) {
#define S16_CE(i, j) { const float hi_ = fmaxf(x[OFF + (i)], x[OFF + (j)]), lo_ = fminf(x[OFF + (i)], x[OFF + (j)]); x[OFF + (i)] = hi_; x[OFF + (j)] = lo_; }
    S16_CE(0, 13) S16_CE(1, 12) S16_CE(2, 15) S16_CE(3, 14) S16_CE(4, 8) S16_CE(5, 6) S16_CE(7, 11) S16_CE(9, 10)
    S16_CE(0, 5) S16_CE(1, 7) S16_CE(2, 9) S16_CE(3, 4) S16_CE(6, 13) S16_CE(8, 14) S16_CE(10, 15) S16_CE(11, 12)
    S16_CE(0, 1) S16_CE(2, 3) S16_CE(4, 5) S16_CE(6, 8) S16_CE(7, 9) S16_CE(10, 11) S16_CE(12, 13) S16_CE(14, 15)
    S16_CE(0, 2) S16_CE(1, 3) S16_CE(4, 10) S16_CE(5, 11) S16_CE(6, 7) S16_CE(8, 9) S16_CE(12, 14) S16_CE(13, 15)
    S16_CE(1, 2) S16_CE(3, 12) S16_CE(4, 6) S16_CE(5, 7) S16_CE(8, 10) S16_CE(9, 11) S16_CE(13, 14)
    S16_CE(1, 4) S16_CE(2, 6) S16_CE(5, 8) S16_CE(7, 10) S16_CE(9, 13) S16_CE(11, 14)
    S16_CE(2, 4) S16_CE(3, 6) S16_CE(9, 12) S16_CE(11, 13)
    S16_CE(3, 5) S16_CE(6, 8) S16_CE(7, 9) S16_CE(10, 12)
    S16_CE(3, 4) S16_CE(5, 6) S16_CE(7, 8) S16_CE(9, 10) S16_CE(11, 12)
    S16_CE(6, 7) S16_CE(8, 9)
#undef S16_CE
}
template <int OFF> __device__ __forceinline__ void bitonic_merge16_desc(float (&x)[64]) {
#pragma unroll
    for (int j = 8; j > 0; j >>= 1)
#pragma unroll
        for (int i = 0; i < 16; ++i) { const int l = i ^ j; if (l > i) { const float hi = fmaxf(x[OFF + i], x[OFF + l]), lo = fminf(x[OFF + i], x[OFF + l]); x[OFF + i] = hi; x[OFF + l] = lo; } }
}
template <int OFF, int OFFB> __device__ __forceinline__ void merge_top16(float (&x)[64]) {
#pragma unroll
    for (int i = 0; i < 16; ++i) x[OFF + i] = fmaxf(x[OFF + i], x[OFFB + 15 - i]);
    bitonic_merge16_desc<OFF>(x);
}
__device__ __forceinline__ void top16_of_64(float (&x)[64]) {
    sort16_desc<0>(x); sort16_desc<16>(x); sort16_desc<32>(x); sort16_desc<48>(x);
    merge_top16<0, 16>(x); merge_top16<32, 48>(x); merge_top16<0, 32>(x);
}
__device__ __forceinline__ void route_phase(Frame& F) {
    const int lane = F.lane, hh = lane >> 5, tl = lane & 31;
    const bf16* QP = (const bf16*)(F.ws + WS_H + 256 * MiB); const bf16* SUBK = WSP(bf16, WS_SUBK);
    unsigned short* EIDX = WSP(unsigned short, WS_Q); bf16* GATE = (bf16*)(F.ws + WS_Q + 32 * MiB);
    LAS float* SCR = (LAS float*)(F.lds + F.wave * 16384);
    LAS unsigned char* TB = F.lds + F.wave * 16384;
    LAS unsigned char* CT = F.lds + 8 * 16384;
    __syncthreads();
    if (F.tid < 64) { const int c = F.tid; int a, bb;
        if (c < 16) { a = 0; bb = c; } else if (c < 24) { a = 1; bb = c - 16; } else if (c < 29) { a = 2; bb = c - 24; } else if (c < 33) { a = 3; bb = c - 29; } else if (c < 36) { a = 4; bb = c - 33; }
        else if (c < 42) { a = 5 + ((c - 36) >> 1); bb = (c - 36) & 1; } else { a = 8 + ((c - 42) & 7); bb = 0; }
        CT[c] = (unsigned char)(a | (bb << 4)); }
    __syncthreads();
    const float NEG_INF = -__builtin_inff();
    const int gw = F.vcu * NWAVES + F.wave, NGW = F.G * NWAVES;
    for (int wu = gw; wu < M / 32; wu += NGW) {
        const size_t tok = (size_t)wu * 32 + tl;
        const bf16* skp = SUBK + (size_t)tl * 128 + 8 * hh;
        bf16x8 ak[2][8];
#pragma unroll
        for (int s = 0; s < 8; ++s) ak[0][s] = *(const GAS bf16x8*)(skp + 16 * s);
        for (int h2 = 0; h2 < 4; ++h2) {
          for (int hi = 0; hi < 2; ++hi) { const int h = 2 * h2 + hi;
#pragma unroll
            for (int p = 0; p < 2; ++p) {
                const int hp = 2 * h + p;
                bf16x8 bq[8];
#pragma unroll
                for (int s = 0; s < 8; ++s) bq[s] = *(const GAS bf16x8*)(QP + tok * 2048 + hp * 128 + 16 * s + 8 * hh);
                float sc[64];
#pragma unroll
                for (int nb = 0; nb < 4; ++nb) {
                    { const int nidx = 4 * hp + nb + 1; const bf16* nx = skp + (size_t)(nidx < 64 ? nidx : 63) * (32 * 128);
#pragma unroll
                      for (int s = 0; s < 8; ++s) ak[(nb + 1) & 1][s] = *(const GAS bf16x8*)(nx + 16 * s); }
                    f32x16 acc;
#pragma unroll
                    for (int i = 0; i < 16; ++i) acc[i] = 0.f;
#pragma unroll
                    for (int s = 0; s < 8; ++s) acc = MFMA32(ak[nb & 1][s], bq[s], acc);
#pragma unroll
                    for (int v = 0; v < 16; ++v) { const int n = 32 * nb + (v & 3) + 8 * (v >> 2) + 4 * hh; sc[16 * nb + v] = __uint_as_float((__float_as_uint(acc[v]) & ~0x7fu) | (unsigned)n); }
                    asm volatile("" ::: "memory");
                }
                top16_of_64(sc);
                { float pt[16];
#pragma unroll
                  for (int i = 0; i < 16; ++i) pt[i] = __shfl_xor(sc[15 - i], 32);
#pragma unroll
                  for (int i = 0; i < 16; ++i) sc[i] = fmaxf(sc[i], pt[i]); }
                bitonic_merge16_desc<0>(sc);
#pragma unroll
                for (int k = 0; k < 16; ++k) SCR[((hi * 2 + p) * 16 + k) * 64 + lane] = sc[k];
            }
          }
            const int h = 2 * h2 + hh;
            float tv[2][16];
#pragma unroll
            for (int p = 0; p < 2; ++p)
#pragma unroll
                for (int k = 0; k < 16; ++k) tv[p][k] = SCR[((hh * 2 + p) * 16 + k) * 64 + lane];
            asm volatile("s_waitcnt lgkmcnt(0)" ::: "memory");
#pragma unroll
            for (int k = 0; k < 16; ++k) { TB[lane * 32 + k] = (unsigned char)(__float_as_uint(tv[0][k]) & 0x7fu); TB[lane * 32 + 16 + k] = (unsigned char)(__float_as_uint(tv[1][k]) & 0x7fu); }
            float cand[64];
            { int c = 0;
#pragma unroll
              for (int a = 0; a < 16; ++a)
#pragma unroll
                  for (int bb = 0; bb < 16; ++bb) if ((a + 1) * (bb + 1) <= 16) { cand[c] = __uint_as_float((__float_as_uint(tv[0][a] + tv[1][bb]) & ~0x3fu) | (unsigned)c); ++c; }
#pragma unroll
              for (int i = 50; i < 64; ++i) cand[i] = NEG_INF; }
            top16_of_64(cand);
            float top[16]; int eid[16];
            { unsigned abv[16];
#pragma unroll
              for (int k = 0; k < 16; ++k) { top[k] = cand[k]; abv[k] = CT[(int)(__float_as_uint(cand[k]) & 0x3fu)]; }
              __builtin_amdgcn_sched_barrier(0);
              unsigned e1_[16], e2_[16];
#pragma unroll
              for (int k = 0; k < 16; ++k) { e1_[k] = TB[lane * 32 + (abv[k] & 15u)]; e2_[k] = TB[lane * 32 + 16 + (abv[k] >> 4)]; }
              __builtin_amdgcn_sched_barrier(0);
#pragma unroll
              for (int k = 0; k < 16; ++k) eid[k] = (int)(e1_[k] * 128u + e2_[k]); }
            float gs = 0.f, ge[16];
#pragma unroll
            for (int k = 0; k < 16; ++k) { ge[k] = __builtin_amdgcn_exp2f((top[k] - top[0]) * 1.4426950408889634f); gs += ge[k]; }
            const float gi = 1.0f / gs;
            {
                v4u e0, e1;
                e0.x = (unsigned)eid[0] | ((unsigned)eid[1] << 16); e0.y = (unsigned)eid[2] | ((unsigned)eid[3] << 16); e0.z = (unsigned)eid[4] | ((unsigned)eid[5] << 16); e0.w = (unsigned)eid[6] | ((unsigned)eid[7] << 16);
                e1.x = (unsigned)eid[8] | ((unsigned)eid[9] << 16); e1.y = (unsigned)eid[10] | ((unsigned)eid[11] << 16); e1.z = (unsigned)eid[12] | ((unsigned)eid[13] << 16); e1.w = (unsigned)eid[14] | ((unsigned)eid[15] << 16);
                *(GAS v4u*)(EIDX + tok * 128 + h * 16) = e0; *(GAS v4u*)(EIDX + tok * 128 + h * 16 + 8) = e1;
#pragma unroll
                for (int k8 = 0; k8 < 2; ++k8) *(GAS v4u*)(GATE + tok * 128 + h * 16 + 8 * k8) = (v4u){pk2(ge[8 * k8] * gi, ge[8 * k8 + 1] * gi), pk2(ge[8 * k8 + 2] * gi, ge[8 * k8 + 3] * gi), pk2(ge[8 * k8 + 4] * gi, ge[8 * k8 + 5] * gi), pk2(ge[8 * k8 + 6] * gi, ge[8 * k8 + 7] * gi)};
            }
        }
    }
}

__device__ __forceinline__ float gelu_tanh(float x) {
    const float z = 0.7978845608028654f * (x + 0.044715f * x * x * x);
    const float e = __builtin_amdgcn_exp2f(z * 2.8853900817779268f);
    const float th = 1.0f - 2.0f * __builtin_amdgcn_rcpf(e + 1.0f);
    return 0.5f * x * (1.0f + th);
}
#define UB0(w) ((float)((w) & 0xffu))
#define UB1(w) ((float)(((w) >> 8) & 0xffu))
#define UB2(w) ((float)(((w) >> 16) & 0xffu))
#define UB3(w) ((float)((w) >> 24))
struct E1Meta { v4u xa, xb, e0, e1; };
__device__ __forceinline__ void e1_phase(Frame& F) {
    const int lane = F.lane, r = lane & 7, gi = lane >> 3, per = F.G >> 2, shard = F.vcu / (per > 0 ? per : 1) > 3 ? 3 : F.vcu / (per > 0 ? per : 1);
    const int wsh = (F.vcu - shard * per) * NWAVES + F.wave, nwsh = (shard == 3 ? F.G - 3 * per : per) * NWAVES;
    const unsigned char* X1Q = (const unsigned char*)(F.ws + WS_X1Q); const unsigned short* EIDX = WSP(unsigned short, WS_Q);
    const unsigned char* tb = WSP(unsigned char, WS_PU) + (size_t)shard * SHARD_BYTES; const unsigned roff = 16u * (unsigned)r; bf16* PART = WSP(bf16, WS_H) + (size_t)shard * M * 128;
#define E1_META(M_, tt) do { const int t_ = (tt) < M ? (tt) : wsh; \
        M_.xa = *(const GAS v4u*)(X1Q + (size_t)t_ * D + 256 * shard + 32 * r); M_.xb = *(const GAS v4u*)(X1Q + (size_t)t_ * D + 256 * shard + 32 * r + 16); \
        M_.e0 = *(const GAS v4u*)(EIDX + (size_t)t_ * 128 + 16 * gi); M_.e1 = *(const GAS v4u*)(EIDX + (size_t)t_ * 128 + 16 * gi + 8); } while (0)
#define E1_ROWS(UR_, QH_, QL_, M_) do { \
        _Pragma("unroll") for (int i = 0; i < 16; ++i) { const unsigned w_ = i < 8 ? M_.e0[i >> 1] : M_.e1[(i - 8) >> 1]; const unsigned id_ = (i & 1) ? (w_ >> 16) : (w_ & 0xffffu); UR_[i] = *(const GAS v4u*)(tb + (size_t)(id_ * 128u + roff)); } \
        _Pragma("unroll") for (int w = 0; w < 4; ++w) { const unsigned q0_ = w < 2 ? M_.xa[2 * w] : M_.xb[2 * w - 4], q1_ = w < 2 ? M_.xa[2 * w + 1] : M_.xb[2 * w - 3]; \
            const unsigned y0_ = ((q0_ ^ 0x80808080u) + 0x08080808u) ^ 0x80808080u, y1_ = ((q1_ ^ 0x80808080u) + 0x08080808u) ^ 0x80808080u; \
            QH_[w] = ((y0_ >> 4) & 0x0f0f0f0fu) | (y1_ & 0xf0f0f0f0u); QL_[w] = (q0_ & 0x0f0f0f0fu) | ((q1_ << 4) & 0xf0f0f0f0u); } } while (0)
#define E1_XOR(v, o) ((o) == 4 ? dpp_xor4(v) : ((o) == 2 ? dpp_xor2(v) : dpp_xor1(v)))
#define E1_TR(n, o) _Pragma("unroll") for (int i = 0; i < (n); ++i) { const bool up_ = (lane & (o)) != 0; \
            const float k0_ = up_ ? part[i + (n)] : part[i], s0_ = up_ ? part[i] : part[i + (n)], k1_ = up_ ? part[8 + i + (n)] : part[8 + i], s1_ = up_ ? part[8 + i] : part[8 + i + (n)]; \
            part[i] = k0_ + E1_XOR(s0_, (o)); part[8 + i] = k1_ + E1_XOR(s1_, (o)); }
#define E1_COMP(UR_, QH_, QL_, tt) do { if ((tt) < M) { float part[16]; \
        _Pragma("unroll") for (int i = 0; i < 16; ++i) { int sh_ = 0, sl_ = 0; \
            _Pragma("unroll") for (int w = 0; w < 4; ++w) { sh_ = __builtin_amdgcn_sdot8((int)UR_[i][w], (int)QH_[w], sh_, false); sl_ = __builtin_amdgcn_sdot8((int)UR_[i][w], (int)QL_[w], sl_, false); } \
            part[i] = (float)(sh_ * 16 + sl_); } \
        E1_TR(4, 4) E1_TR(2, 2) E1_TR(1, 1) \
        bf16* po_ = PART + (size_t)(tt) * 128 + 16 * gi + r; const unsigned pw_ = pk2(part[0], part[8]); po_[0] = (bf16)(pw_ & 0xffffu); po_[8] = (bf16)(pw_ >> 16); } } while (0)
    E1Meta mA, mB; v4u urA[16], urB[16]; unsigned qhA[4], qlA[4], qhB[4], qlB[4];
    int t = wsh;
    E1_META(mA, t); E1_META(mB, t + nwsh);
    E1_ROWS(urA, qhA, qlA, mA);
    for (; t < M; t += 2 * nwsh) {
        E1_META(mA, t + 2 * nwsh);
        E1_ROWS(urB, qhB, qlB, mB);
        E1_COMP(urA, qhA, qlA, t);
        E1_META(mB, t + 3 * nwsh);
        E1_ROWS(urA, qhA, qlA, mA);
        E1_COMP(urB, qhB, qlB, t + nwsh);
    }
#undef E1_META
#undef E1_ROWS
#undef E1_TR
#undef E1_XOR
#undef E1_COMP
}
__device__ __forceinline__ void er_phase(Frame& F) {
    constexpr int U = 4;
    const int gw = F.vcu * NWAVES + F.wave, NGW = F.G * NWAVES, lane = F.lane;
    const unsigned short* EIDX = WSP(unsigned short, WS_Q); const bf16* GATE = (const bf16*)(F.ws + WS_Q + 32 * MiB); unsigned char* COEF8 = (unsigned char*)(F.ws + WS_Q + 64 * MiB);
    const bf16* PART = WSP(bf16, WS_H); const float* SU = WSP(float, WS_SU); const float* SV = WSP(float, WS_SV); const float* SX = WSP(float, WS_SX);
    for (int t0 = gw; t0 < M; t0 += NGW * U) {
        float sacc[U][2], gt[U][2]; int ee[U][2];
#pragma unroll
        for (int u = 0; u < U; ++u) { const int t = t0 + u * NGW < M ? t0 + u * NGW : t0;
#pragma unroll
            for (int hs = 0; hs < 2; ++hs) { const int slot = lane + 64 * hs; float a = 0.f;
#pragma unroll
                for (int sh = 0; sh < 4; ++sh) a += bf1(PART[((size_t)sh * M + t) * 128 + slot]);
                sacc[u][hs] = a; ee[u][hs] = (int)EIDX[(size_t)t * 128 + slot]; gt[u][hs] = bf1(GATE[(size_t)t * 128 + slot]); } }
#pragma unroll
        for (int u = 0; u < U; ++u) { const int t = t0 + u * NGW < M ? t0 + u * NGW : t0; const float step0 = SX[t];
#pragma unroll
            for (int hs = 0; hs < 2; ++hs) { const float c = gt[u][hs] * gelu_tanh(SU[ee[u][hs]] * step0 * sacc[u][hs]) * SV[ee[u][hs]]; sacc[u][hs] = c; } }
#pragma unroll
        for (int u = 0; u < U; ++u) { const int t = t0 + u * NGW; if (t < M) {
#pragma unroll
            for (int hs = 0; hs < 2; ++hs) { const int k = 8 * (lane & 15) + (lane >> 4) + 4 * hs; const float cs = fminf(fmaxf(64.0f * sacc[u][hs], -448.f), 448.f);
                const int hi = __builtin_amdgcn_cvt_pk_fp8_f32(cs, 0.f, 0, false); const float rlo = 16.0f * (cs - __builtin_amdgcn_cvt_f32_fp8(hi, 0)); const int lo = __builtin_amdgcn_cvt_pk_fp8_f32(rlo, 0.f, 0, false);
                COEF8[(size_t)t * 256 + k] = (unsigned char)(hi & 0xff); COEF8[(size_t)t * 256 + 128 + k] = (unsigned char)(lo & 0xff); } } }
    }
}
struct E2Idx { v4u e0, e1; };
__device__ __forceinline__ void e2_phase(Frame& F) {
    typedef int i32x8 __attribute__((ext_vector_type(8))); typedef float f32x2s __attribute__((ext_vector_type(2)));
    const int lane = F.lane, g = lane >> 3, r = lane & 15, kb = lane >> 4, per = F.G >> 2, shard = F.vcu / (per > 0 ? per : 1) > 3 ? 3 : F.vcu / (per > 0 ? per : 1);
    const int wsh = (F.vcu - shard * per) * NWAVES + F.wave, nwsh = (shard == 3 ? F.G - 3 * per : per) * NWAVES;
    const unsigned char* X1Q = (const unsigned char*)(F.ws + WS_X1Q); const float* SX = WSP(float, WS_SX); const unsigned short* EIDX = WSP(unsigned short, WS_Q); const unsigned char* COEF8 = (const unsigned char*)(F.ws + WS_Q + 64 * MiB);
    const unsigned char* tb = WSP(unsigned char, WS_PV) + (size_t)shard * SHARD_BYTES; bf16* Y2 = (bf16*)(F.ws + WS_H + 256 * MiB);
    LAS unsigned char* LB = F.lds + F.wave * 16384;
    const unsigned roff = (unsigned)(((lane & 7) ^ g) << 4);
    const unsigned rdbase = (unsigned)(size_t)LB + (unsigned)((32 * kb + r) * 128);
    __syncthreads();
#define E2_IDX(E_, tt) do { const int t_ = (tt) < M ? (tt) : wsh; \
        E_.e0 = *(const GAS v4u*)(EIDX + (size_t)t_ * 128 + 16 * g); E_.e1 = *(const GAS v4u*)(EIDX + (size_t)t_ * 128 + 16 * g + 8); } while (0)
#define E2_GATHER(E_) do { _Pragma("unroll") for (int j = 0; j < 16; ++j) { const unsigned w_ = j < 8 ? E_.e0[j >> 1] : E_.e1[(j - 8) >> 1]; const unsigned id_ = (j & 1) ? (w_ >> 16) : (w_ & 0xffffu); \
            __builtin_amdgcn_global_load_lds((const unsigned*)(tb + (size_t)(id_ * 128u + roff)), (LAS unsigned*)(LB + j * 1024), 16, 0, 0); } } while (0)
#define E2_UNIT(ECUR_, ENXT_, tt) do { const int t_ = (tt) < M ? (tt) : wsh;     \
        v4u a0_ = (v4u){0u, 0u, 0u, 0u}, a1_ = a0_, xq_ = a0_; float sx_ = 0.f; \
        if (r < 2) { \
            if (E2_ALAY == 1) { a0_ = *(const GAS v4u*)(COEF8 + (size_t)t_ * 256 + r * 128 + 16 * kb); a1_ = *(const GAS v4u*)(COEF8 + (size_t)t_ * 256 + r * 128 + 64 + 16 * kb); }     \
            else if (E2_ALAY == 2) { const v2u p0_ = *(const GAS v2u*)(COEF8 + (size_t)t_ * 256 + r * 128 + 8 * kb), p1_ = *(const GAS v2u*)(COEF8 + (size_t)t_ * 256 + r * 128 + 32 + 8 * kb), p2_ = *(const GAS v2u*)(COEF8 + (size_t)t_ * 256 + r * 128 + 64 + 8 * kb), p3_ = *(const GAS v2u*)(COEF8 + (size_t)t_ * 256 + r * 128 + 96 + 8 * kb); \
                a0_ = (v4u){p0_.x, p0_.y, p1_.x, p1_.y}; a1_ = (v4u){p2_.x, p2_.y, p3_.x, p3_.y}; }     \
            else { a0_ = *(const GAS v4u*)(COEF8 + (size_t)t_ * 256 + r * 128 + 32 * kb); a1_ = *(const GAS v4u*)(COEF8 + (size_t)t_ * 256 + r * 128 + 32 * kb + 16); } } \
        if (lane < 16) { xq_ = *(const GAS v4u*)(X1Q + (size_t)t_ * D + 256 * shard + 16 * lane); sx_ = ALPHA * SX[t_]; }     \
        asm volatile("s_waitcnt vmcnt(0)" ::: "memory");                  \
        v2u bq_[16][2]; \
        _Pragma("unroll") for (int q = 0; q < 8; ++q) { const unsigned ad_ = rdbase + (unsigned)((q ^ (r & 7)) << 4); \
            asm volatile("ds_read_b64_tr_b4 %0, %4\n\tds_read_b64_tr_b4 %1, %4 offset:2048\n\tds_read_b64_tr_b4 %2, %4 offset:8\n\tds_read_b64_tr_b4 %3, %4 offset:2056" \
                         : "=&v"(bq_[2 * q][0]), "=&v"(bq_[2 * q][1]), "=&v"(bq_[2 * q + 1][0]), "=&v"(bq_[2 * q + 1][1]) : "v"(ad_) : "memory"); } \
        asm volatile("s_waitcnt lgkmcnt(0)" : "+v"(bq_[0][0]), "+v"(bq_[0][1]), "+v"(bq_[1][0]), "+v"(bq_[1][1]), "+v"(bq_[2][0]), "+v"(bq_[2][1]), "+v"(bq_[3][0]), "+v"(bq_[3][1]) :: "memory");     \
        asm volatile("" : "+v"(bq_[4][0]), "+v"(bq_[4][1]), "+v"(bq_[5][0]), "+v"(bq_[5][1]), "+v"(bq_[6][0]), "+v"(bq_[6][1]), "+v"(bq_[7][0]), "+v"(bq_[7][1]) :: "memory"); \
        asm volatile("" : "+v"(bq_[8][0]), "+v"(bq_[8][1]), "+v"(bq_[9][0]), "+v"(bq_[9][1]), "+v"(bq_[10][0]), "+v"(bq_[10][1]), "+v"(bq_[11][0]), "+v"(bq_[11][1]) :: "memory"); \
        asm volatile("" : "+v"(bq_[12][0]), "+v"(bq_[12][1]), "+v"(bq_[13][0]), "+v"(bq_[13][1]), "+v"(bq_[14][0]), "+v"(bq_[14][1]), "+v"(bq_[15][0]), "+v"(bq_[15][1]) :: "memory"); \
        E2_GATHER(ENXT_);                                                \
        E2_IDX(ECUR_, (tt) + 2 * nwsh); \
        const i32x8 a8_ = (i32x8){(int)a0_.x, (int)a0_.y, (int)a0_.z, (int)a0_.w, (int)a1_.x, (int)a1_.y, (int)a1_.z, (int)a1_.w}; float val_[16]; \
        _Pragma("unroll") for (int nb = 0; nb < 16; ++nb) { const i32x8 b8_ = (i32x8){(int)bq_[nb][0].x, (int)bq_[nb][0].y, (int)bq_[nb][1].x, (int)bq_[nb][1].y, 0, 0, 0, 0}; \
            const f32x4 d_ = __builtin_amdgcn_mfma_scale_f32_16x16x128_f8f6f4(a8_, b8_, (f32x4){0.f, 0.f, 0.f, 0.f}, 0  , 4  , 0, 0, 0, 0); \
            val_[nb] = (d_[0] + d_[1] * 0.0625f) * (1.0f / 64.0f); } \
        if (lane < 16) { v4u o0_, o1_; float xr_[16]; \
            _Pragma("unroll") for (int i = 0; i < 16; ++i) xr_[i] = sx_ * (float)(((int)(xq_[i >> 2] << (24 - 8 * (i & 3)))) >> 24); \
            o0_.x = pk2(xr_[0] + val_[0], xr_[1] + val_[1]); o0_.y = pk2(xr_[2] + val_[2], xr_[3] + val_[3]); o0_.z = pk2(xr_[4] + val_[4], xr_[5] + val_[5]); o0_.w = pk2(xr_[6] + val_[6], xr_[7] + val_[7]); \
            o1_.x = pk2(xr_[8] + val_[8], xr_[9] + val_[9]); o1_.y = pk2(xr_[10] + val_[10], xr_[11] + val_[11]); o1_.z = pk2(xr_[12] + val_[12], xr_[13] + val_[13]); o1_.w = pk2(xr_[14] + val_[14], xr_[15] + val_[15]); \
            *(GAS v4u*)(Y2 + (size_t)t_ * D + 256 * shard + 16 * lane) = o0_; *(GAS v4u*)(Y2 + (size_t)t_ * D + 256 * shard + 16 * lane + 8) = o1_; } } while (0)
    E2Idx eA, eB;
    int t = wsh;
    E2_IDX(eA, t); E2_IDX(eB, t + nwsh);
    E2_GATHER(eA);
    for (; t < M; t += 2 * nwsh) {
        E2_UNIT(eA, eB, t);
        E2_UNIT(eB, eA, t + nwsh);
    }
    asm volatile("s_waitcnt vmcnt(0)" ::: "memory");
    __syncthreads();
#undef E2_IDX
#undef E2_GATHER
#undef E2_UNIT
}
__device__ __forceinline__ void ln2_phase(Frame& F) {
    constexpr int U = 4;
    const int gw = F.vcu * NWAVES + F.wave, NGW = F.G * NWAVES, lane = F.lane;
    const bf16* Y = (const bf16*)(F.ws + WS_H + 256 * MiB);
    f32x4 g[4], bb[4];
#pragma unroll
    for (int j = 0; j < 4; ++j) { g[j] = *((const GAS f32x4*)F.a->in[18] + lane + 64 * j); bb[j] = *((const GAS f32x4*)F.a->in[19] + lane + 64 * j); }
    for (int t0 = gw; t0 < M; t0 += NGW * U) {
        f32x4 v[U][4]; float s[U], s2[U];
#pragma unroll
        for (int u = 0; u < U; ++u) { const int t = t0 + u * NGW < M ? t0 + u * NGW : t0; const GAS v2u* yr = (const GAS v2u*)(Y + (size_t)t * D) + lane;
#pragma unroll
            for (int j = 0; j < 4; ++j) { const v2u w = yr[64 * j]; v[u][j] = (f32x4){bflo(w.x), bfhi(w.x), bflo(w.y), bfhi(w.y)}; } }
#pragma unroll
        for (int u = 0; u < U; ++u) { s[u] = 0.f;
#pragma unroll
            for (int j = 0; j < 4; ++j) s[u] += (v[u][j][0] + v[u][j][1]) + (v[u][j][2] + v[u][j][3]); }
        wave_sum_n<U>(s);
#pragma unroll
        for (int u = 0; u < U; ++u) { const float mean = s[u] * (1.f / D); s2[u] = 0.f;
#pragma unroll
            for (int j = 0; j < 4; ++j) { v[u][j] = v[u][j] - mean; s2[u] += (v[u][j][0] * v[u][j][0] + v[u][j][1] * v[u][j][1]) + (v[u][j][2] * v[u][j][2] + v[u][j][3] * v[u][j][3]); } }
        wave_sum_n<U>(s2);
#pragma unroll
        for (int u = 0; u < U; ++u) { const int t = t0 + u * NGW; const float rstd = 1.f / sqrtf(s2[u] * (1.f / D) + LN_EPS); if (t < M) {
#pragma unroll
            for (int j = 0; j < 4; ++j) *((GAS f32x4*)(F.out + (size_t)t * D) + lane + 64 * j) = v[u][j] * rstd * g[j] + bb[j]; } }
    }
}

__device__ __forceinline__ void ph1_inproj(Frame& F) {
    pg8::Gemm g{WSP(bf16, WS_XQ), WSP(bf16, WS_WIN_T), M, HW, 512, 512, 512}; pg8::StaticOrder S; S.init(M, HW, F.G, (int)blockIdx.x);
    pg8::EpiI8G E{WSP(bf16, WS_H), HW, WSP(float, WS_SX), WSP(float, WS_SW), WSP(float, WS_BIASP), H_GA, H_GB + 1024, 2048};
    pg8::gemm_phase<pg8::EpiI8G, pg8::StaticOrder, true, true, 1>(F.lds, g, S, E);
}
__device__ __forceinline__ void ph3_up(Frame& F) {
    { pg8::Gemm g{WSP(bf16, WS_XB), WSP(bf16, WS_WQ_T), M, 768, 384, 384, 384}; pg8::StaticOrder S; S.init(M, 768, F.G, (int)blockIdx.x);
      pg8::EpiI8F8 E{WSP(unsigned char, WS_Q), 768, WSP(float, WS_RSQ), WSP(float, WS_SW) + 12288};
      pg8::gemm_phase<pg8::EpiI8F8, pg8::StaticOrder, true, true, 1>(F.lds, g, S, E); }
    __syncthreads();
    { pg8::Gemm g{(const bf16*)((const unsigned char*)WSP(bf16, WS_H) + H_CKV), WSP(bf16, WS_WKV_T), M, 1024, 128, HW, 128};     pg8::StaticOrder S; S.init(M, 1024, F.G, (int)blockIdx.x);
      pg8::EpiScaleF8 E{WSP(unsigned char, WS_KV), 1024, WSP(float, WS_RSKV)};
      pg8::gemm_phase<pg8::EpiScaleF8, pg8::StaticOrder, true, true, 2>(F.lds, g, S, E); }
}
__device__ __forceinline__ void peer_tables_convert(Frame& F) {
    { const int gwq = F.vcu * NWAVES + F.wave, NGWq = F.G * NWAVES, lane = F.lane;
      for (int r = gwq; r < 2 * 16384; r += NGWq) {
          const int tb = r >> 14, row = r & 16383; const float* srow = (tb ? F.a->in[17] : F.a->in[16]) + (size_t)row * 1024;
          float x[16]; float ss = 0.f;
          if (tb) {
#pragma unroll
              for (int n = 0; n < 16; ++n) x[n] = srow[256 * (lane >> 4) + 16 * n + (lane & 15)];
          } else {
#pragma unroll
              for (int j = 0; j < 4; ++j) { const f32x4 v = *(const GAS f32x4*)(srow + 16 * lane + 4 * j); x[4 * j] = v[0]; x[4 * j + 1] = v[1]; x[4 * j + 2] = v[2]; x[4 * j + 3] = v[3]; }
          }
#pragma unroll
          for (int n = 0; n < 16; ++n) ss += x[n] * x[n];
#pragma unroll
          for (int o = 1; o < 64; o <<= 1) ss += __shfl_xor(ss, o);
          const float rms = sqrtf(ss * (1.0f / 1024.0f));
          const float sc = rms > 0.f ? (tb ? rms * (1.0f / 2.1f) : rms * 0.335f) : 1.0f, isc = 1.0f / sc;
          v2u o2;
#pragma unroll
          for (int h = 0; h < 2; ++h) { unsigned w = 0u;
#pragma unroll
              for (int i = 0; i < 8; ++i) { const float xs = x[8 * h + i] * isc; unsigned c; int pos;
                  if (tb) { const float a = fabsf(xs); c = (unsigned)((a > 0.25f) + (a > 0.75f) + (a > 1.25f) + (a > 1.75f) + (a > 2.5f) + (a > 3.5f) + (a > 5.0f)) | (xs < 0.f ? 8u : 0u); pos = 4 * i; }
                  else { float q = rintf(xs); q = fminf(fmaxf(q, -8.f), 7.f); c = (unsigned)(int)q & 0xfu; pos = 8 * (i & 3) + 4 * (i >> 2); }
                  w |= c << pos; }
              if (h == 0) o2.x = w; else o2.y = w; }
          *(GAS v2u*)((unsigned char*)(F.ws + (tb ? WS_PV : WS_PU)) + (size_t)(lane >> 4) * SHARD_BYTES + (size_t)row * 128 + 8 * (lane & 15)) = o2;
          if (lane == 0) ((float*)(F.ws + (tb ? WS_SV : WS_SU)))[row] = sc;
      } }
}
__device__ __forceinline__ void ph4_attn(Frame& F) {
#if !EXP_NOMIX && !EXP_NOMLA
    if ((PHASE_MASK >> 17) & 1) { mla_phase(F); int t_ = threadIdx.x; asm volatile("" : "+v"(t_)); F.tid = t_; F.lane = t_ & 63; }
#endif
#if !EXP_NOMIX && !EXP_NODSA
    if ((PHASE_MASK >> 16) & 1) dsa_phase(F);
#endif
    peer_tables_convert(F);
}
__device__ __forceinline__ void ph5_merge(Frame& F) {
#if EXP_NOMIX
    { const size_t gtid = (size_t)F.vcu * (NWAVES * 64) + F.tid, NT = (size_t)F.G * (NWAVES * 64); for (size_t i = gtid; i < (size_t)M * 1024 / 8; i += NT) *(GAS v4u*)(WSP(bf16, WS_Q) + 8 * i) = (v4u){0u, 0u, 0u, 0u}; }
#else
    { pg8::Gemm g{WSP(bf16, WS_XB), WSP(bf16, WS_WOA_T), M, 1024, 512, 512, 512}; pg8::StaticOrder S; S.init(M, 1024, F.G, (int)blockIdx.x);
      pg8::EpiGate2 E{(unsigned char*)(F.ws + WS_Q), 1024, (const unsigned char*)(WSP(bf16, WS_H) + H_GA), 2 * HW, 1.0f / 8192.0f};
      pg8::gemm_phase<pg8::EpiGate2, pg8::StaticOrder, true, true, 2>(F.lds, g, S, E); }
#endif
}
__device__ __forceinline__ void ph6_out(Frame& F) {
    pg8::Gemm g{(const bf16*)(F.ws + WS_Q), WSP(bf16, WS_WOUT_T), M, 1024, 512, 512, 512}; pg8::StaticOrder S; S.init(M, 1024, F.G, (int)blockIdx.x);
    pg8::EpiResF32 E{WSP(bf16, WS_H), F.a->in[0], 1024, ALPHA, 1.0f / 8192.0f};
    pg8::gemm_phase<pg8::EpiResF32, pg8::StaticOrder, true, true, 2>(F.lds, g, S, E);
}
__device__ __forceinline__ void ph8_peerq(Frame& F) {
    pg8::Gemm g{WSP(bf16, WS_X1Q), WSP(bf16, WS_WPQ_T), M, 2048, 512, 512, 512}; pg8::StaticOrder S; S.init(M, 2048, F.G, (int)blockIdx.x);
    pg8::EpiI8 E{(bf16*)(F.ws + WS_H + 256 * MiB), 2048, WSP(float, WS_SX), WSP(float, WS_SW) + 8192, nullptr};
    pg8::gemm_phase<pg8::EpiI8, pg8::StaticOrder, true, true, 1>(F.lds, g, S, E);
}

__global__ void __launch_bounds__(NWAVES * 64, 2) fwd_kernel(Args args) {
    extern __shared__ __attribute__((aligned(16))) unsigned char lds[];
    Frame F;
    F.lds = (LAS unsigned char*)lds;
    F.tid = threadIdx.x; F.lane = F.tid & 63; F.wave = __builtin_amdgcn_readfirstlane(F.tid >> 6);
    F.G = gridDim.x; { const int bx = blockIdx.x; F.vcu = (F.G % 8 == 0) ? (bx % 8) * (F.G / 8) + bx / 8 : bx; }
    F.a = &args; F.pos = (const int*)args.in[1]; F.out = args.out; F.ws = args.ws;
    volatile LAS unsigned* MISC = (volatile LAS unsigned*)(F.lds + MISC_OFF);
    if (F.tid < 32) MISC[F.tid] = 0u;
    __syncthreads();
    XcdBarrier bar = xcd_barrier_post((unsigned*)(F.ws + WS_CTL) + CW_BAR, MISC + 8);
    const int lo = args.ph_lo, hi = args.ph_hi;
#define IN(k) (lo <= (k) && (k) < hi && ((PHASE_MASK >> (k)) & 1))
#define SEAM(k) do { if (IN(k) && IN((k) + 1)) xcd_barrier(bar); } while (0)

#define RUNPH(k, call) do { if (IN(k)) { call; if ((REPEAT_MASK >> (k)) & 1) { xcd_barrier(bar); call; } } } while (0)
    RUNPH(0, p0_prologue(F)); SEAM(0);
    RUNPH(1, ph1_inproj(F)); SEAM(1);
    RUNPH(2, p2_small(F)); SEAM(2);
    RUNPH(3, ph3_up(F)); SEAM(3);
    RUNPH(4, ph4_attn(F)); SEAM(4);
    RUNPH(5, ph5_merge(F)); SEAM(5);
    RUNPH(6, ph6_out(F)); SEAM(6);
    RUNPH(7, ln1_phase(F)); SEAM(7);
    RUNPH(8, ph8_peerq(F)); SEAM(8);
    RUNPH(9, route_phase(F)); SEAM(9);
    RUNPH(10, e1_phase(F)); SEAM(10);
    RUNPH(11, er_phase(F)); SEAM(11);
    RUNPH(12, e2_phase(F)); SEAM(12);
    RUNPH(13, ln2_phase(F));
#undef RUNPH
#undef IN
#undef SEAM
}

extern "C" void kernel_launch(void* const* d_in, const int* in_sizes, int n_in, void* d_out, int out_size, void* d_ws, size_t ws_size, hipStream_t stream) {
    static int grid = 0;
    if (grid == 0) {
        if (n_in != 20 || out_size != M * D || ws_size < WS_END) { fprintf(stderr, "kernel_launch: unexpected shapes (n_in %d out %d ws %zu)\n", n_in, out_size, ws_size); grid = -1; return; }
        int dev = 0, cus = 0, per_cu = 0;
        if (hipGetDevice(&dev) != hipSuccess || hipDeviceGetAttribute(&cus, hipDeviceAttributeMultiprocessorCount, dev) != hipSuccess) { grid = -1; return; }
        if (hipFuncSetAttribute((const void*)fwd_kernel, hipFuncAttributeMaxDynamicSharedMemorySize, LDS_BYTES) != hipSuccess) { grid = -1; return; }
        if (hipOccupancyMaxActiveBlocksPerMultiprocessor(&per_cu, (const void*)fwd_kernel, NWAVES * 64, LDS_BYTES) != hipSuccess || per_cu < 1) { fprintf(stderr, "kernel_launch: occupancy query says %d\n", per_cu); }
        (void)hipGetLastError();
        grid = cus;
    }
    if (grid < 0) return;
    (void)hipMemsetAsync((char*)d_ws + WS_CTL, 0, CTL_ZERO_BYTES, stream);
    Args a{};
    for (int i = 0; i < 20; ++i) a.in[i] = (const float*)d_in[i];
    a.out = (float*)d_out; a.ws = (unsigned char*)d_ws; a.ph_lo = 0; a.ph_hi = NPHASES;
    hipLaunchKernelGGL(fwd_kernel, dim3(grid), dim3(NWAVES * 64), LDS_BYTES, stream, a);
}
```

```cpp
#include <hip/hip_runtime.h>
#include <cstdio>
#include <cstdint>
namespace pg8 {
#define PG8_LAS __attribute__((address_space(3)))
typedef unsigned short bf16_t;
typedef short bf16x8 __attribute__((ext_vector_type(8)));
typedef float f32x4 __attribute__((ext_vector_type(4)));
typedef unsigned u32x4 __attribute__((ext_vector_type(4)));
constexpr int BM = 256, BK = 64, HALF = 128, HTB = HALF * BK * 2  , STAGE_BYTES = 8 * HTB, NXCD = 8, WGM = 8;

__host__ __device__ __forceinline__ int lds_byte(int r, int c) { const int st = (r >> 4) * 2 + (c >> 5), rr = r & 15, cc = c & 31, ob = rr * 64 + cc * 2; return st * 1024 + (ob ^ (((ob >> 9) & 1) << 5)); }
__host__ __device__ __forceinline__ void stage_rc(int b, int& R, int& C) { const int st = b / 1024, sb = b % 1024, swz = sb ^ (((sb >> 9) & 1) << 5); R = (st >> 1) * 16 + swz / 64; C = (st & 1) * 32 + (swz % 64) / 2; }
__host__ __device__ __forceinline__ int perm32(int rho) { const int n = rho >> 4, i = rho & 15; return 8 * (i >> 2) + 4 * n + (i & 3); }

struct Unit { int pm, pn; };
struct Gemm { const bf16_t* A; const bf16_t* Bt; int M, N, K, lda, ldb; };

struct StaticOrder {
    int nM, nN, nwg, G, c;
    __host__ __device__ void init(int M, int N, int G_, int c_) { nM = M / BM; nN = N / BM; nwg = nM * nN; G = G_; c = c_; }
    __host__ __device__ bool next(int i, Unit& u) const {
        const long L = (long)i * G + c; if (L >= nwg) return false;
        int wgid = (int)L; { const int q = nwg / NXCD, r = nwg % NXCD, xcd = wgid % NXCD, off = wgid / NXCD; wgid = (xcd < r ? xcd * (q + 1) : r * (q + 1) + (xcd - r) * q) + off; }
        const int nig = WGM * nN, gid = wgid / nig, fm = gid * WGM, gsz = (nM - fm) < WGM ? (nM - fm) : WGM;
        u.pm = fm + ((wgid % nig) % gsz); u.pn = (wgid % nig) / gsz; return true;
    }
    __device__ __forceinline__ void a_ready(const Unit&) const {}
    __device__ __forceinline__ void done(const Unit&) const {}
};
__device__ __forceinline__ unsigned cvt_pk_bf16(float lo, float hi) { unsigned r; asm volatile("v_cvt_pk_bf16_f32 %0, %1, %2" : "=v"(r) : "v"(lo), "v"(hi)); return r; }
__device__ __forceinline__ float bflo(unsigned w) { return __uint_as_float(w << 16); }
__device__ __forceinline__ float bfhi(unsigned w) { return __uint_as_float(w & 0xffff0000u); }
typedef int i32x4 __attribute__((ext_vector_type(4)));
struct EpiBf16 { typedef f32x4 AccT;
    static constexpr bool PERM = true, AFTER_DRAIN = false, HAS_MID = false;
    bf16_t* O; int ldc; const float* bias;
    __device__ __forceinline__ void operator()(const f32x4 (&acc)[2][2][4][2], const Unit& u, int wr, int wc, int fr, int fq) const {
        const int row0 = u.pm * BM + wr * 64 + fr, col0 = u.pn * BM + wc * 32 + 8 * fq;
        f32x4 bv[2][2];
#pragma unroll
        for (int bj = 0; bj < 2; ++bj)
#pragma unroll
            for (int n = 0; n < 2; ++n) bv[bj][n] = bias ? *(const f32x4*)(bias + col0 + bj * HALF + 4 * n) : (f32x4){0.f, 0.f, 0.f, 0.f};
#pragma unroll
        for (int ai = 0; ai < 2; ++ai)
#pragma unroll
            for (int m = 0; m < 4; ++m) { bf16_t* rowp = O + (size_t)(row0 + ai * HALF + m * 16) * ldc + col0;
#pragma unroll
                for (int bj = 0; bj < 2; ++bj) { const f32x4 v0 = acc[ai][bj][m][0] + bv[bj][0], v1 = acc[ai][bj][m][1] + bv[bj][1];
                    u32x4 w; w.x = cvt_pk_bf16(v0[0], v0[1]); w.y = cvt_pk_bf16(v0[2], v0[3]); w.z = cvt_pk_bf16(v1[0], v1[1]); w.w = cvt_pk_bf16(v1[2], v1[3]);
                    *(u32x4*)(rowp + bj * HALF) = w; } }
    }
};
struct EpiI8 { typedef i32x4 AccT;
    static constexpr bool PERM = true, AFTER_DRAIN = false, HAS_MID = false;
    bf16_t* O; int ldc; const float* sa; const float* sb; const float* bias;
    __device__ __forceinline__ void operator()(const i32x4 (&acc)[2][2][4][2], const Unit& u, int wr, int wc, int fr, int fq) const {
        const int row0 = u.pm * BM + wr * 64 + fr, col0 = u.pn * BM + wc * 32 + 8 * fq;
        f32x4 bv[2][2], sv[2][2];
#pragma unroll
        for (int bj = 0; bj < 2; ++bj)
#pragma unroll
            for (int n = 0; n < 2; ++n) { bv[bj][n] = bias ? *(const f32x4*)(bias + col0 + bj * HALF + 4 * n) : (f32x4){0.f, 0.f, 0.f, 0.f}; sv[bj][n] = *(const f32x4*)(sb + col0 + bj * HALF + 4 * n); }
#pragma unroll
        for (int ai = 0; ai < 2; ++ai)
#pragma unroll
            for (int m = 0; m < 4; ++m) { const int row = row0 + ai * HALF + m * 16; const float sr = sa[row]; bf16_t* rowp = O + (size_t)row * ldc + col0;
#pragma unroll
                for (int bj = 0; bj < 2; ++bj) { f32x4 v0, v1;
#pragma unroll
                    for (int i = 0; i < 4; ++i) { v0[i] = (float)acc[ai][bj][m][0][i] * (sr * sv[bj][0][i]) + bv[bj][0][i]; v1[i] = (float)acc[ai][bj][m][1][i] * (sr * sv[bj][1][i]) + bv[bj][1][i]; }
                    u32x4 w; w.x = cvt_pk_bf16(v0[0], v0[1]); w.y = cvt_pk_bf16(v0[2], v0[3]); w.z = cvt_pk_bf16(v1[0], v1[1]); w.w = cvt_pk_bf16(v1[2], v1[3]);
                    *(u32x4*)(rowp + bj * HALF) = w; } }
    }
};
struct EpiI8G { typedef i32x4 AccT;
    static constexpr bool PERM = true, AFTER_DRAIN = false, HAS_MID = false;
    bf16_t* O; int ldc; const float* sa; const float* sb; const float* bias; int glo, ghi, f8hi;
    __device__ __forceinline__ void operator()(const i32x4 (&acc)[2][2][4][2], const Unit& u, int wr, int wc, int fr, int fq) const {
        const int row0 = u.pm * BM + wr * 64 + fr, col0 = u.pn * BM + wc * 32 + 8 * fq; const bool gate = (u.pn * BM >= glo) && (u.pn * BM < ghi), f8 = u.pn * BM < f8hi;
        f32x4 bv[2][2], sv[2][2];
#pragma unroll
        for (int bj = 0; bj < 2; ++bj)
#pragma unroll
            for (int n = 0; n < 2; ++n) { bv[bj][n] = *(const f32x4*)(bias + col0 + bj * HALF + 4 * n); sv[bj][n] = *(const f32x4*)(sb + col0 + bj * HALF + 4 * n); }
#pragma unroll
        for (int ai = 0; ai < 2; ++ai)
#pragma unroll
            for (int m = 0; m < 4; ++m) { const int row = row0 + ai * HALF + m * 16; const float sr = sa[row]; bf16_t* rowp = O + (size_t)row * ldc + col0;
                unsigned char* growp = (unsigned char*)(O + (size_t)row * ldc + glo) + (col0 - glo);
#pragma unroll
                for (int bj = 0; bj < 2; ++bj) { f32x4 v0, v1;
#pragma unroll
                    for (int i = 0; i < 4; ++i) { v0[i] = (float)acc[ai][bj][m][0][i] * (sr * sv[bj][0][i]) + bv[bj][0][i]; v1[i] = (float)acc[ai][bj][m][1][i] * (sr * sv[bj][1][i]) + bv[bj][1][i]; }
                    if (gate) { unsigned w4 = 0u;
#pragma unroll
                        for (int i = 0; i < 4; ++i) { const float s0 = 15.0f * __builtin_amdgcn_rcpf(1.0f + __builtin_amdgcn_exp2f(-1.44269504f * v0[i])), s1 = 15.0f * __builtin_amdgcn_rcpf(1.0f + __builtin_amdgcn_exp2f(-1.44269504f * v1[i]));
                            w4 |= ((unsigned)__builtin_rintf(s0) << (4 * i)) | ((unsigned)__builtin_rintf(s1) << (16 + 4 * i)); }
                        *(unsigned*)((unsigned char*)(O + (size_t)row * ldc + glo) + ((col0 - glo + bj * HALF) >> 1)) = w4; }
                    else if (f8) { int w0 = 0, w1 = 0;
#pragma unroll
                        for (int i = 0; i < 4; ++i) { v0[i] = __builtin_fminf(__builtin_fmaxf(v0[i], -448.0f), 448.0f); v1[i] = __builtin_fminf(__builtin_fmaxf(v1[i], -448.0f), 448.0f); }
                        w0 = __builtin_amdgcn_cvt_pk_fp8_f32(v0[0], v0[1], w0, false); w0 = __builtin_amdgcn_cvt_pk_fp8_f32(v0[2], v0[3], w0, true);
                        w1 = __builtin_amdgcn_cvt_pk_fp8_f32(v1[0], v1[1], w1, false); w1 = __builtin_amdgcn_cvt_pk_fp8_f32(v1[2], v1[3], w1, true);
                        typedef unsigned u32x2 __attribute__((ext_vector_type(2))); u32x2 w; w.x = (unsigned)w0; w.y = (unsigned)w1; *(u32x2*)((unsigned char*)(O + (size_t)row * ldc) + col0 + bj * HALF) = w; }
                    else { u32x4 w; w.x = cvt_pk_bf16(v0[0], v0[1]); w.y = cvt_pk_bf16(v0[2], v0[3]); w.z = cvt_pk_bf16(v1[0], v1[1]); w.w = cvt_pk_bf16(v1[2], v1[3]);
                        *(u32x4*)(rowp + bj * HALF) = w; } } }
    }
};
struct EpiI8F8 { typedef i32x4 AccT;
    static constexpr bool PERM = true, AFTER_DRAIN = false, HAS_MID = false;
    unsigned char* O; int ldc; const float* sa; const float* sb;
    __device__ __forceinline__ void operator()(const i32x4 (&acc)[2][2][4][2], const Unit& u, int wr, int wc, int fr, int fq) const {
        const int row0 = u.pm * BM + wr * 64 + fr, col0 = u.pn * BM + wc * 32 + 8 * fq; typedef unsigned u32x2 __attribute__((ext_vector_type(2)));
        f32x4 sv[2][2];
#pragma unroll
        for (int bj = 0; bj < 2; ++bj)
#pragma unroll
            for (int n = 0; n < 2; ++n) sv[bj][n] = *(const f32x4*)(sb + col0 + bj * HALF + 4 * n);
#pragma unroll
        for (int ai = 0; ai < 2; ++ai)
#pragma unroll
            for (int m = 0; m < 4; ++m) { const int row = row0 + ai * HALF + m * 16; const float sr = sa[row];
#pragma unroll
                for (int bj = 0; bj < 2; ++bj) { float v[8];
#pragma unroll
                    for (int i = 0; i < 4; ++i) { v[i] = __builtin_fminf(__builtin_fmaxf((float)acc[ai][bj][m][0][i] * (sr * sv[bj][0][i]), -448.0f), 448.0f); v[4 + i] = __builtin_fminf(__builtin_fmaxf((float)acc[ai][bj][m][1][i] * (sr * sv[bj][1][i]), -448.0f), 448.0f); }
                    int w0 = 0, w1 = 0;
                    w0 = __builtin_amdgcn_cvt_pk_fp8_f32(v[0], v[1], w0, false); w0 = __builtin_amdgcn_cvt_pk_fp8_f32(v[2], v[3], w0, true);
                    w1 = __builtin_amdgcn_cvt_pk_fp8_f32(v[4], v[5], w1, false); w1 = __builtin_amdgcn_cvt_pk_fp8_f32(v[6], v[7], w1, true);
                    u32x2 w; w.x = (unsigned)w0; w.y = (unsigned)w1; *(u32x2*)(O + (unsigned)(row * ldc + col0 + bj * HALF)) = w; } }
    }
};
struct EpiScaleF8 { typedef f32x4 AccT;
    static constexpr bool PERM = true, AFTER_DRAIN = false, HAS_MID = false;
    unsigned char* O; int ldc; const float* rs;
    __device__ __forceinline__ void operator()(const f32x4 (&acc)[2][2][4][2], const Unit& u, int wr, int wc, int fr, int fq) const {
        const int row0 = u.pm * BM + wr * 64 + fr, col0 = u.pn * BM + wc * 32 + 8 * fq; typedef unsigned u32x2 __attribute__((ext_vector_type(2)));
#pragma unroll
        for (int ai = 0; ai < 2; ++ai)
#pragma unroll
            for (int m = 0; m < 4; ++m) { const int row = row0 + ai * HALF + m * 16; const float s = rs[row];
#pragma unroll
                for (int bj = 0; bj < 2; ++bj) { float v[8];
#pragma unroll
                    for (int i = 0; i < 4; ++i) { v[i] = __builtin_fminf(__builtin_fmaxf(acc[ai][bj][m][0][i] * s, -448.0f), 448.0f); v[4 + i] = __builtin_fminf(__builtin_fmaxf(acc[ai][bj][m][1][i] * s, -448.0f), 448.0f); }
                    int w0 = 0, w1 = 0;
                    w0 = __builtin_amdgcn_cvt_pk_fp8_f32(v[0], v[1], w0, false); w0 = __builtin_amdgcn_cvt_pk_fp8_f32(v[2], v[3], w0, true);
                    w1 = __builtin_amdgcn_cvt_pk_fp8_f32(v[4], v[5], w1, false); w1 = __builtin_amdgcn_cvt_pk_fp8_f32(v[6], v[7], w1, true);
                    u32x2 w; w.x = (unsigned)w0; w.y = (unsigned)w1; *(u32x2*)(O + (unsigned)(row * ldc + col0 + bj * HALF)) = w; } }
    }
};
struct EpiScaleRope { typedef f32x4 AccT;
    static constexpr bool PERM = true, AFTER_DRAIN = false, HAS_MID = false;
    bf16_t* O; int ldc; const float* rs; const float* cs; int rope_pn;
    __device__ __forceinline__ void operator()(const f32x4 (&acc)[2][2][4][2], const Unit& u, int wr, int wc, int fr, int fq) const {
        const int row0 = u.pm * BM + wr * 64 + fr, col0 = u.pn * BM + wc * 32 + 8 * fq; const bool rope = (u.pn == rope_pn);
#pragma unroll
        for (int ai = 0; ai < 2; ++ai)
#pragma unroll
            for (int m = 0; m < 4; ++m) { const int row = row0 + ai * HALF + m * 16; const float s = rs[row]; bf16_t* rowp = O + (size_t)row * ldc + col0;
                f32x4 ca = (f32x4){1.f, 0.f, 1.f, 0.f}, cb = ca;
                if (rope) { ca = *(const f32x4*)(cs + (size_t)row * 32 + 8 * fq); cb = *(const f32x4*)(cs + (size_t)row * 32 + 8 * fq + 4); }
#pragma unroll
                for (int bj = 0; bj < 2; ++bj) { const f32x4 a = acc[ai][bj][m][0] * s, b = acc[ai][bj][m][1] * s; f32x4 o0, o1;
                    o0[0] = a[0] * ca[0] - b[0] * ca[1]; o1[0] = b[0] * ca[0] + a[0] * ca[1];
                    o0[1] = a[1] * ca[2] - b[1] * ca[3]; o1[1] = b[1] * ca[2] + a[1] * ca[3];
                    o0[2] = a[2] * cb[0] - b[2] * cb[1]; o1[2] = b[2] * cb[0] + a[2] * cb[1];
                    o0[3] = a[3] * cb[2] - b[3] * cb[3]; o1[3] = b[3] * cb[2] + a[3] * cb[3];
                    u32x4 w; w.x = cvt_pk_bf16(o0[0], o0[1]); w.y = cvt_pk_bf16(o0[2], o0[3]); w.z = cvt_pk_bf16(o1[0], o1[1]); w.w = cvt_pk_bf16(o1[2], o1[3]);
                    *(u32x4*)(rowp + bj * HALF) = w; } }
    }
};
struct EpiScaleRopeI8 { typedef i32x4 AccT;
    static constexpr bool PERM = true, AFTER_DRAIN = false, HAS_MID = false;
    bf16_t* O; int ldc; const float* rs; const float* sb; const float* cs; int rope_pn;
    __device__ __forceinline__ void operator()(const i32x4 (&acc)[2][2][4][2], const Unit& u, int wr, int wc, int fr, int fq) const {
        const int row0 = u.pm * BM + wr * 64 + fr, col0 = u.pn * BM + wc * 32 + 8 * fq; const bool rope = (u.pn == rope_pn);
#pragma unroll
        for (int ai = 0; ai < 2; ++ai)
#pragma unroll
            for (int m = 0; m < 4; ++m) { const int row = row0 + ai * HALF + m * 16; const float s = rs[row]; bf16_t* rowp = O + (size_t)row * ldc + col0;
                f32x4 ca = (f32x4){1.f, 0.f, 1.f, 0.f}, cb = ca;
                if (rope) { ca = *(const f32x4*)(cs + (size_t)row * 32 + 8 * fq); cb = *(const f32x4*)(cs + (size_t)row * 32 + 8 * fq + 4); }
#pragma unroll
                for (int bj = 0; bj < 2; ++bj) { const f32x4 sv0 = *(const f32x4*)(sb + col0 + bj * HALF) * s, sv1 = *(const f32x4*)(sb + col0 + bj * HALF + 4) * s; f32x4 a, b, o0, o1;
#pragma unroll
                    for (int i = 0; i < 4; ++i) { a[i] = (float)acc[ai][bj][m][0][i] * sv0[i]; b[i] = (float)acc[ai][bj][m][1][i] * sv1[i]; }
                    o0[0] = a[0] * ca[0] - b[0] * ca[1]; o1[0] = b[0] * ca[0] + a[0] * ca[1];
                    o0[1] = a[1] * ca[2] - b[1] * ca[3]; o1[1] = b[1] * ca[2] + a[1] * ca[3];
                    o0[2] = a[2] * cb[0] - b[2] * cb[1]; o1[2] = b[2] * cb[0] + a[2] * cb[1];
                    o0[3] = a[3] * cb[2] - b[3] * cb[3]; o1[3] = b[3] * cb[2] + a[3] * cb[3];
                    u32x4 w; w.x = cvt_pk_bf16(o0[0], o0[1]); w.y = cvt_pk_bf16(o0[2], o0[3]); w.z = cvt_pk_bf16(o1[0], o1[1]); w.w = cvt_pk_bf16(o1[2], o1[3]);
                    *(u32x4*)(rowp + bj * HALF) = w; }
                asm volatile("" ::: "memory"); }
    }
};
template <bool OUT8>
struct EpiGate { typedef f32x4 AccT;
    static constexpr bool PERM = true, AFTER_DRAIN = false, HAS_MID = false;
    void* O; int ldc; const unsigned char* G; int ldg; const bf16_t* T; int ldt; float cs;
    __device__ __forceinline__ void operator()(const f32x4 (&acc)[2][2][4][2], const Unit& u, int wr, int wc, int fr, int fq) const {
        const int row0 = u.pm * BM + wr * 64 + fr, col0 = u.pn * BM + wc * 32 + 8 * fq; const float gs = cs * (1.0f / 255.0f);
        typedef unsigned u32x2 __attribute__((ext_vector_type(2)));
#pragma unroll
        for (int ai = 0; ai < 2; ++ai)
#pragma unroll
            for (int m = 0; m < 4; ++m) { const int row = row0 + ai * HALF + m * 16;
#pragma unroll
                for (int bj = 0; bj < 2; ++bj) { const int col = col0 + bj * HALF;
                    const u32x2 g = *(const u32x2*)(G + (size_t)row * ldg + col); u32x4 t = (u32x4){0u, 0u, 0u, 0u}; if (T) t = *(const u32x4*)(T + (size_t)row * ldt + col);
                    const f32x4 a = acc[ai][bj][m][0], b = acc[ai][bj][m][1];
                    float gv[8] = {(float)(g.x & 0xffu), (float)((g.x >> 8) & 0xffu), (float)((g.x >> 16) & 0xffu), (float)(g.x >> 24), (float)(g.y & 0xffu), (float)((g.y >> 8) & 0xffu), (float)((g.y >> 16) & 0xffu), (float)(g.y >> 24)};
                    float tv[8] = {bflo(t.x), bfhi(t.x), bflo(t.y), bfhi(t.y), bflo(t.z), bfhi(t.z), bflo(t.w), bfhi(t.w)}; float o[8];
#pragma unroll
                    for (int i = 0; i < 8; ++i) o[i] = tv[i] + (gv[i] * gs) * (i < 4 ? a[i & 3] : b[i & 3]);
                    if constexpr (OUT8) { int w0 = 0, w1 = 0;
#pragma unroll
                        for (int i = 0; i < 8; ++i) o[i] = __builtin_fminf(__builtin_fmaxf(o[i] * 32.0f, -448.0f), 448.0f);
                        w0 = __builtin_amdgcn_cvt_pk_fp8_f32(o[0], o[1], w0, false); w0 = __builtin_amdgcn_cvt_pk_fp8_f32(o[2], o[3], w0, true);
                        w1 = __builtin_amdgcn_cvt_pk_fp8_f32(o[4], o[5], w1, false); w1 = __builtin_amdgcn_cvt_pk_fp8_f32(o[6], o[7], w1, true);
                        u32x2 w; w.x = (unsigned)w0; w.y = (unsigned)w1; *(u32x2*)((unsigned char*)O + (size_t)row * ldc + col) = w; }
                    else { u32x4 w; w.x = cvt_pk_bf16(o[0], o[1]); w.y = cvt_pk_bf16(o[2], o[3]); w.z = cvt_pk_bf16(o[4], o[5]); w.w = cvt_pk_bf16(o[6], o[7]);
                        *(u32x4*)((bf16_t*)O + (size_t)row * ldc + col) = w; } } }
    }
};
struct EpiGate2 { typedef f32x4 AccT;
    static constexpr bool PERM = true, AFTER_DRAIN = false, HAS_MID = true;
    unsigned char* O; int ldc; const unsigned char* G; int ldg; float cs;
    typedef unsigned u32x2 __attribute__((ext_vector_type(2)));
    __device__ __forceinline__ void mid(f32x4 (&acc)[2][2][4][2], const Unit& u, int wr, int wc, int fr, int fq) const {
        asm volatile("" : "+v"(fr), "+v"(fq));
        const int row0 = u.pm * BM + wr * 64 + fr, col0 = u.pn * BM + wc * 32 + 8 * fq;
#pragma unroll
        for (int ai = 0; ai < 2; ++ai)
#pragma unroll
            for (int m = 0; m < 4; ++m) { const int row = row0 + ai * HALF + m * 16;
#pragma unroll
                for (int bj = 0; bj < 2; ++bj) { const int col = col0 + bj * HALF;
                    const unsigned go = (unsigned)(row * ldg + (col >> 1)); const unsigned ga = *(const unsigned*)(G + go), gb = *(const unsigned*)(G + go + 512u);
#pragma unroll
                    for (int i = 0; i < 4; ++i) { const float a0 = (float)((ga >> (4 * i)) & 0xfu), a1 = (float)((ga >> (16 + 4 * i)) & 0xfu);
                        const float b0 = __builtin_fmaxf((float)((gb >> (4 * i)) & 0xfu), 1.0f), b1 = __builtin_fmaxf((float)((gb >> (16 + 4 * i)) & 0xfu), 1.0f);
                        acc[ai][bj][m][0][i] *= a0 * __builtin_amdgcn_rcpf(b0); acc[ai][bj][m][1][i] *= a1 * __builtin_amdgcn_rcpf(b1); } }
                asm volatile("" ::: "memory"); }
    }
    __device__ __forceinline__ void operator()(const f32x4 (&acc)[2][2][4][2], const Unit& u, int wr, int wc, int fr, int fq) const {
        const int row0 = u.pm * BM + wr * 64 + fr, col0 = u.pn * BM + wc * 32 + 8 * fq; const float gs = cs * (32.0f / 15.0f);
#pragma unroll
        for (int ai = 0; ai < 2; ++ai)
#pragma unroll
            for (int m = 0; m < 4; ++m) { const int row = row0 + ai * HALF + m * 16;
#pragma unroll
                for (int bj = 0; bj < 2; ++bj) { const int col = col0 + bj * HALF;
                    const unsigned gb = *(const unsigned*)(G + (unsigned)(row * ldg + (col >> 1)) + 512u); float o[8];
#pragma unroll
                    for (int i = 0; i < 4; ++i) { const float b0 = __builtin_fmaxf((float)((gb >> (4 * i)) & 0xfu), 1.0f), b1 = __builtin_fmaxf((float)((gb >> (16 + 4 * i)) & 0xfu), 1.0f);
                        o[i] = __builtin_fminf(__builtin_fmaxf(acc[ai][bj][m][0][i] * (b0 * gs), -448.0f), 448.0f); o[4 + i] = __builtin_fminf(__builtin_fmaxf(acc[ai][bj][m][1][i] * (b1 * gs), -448.0f), 448.0f); }
                    int w0 = 0, w1 = 0;
                    w0 = __builtin_amdgcn_cvt_pk_fp8_f32(o[0], o[1], w0, false); w0 = __builtin_amdgcn_cvt_pk_fp8_f32(o[2], o[3], w0, true);
                    w1 = __builtin_amdgcn_cvt_pk_fp8_f32(o[4], o[5], w1, false); w1 = __builtin_amdgcn_cvt_pk_fp8_f32(o[6], o[7], w1, true);
                    u32x2 w; w.x = (unsigned)w0; w.y = (unsigned)w1; *(u32x2*)(O + (unsigned)(row * ldc + col)) = w; } }
    }
};
struct EpiResF32 { typedef f32x4 AccT;
    static constexpr bool PERM = false, AFTER_DRAIN = false, HAS_MID = false;
    bf16_t* Y; const float* X; int ldc; float alpha, cs;
    __device__ __forceinline__ void operator()(const f32x4 (&acc)[2][2][4][2], const Unit& u, int wr, int wc, int fr, int fq) const {
        const int row0 = u.pm * BM + wr * 64 + fr, col0 = u.pn * BM + wc * 32 + 4 * fq;
#pragma unroll
        for (int ai = 0; ai < 2; ++ai)
#pragma unroll
            for (int m = 0; m < 4; ++m) { const size_t off = (size_t)(row0 + ai * HALF + m * 16) * ldc + col0;
#pragma unroll
                for (int bj = 0; bj < 2; ++bj)
#pragma unroll
                    for (int n = 0; n < 2; ++n) { const f32x4 xv = *(const f32x4*)(X + off + bj * HALF + n * 16); const f32x4 y = xv * alpha + acc[ai][bj][m][n] * cs;
                        typedef unsigned u32x2 __attribute__((ext_vector_type(2))); u32x2 w; w.x = cvt_pk_bf16(y[0], y[1]); w.y = cvt_pk_bf16(y[2], y[3]); *(u32x2*)(Y + off + bj * HALF + n * 16) = w; } }
    }
};
template <class Epi, class Sched, bool ALIGN_EPI = false, bool SP2 = false, int I8 = 0>
__device__ __forceinline__ void gemm_phase(PG8_LAS unsigned char* lds, const Gemm g, const Sched& S, const Epi& E) {
    int tid_ = threadIdx.x; asm volatile("" : "+v"(tid_));
    const int tid = tid_, wid = __builtin_amdgcn_readfirstlane(tid >> 6), lane = tid & 63, wr = wid >> 2, wc = wid & 3, fr = lane & 15, fq = lane >> 4;
    const int K = g.K, nt = K / BK;
    unsigned voffA[2], voffB[2];
#pragma unroll
    for (int i = 0; i < 2; ++i) { int R, C; stage_rc(tid * 16 + i * 8192, R, C); const int Rb = Epi::PERM ? ((R & ~31) + perm32(R & 31)) : R;
        voffA[i] = (unsigned)(R * g.lda + C) * 2u; voffB[i] = (unsigned)(Rb * g.ldb + C) * 2u; }
    const size_t kstep = (size_t)(BK * 2);
    const size_t hstepA = (size_t)HALF * g.lda * 2, hstepB = (size_t)HALF * g.ldb * 2;
    const size_t tstepA = 2 * hstepA, tstepB = 2 * hstepB;
    const unsigned ldsw = (unsigned)wid * 1024u;
    const int aoff = lds_byte(wr * 64 + fr, fq * 8), boff = lds_byte(wc * 32 + fr, fq * 8);
#define PG8_SA(b, h) (((b) * 2 + (h)) * HTB)
#define PG8_SB(b, h) ((4 + (b) * 2 + (h)) * HTB)
#define PG8_STAGE(bufoff, gbase, voff) do { _Pragma("unroll") for (int _i = 0; _i < 2; ++_i) \
        __builtin_amdgcn_global_load_lds((const unsigned*)((const char*)(gbase) + (voff)[_i]), (PG8_LAS unsigned*)(lds + (bufoff) + ldsw + _i * 8192), 16, 0, 0); } while (0)
#define PG8_LDA(dst, b, h) do { _Pragma("unroll") for (int m = 0; m < 4; ++m) _Pragma("unroll") for (int k = 0; k < 2; ++k) dst[m][k] = *(const PG8_LAS bf16x8*)(lds + PG8_SA(b, h) + aoff + m * 2048 + k * 1024); } while (0)
#define PG8_LDB(dst, b, h) do { _Pragma("unroll") for (int n = 0; n < 2; ++n) _Pragma("unroll") for (int k = 0; k < 2; ++k) dst[n][k] = *(const PG8_LAS bf16x8*)(lds + PG8_SB(b, h) + boff + n * 2048 + k * 1024); } while (0)
#define PG8_MMA(ai, bj, At, Bt) do { __builtin_amdgcn_s_setprio(1); _Pragma("unroll") for (int m = 0; m < 4; ++m) _Pragma("unroll") for (int n = 0; n < 2; ++n) _Pragma("unroll") for (int k = 0; k < 2; ++k) \
        { if constexpr (I8 == 2) { if (k == 0) { typedef int i32x8 __attribute__((ext_vector_type(8))); \
              const i32x8 b8_ = __builtin_shufflevector(__builtin_bit_cast(i32x4, Bt[n][0]), __builtin_bit_cast(i32x4, Bt[n][1]), 0, 1, 2, 3, 4, 5, 6, 7), a8_ = __builtin_shufflevector(__builtin_bit_cast(i32x4, At[m][0]), __builtin_bit_cast(i32x4, At[m][1]), 0, 1, 2, 3, 4, 5, 6, 7); \
              asm volatile("v_mfma_f32_16x16x128_f8f6f4 %0, %1, %2, %0" : "+v"(acc[ai][bj][m][n]) : "v"(b8_), "v"(a8_)); } } \
          else if constexpr (I8 == 1) acc[ai][bj][m][n] = __builtin_bit_cast(AccT, __builtin_amdgcn_mfma_i32_16x16x64_i8(__builtin_bit_cast(i32x4, Bt[n][k]), __builtin_bit_cast(i32x4, At[m][k]), __builtin_bit_cast(i32x4, acc[ai][bj][m][n]), 0, 0, 0)); \
          else acc[ai][bj][m][n] = __builtin_bit_cast(AccT, __builtin_amdgcn_mfma_f32_16x16x32_bf16(Bt[n][k], At[m][k], __builtin_bit_cast(f32x4, acc[ai][bj][m][n]), 0, 0, 0)); } __builtin_amdgcn_s_setprio(0); } while (0)
#define PG8_WAIT_V(n) asm volatile("s_waitcnt vmcnt(" #n ")" ::: "memory")
#define PG8_WAIT_L(n) asm volatile("s_waitcnt lgkmcnt(" #n ")" ::: "memory")
#define PG8_BAR __builtin_amdgcn_s_barrier()
#define PG8_SCHED __builtin_amdgcn_sched_barrier(0)
    Unit cur, nxt; int ui = 0;
    if (!S.next(0, cur)) return;
    typedef typename Epi::AccT AccT;
    AccT acc[2][2][4][2];
#pragma unroll
    for (int a = 0; a < 2; ++a)
#pragma unroll
        for (int b = 0; b < 2; ++b)
#pragma unroll
            for (int m = 0; m < 4; ++m)
#pragma unroll
                for (int n = 0; n < 2; ++n) acc[a][b][m][n] = (AccT){0, 0, 0, 0};
    bf16x8 At[4][2], B0[2][2], B1[2][2];
    const char* cA = (const char*)g.A + (size_t)cur.pm * tstepA; const char* cB = (const char*)g.Bt + (size_t)cur.pn * tstepB;
    S.a_ready(cur);
    if constexpr (SP2) {
        PG8_STAGE(PG8_SB(0, 0), cB, voffB); PG8_STAGE(PG8_SB(0, 1), cB + hstepB, voffB); PG8_STAGE(PG8_SA(0, 0), cA, voffA); PG8_STAGE(PG8_SA(0, 1), cA + hstepA, voffA);
        if (wr == 1) PG8_BAR;
        PG8_WAIT_V(2); PG8_BAR;
        PG8_STAGE(PG8_SB(1, 0), cB + kstep, voffB); PG8_STAGE(PG8_SA(1, 0), cA + kstep, voffA); PG8_STAGE(PG8_SB(1, 1), cB + hstepB + kstep, voffB);
        PG8_WAIT_V(6); PG8_BAR;
    } else {
        PG8_STAGE(PG8_SB(0, 0), cB, voffB); PG8_STAGE(PG8_SA(0, 0), cA, voffA); PG8_STAGE(PG8_SB(0, 1), cB + hstepB, voffB); PG8_STAGE(PG8_SA(0, 1), cA + hstepA, voffA);
        if (wr == 1) PG8_BAR;
        PG8_WAIT_V(4); PG8_BAR;
        PG8_STAGE(PG8_SB(1, 0), cB + kstep, voffB); PG8_STAGE(PG8_SA(1, 0), cA + kstep, voffA); PG8_STAGE(PG8_SB(1, 1), cB + hstepB + kstep, voffB);
        PG8_WAIT_V(6); PG8_BAR;
    }
    for (;;) {
        const bool has_next = S.next(ui + 1, nxt);
        const char* nA = has_next ? (const char*)g.A + (size_t)nxt.pm * tstepA : cA; const char* nB = has_next ? (const char*)g.Bt + (size_t)nxt.pn * tstepB : cB;
#pragma nounroll
        for (int t = 0; t < nt; t += 2) {
            if constexpr (Epi::HAS_MID) { if (t == (nt >> 1)) { if constexpr (I8 == 2) { asm volatile("s_nop 15\n\ts_nop 15" ::: "memory"); PG8_SCHED; } E.mid(acc, cur, wr, wc, fr, fq); asm volatile("s_nop 7" ::: "memory"); PG8_SCHED; } }
            const bool last = (t == nt - 2);
            const char* a1 = cA + (size_t)(t + 1) * kstep;
            const char* a2 = last ? nA : cA + (size_t)(t + 2) * kstep; const char* b2 = last ? nB : cB + (size_t)(t + 2) * kstep;
            const char* a3 = a2 + kstep; const char* b3 = b2 + kstep;
            if (last && has_next) S.a_ready(nxt);
            if constexpr (SP2) {
            PG8_LDB(B0, 0, 0); PG8_LDB(B1, 0, 1); PG8_SCHED; PG8_LDA(At, 0, 0); PG8_STAGE(PG8_SA(1, 1), a1 + hstepA, voffA);
            PG8_WAIT_V(8); PG8_WAIT_L(0); PG8_BAR; PG8_MMA(0, 0, At, B0); PG8_MMA(0, 1, At, B1); PG8_BAR; PG8_SCHED;
            PG8_LDA(At, 0, 1); PG8_STAGE(PG8_SB(0, 0), b2, voffB); PG8_STAGE(PG8_SB(0, 1), b2 + hstepB, voffB); PG8_STAGE(PG8_SA(0, 0), a2, voffA);
            PG8_WAIT_V(8); PG8_WAIT_L(0); PG8_BAR; PG8_MMA(1, 0, At, B0); PG8_MMA(1, 1, At, B1); PG8_BAR; PG8_SCHED;
            PG8_LDB(B0, 1, 0); PG8_LDB(B1, 1, 1); PG8_SCHED; PG8_LDA(At, 1, 0); PG8_STAGE(PG8_SA(0, 1), a2 + hstepA, voffA);
            PG8_WAIT_V(8); PG8_WAIT_L(0); PG8_BAR; PG8_MMA(0, 0, At, B0); PG8_MMA(0, 1, At, B1); PG8_BAR; PG8_SCHED;
            PG8_LDA(At, 1, 1); PG8_STAGE(PG8_SB(1, 0), b3, voffB); PG8_STAGE(PG8_SB(1, 1), b3 + hstepB, voffB); PG8_STAGE(PG8_SA(1, 0), a3, voffA);
            PG8_WAIT_V(8); PG8_WAIT_L(0); PG8_BAR; PG8_MMA(1, 0, At, B0); PG8_MMA(1, 1, At, B1); PG8_BAR; PG8_SCHED;
            } else {
            PG8_LDB(B0, 0, 0); PG8_SCHED; PG8_LDA(At, 0, 0); PG8_STAGE(PG8_SA(1, 1), a1 + hstepA, voffA);
            PG8_WAIT_L(8); PG8_BAR; PG8_WAIT_L(0); PG8_MMA(0, 0, At, B0); PG8_BAR; PG8_SCHED;
            PG8_LDB(B1, 0, 1); PG8_STAGE(PG8_SB(0, 0), b2, voffB);
            PG8_BAR; PG8_WAIT_L(0); PG8_MMA(0, 1, At, B1); PG8_BAR;
            PG8_LDA(At, 0, 1); PG8_STAGE(PG8_SA(0, 0), a2, voffA);
            PG8_BAR; PG8_WAIT_L(0); PG8_MMA(1, 0, At, B0); PG8_BAR; PG8_SCHED;
            PG8_STAGE(PG8_SB(0, 1), b2 + hstepB, voffB);
            PG8_WAIT_V(6); PG8_BAR; PG8_MMA(1, 1, At, B1); PG8_BAR;
            PG8_LDB(B0, 1, 0); PG8_SCHED; PG8_LDA(At, 1, 0); PG8_STAGE(PG8_SA(0, 1), a2 + hstepA, voffA);
            PG8_WAIT_L(8); PG8_BAR; PG8_WAIT_L(0); PG8_MMA(0, 0, At, B0); PG8_BAR; PG8_SCHED;
            PG8_LDB(B1, 1, 1); PG8_STAGE(PG8_SB(1, 0), b3, voffB);
            PG8_BAR; PG8_WAIT_L(0); PG8_MMA(0, 1, At, B1); PG8_BAR;
            PG8_LDA(At, 1, 1); PG8_STAGE(PG8_SA(1, 0), a3, voffA);
            PG8_BAR; PG8_WAIT_L(0); PG8_MMA(1, 0, At, B0); PG8_BAR; PG8_SCHED;
            PG8_STAGE(PG8_SB(1, 1), b3 + hstepB, voffB);
            PG8_WAIT_V(6); PG8_BAR; PG8_MMA(1, 1, At, B1); PG8_BAR;
            }
        }
        if constexpr (I8 == 2) { asm volatile("s_nop 15\n\ts_nop 15" ::: "memory"); PG8_SCHED; }
        if constexpr (ALIGN_EPI) { if (wr == 0) PG8_BAR; }
        if constexpr (!Epi::AFTER_DRAIN) { E(acc, cur, wr, wc, fr, fq); S.done(cur); }
        if (!has_next) break;
#pragma unroll
        for (int a = 0; a < 2; ++a)
#pragma unroll
            for (int b = 0; b < 2; ++b)
#pragma unroll
                for (int m = 0; m < 4; ++m)
#pragma unroll
                    for (int n = 0; n < 2; ++n) acc[a][b][m][n] = (AccT){0, 0, 0, 0};
        cur = nxt; cA = nA; cB = nB; ++ui;
        if constexpr (ALIGN_EPI) { if (wr == 1) PG8_BAR; }
    }
    PG8_WAIT_V(0);
    if constexpr (!ALIGN_EPI) { if (wr == 0) PG8_BAR; }
    PG8_BAR;
    if constexpr (Epi::AFTER_DRAIN) { E.fused(acc, cur, wr, wc, fr, fq, lds, wid, lane); S.done(cur); }
#undef PG8_SA
#undef PG8_SB
#undef PG8_STAGE
#undef PG8_LDA
#undef PG8_LDB
#undef PG8_MMA
#undef PG8_WAIT_V
#undef PG8_WAIT_L
#undef PG8_BAR
#undef PG8_SCHED
}
}

#define GAS __attribute__((address_space(1)))
#define LAS __attribute__((address_space(3)))
typedef unsigned short bf16;
typedef unsigned v4u __attribute__((ext_vector_type(4)));
typedef unsigned v2u __attribute__((ext_vector_type(2)));
typedef float f32x4 __attribute__((ext_vector_type(4)));
typedef float f32x16 __attribute__((ext_vector_type(16)));
typedef int i32x4 __attribute__((ext_vector_type(4)));
typedef short bf16x8 __attribute__((ext_vector_type(8)));
typedef __bf16 bf16x2v __attribute__((ext_vector_type(2)));
typedef GAS unsigned gu32;
#define RLX_AGENT __ATOMIC_RELAXED, __HIP_MEMORY_SCOPE_AGENT
#define LDS_WAIT() asm volatile("s_waitcnt lgkmcnt(0)" ::: "memory")
#define VM_WAIT() asm volatile("s_waitcnt vmcnt(0)" ::: "memory")
#define XB_TMO      128
#define XB_XCNT(j)  (256  + 64 * (j))
#define XB_XSUB(j)  (1280 + 64 * (j))
#define XB_XGEN(j)  (2304 + 64 * (j))
#define XB_TOP      3328
#define XB_TOPGEN   3392
#define XCD_BAR_WORDS 3456
#define XB_SPIN_CAP (1u << 18)

__device__ __forceinline__ unsigned xb_ld(unsigned* p)              { return __hip_atomic_load(p, __ATOMIC_RELAXED, __HIP_MEMORY_SCOPE_AGENT); }
__device__ __forceinline__ unsigned xb_add(unsigned* p, unsigned v) { return __hip_atomic_fetch_add(p, v, __ATOMIC_RELAXED, __HIP_MEMORY_SCOPE_AGENT); }
__device__ __forceinline__ unsigned xb_xcc_id() { return (unsigned)__builtin_amdgcn_s_getreg((3 << 11) | 20) & 0xFu; }
#define XB_SPIN(cond, bar) do { unsigned _sp = 0; while (cond) { __builtin_amdgcn_s_sleep(1); \
    if ((++_sp & 255u) == 0u) { if (xb_ld(&(bar)[XB_TMO])) break; if (_sp > XB_SPIN_CAP) { atomicAdd(&(bar)[XB_TMO], 1u); break; } } } } while (0)

struct XcdBarrier {
    unsigned* bar; unsigned x;
    volatile LAS unsigned* st;
};

__device__ __forceinline__ XcdBarrier xcd_barrier_post(unsigned* bar, volatile LAS unsigned* st) {
    XcdBarrier b; b.bar = bar; b.x = xb_xcc_id(); b.st = st;
    if (threadIdx.x == 0) (void)xb_add(&bar[XB_XCNT(b.x)], 1u);
    return b;
}
__device__ __forceinline__ void xcd_barrier_complete(unsigned* bar, unsigned x, unsigned& nloc, unsigned& nx) {
    const unsigned G = gridDim.x * gridDim.y * gridDim.z;
    unsigned sum, cnt, mine, sp = 0u;
    for (;;) {
        sum = 0u; cnt = 0u; mine = 0u;
#pragma unroll
        for (unsigned j = 0; j < 16; ++j) { const unsigned c = xb_ld(&bar[XB_XCNT(j)]); sum += c; cnt += (c > 0u) ? 1u : 0u; mine = (j == x) ? c : mine; }
        if (sum == G) break;
        __builtin_amdgcn_s_sleep(1);
        if ((++sp & 255u) == 0u) { if (xb_ld(&bar[XB_TMO])) break; if (sp > XB_SPIN_CAP) { atomicAdd(&bar[XB_TMO], 1u); break; } }
    }
    nloc = mine > 0u ? mine : 1u; nx = cnt > 0u ? cnt : 1u;
}

__device__ __forceinline__ void xcd_barrier(const XcdBarrier& b) {
    asm volatile("s_waitcnt vmcnt(0)" ::: "memory");
    __syncthreads();
    if (threadIdx.x == 0) {
        unsigned* bar = b.bar;
        __builtin_amdgcn_s_waitcnt(0);
        unsigned nloc = b.st[0], nx = b.st[1];
        if (nloc == 0u) { xcd_barrier_complete(bar, b.x, nloc, nx); b.st[0] = nloc; b.st[1] = nx; }
        const unsigned old = xb_add(&bar[XB_XSUB(b.x)], 1u);
        const unsigned gen = old / nloc;
        if (old + 1u == (gen + 1u) * nloc) {
            __builtin_amdgcn_fence(__ATOMIC_RELEASE, "agent");
            asm volatile("s_waitcnt vmcnt(0)" ::: "memory");
            const unsigned og = xb_add(&bar[XB_TOP], 1u);
            const unsigned tg = og / nx;
            if (og + 1u == (tg + 1u) * nx) xb_add(&bar[XB_TOPGEN], 1u);
            else XB_SPIN(xb_ld(&bar[XB_TOPGEN]) == tg, bar);
            __builtin_amdgcn_fence(__ATOMIC_ACQUIRE, "agent");
            xb_add(&bar[XB_XGEN(b.x)], 1u);
            asm volatile("s_waitcnt vmcnt(0)" ::: "memory");
        } else {
            XB_SPIN(xb_ld(&bar[XB_XGEN(b.x)]) == gen, bar);
            __builtin_amdgcn_fence(__ATOMIC_ACQUIRE, "agent");
            asm volatile("s_waitcnt vmcnt(0)" ::: "memory");
        }
    }
    __syncthreads();
}

constexpr int NWAVES = 8;
constexpr int BATCH = 32, SEQ = 2048, D = 1024, M = BATCH * SEQ;
constexpr int HW = 4352;
constexpr int H_CQ = 0, H_CKV = 768, H_QB = 1024, H_QIDX = 1536, H_GA = 2048, H_GB = 3072, H_KROPE = 4096, H_KB = 4128, H_VB = 4192, H_KIDX = 4256, H_WIDX = 4320;
constexpr float ALPHA = 1.189207115002721f;
constexpr float LN_EPS = 1e-5f, RMS_EPS = 1e-6f;
constexpr int NPHASES = 14;
constexpr size_t SHARD_BYTES = (size_t)16384 * 128;
#ifndef E2_ALAY
#define E2_ALAY 1
#endif
#ifndef DSA_REP
#define DSA_REP 1
#endif
#ifndef E2_TEST
#define E2_TEST 0
#endif
#ifndef REPEAT_MASK
#define REPEAT_MASK 0
#endif
#ifndef PHASE_MASK
#define PHASE_MASK 0x33fff
#endif
#ifndef EXP_NOMIX
#define EXP_NOMIX 0
#endif
#ifndef MLA_PROBE
#define MLA_PROBE 0
#endif
#ifndef DSA_SKIP
#define DSA_SKIP 0
#endif
#ifndef EXP_NODSA
#define EXP_NODSA 0
#endif
#ifndef EXP_NOMLA
#define EXP_NOMLA 0
#endif

constexpr size_t MiB = 1u << 20;
constexpr size_t WS_CTL = 0, CTL_ZERO_BYTES = 1 * MiB;
constexpr size_t WS_BIASP = 1 * MiB, WS_RSQ = 2 * MiB, WS_RSKV = 2 * MiB + 512 * 1024, WS_WIDX = 3 * MiB, WS_CS = 5 * MiB, WS_KPE = 13 * MiB, WS_KIDX = 17 * MiB, WS_KB = 25 * MiB, WS_VB = 33 * MiB;
constexpr size_t WS_WIN_T = 41 * MiB, WS_WQ_T = 50 * MiB, WS_WKV_T = 52 * MiB, WS_WOA_T = 53 * MiB, WS_WOB_T = 54 * MiB, WS_WOUT_T = 55 * MiB, WS_WPQ_T = 57 * MiB, WS_SUBK = 61 * MiB, WS_PU = 62 * MiB  , WS_PV = 78 * MiB, WS_SU = 94 * MiB  , WS_SV = 95 * MiB, WS_XMAX = 96 * MiB  , WS_CSUM = 97 * MiB  ,
                 WS_SX = 98 * MiB  , WS_SW = 99 * MiB  ;
constexpr size_t WS_XB = 128 * MiB;
constexpr size_t WS_XQ = 256 * MiB;
constexpr size_t WS_X1Q = 384 * MiB;
constexpr size_t WS_Q = 256 * MiB, WS_KV = 352 * MiB;
constexpr size_t WS_H = 480 * MiB;
constexpr size_t WS_END = 1024 * MiB;
constexpr int CW_BAR = 4096;

constexpr int LDS_BYTES = 163840;
constexpr int MISC_OFF = LDS_BYTES - 256;

typedef float f32x2v __attribute__((ext_vector_type(2)));
__device__ __forceinline__ unsigned pk4_fp8(float a, float b, float c, float d) {
    a = fminf(fmaxf(a, -448.f), 448.f); b = fminf(fmaxf(b, -448.f), 448.f); c = fminf(fmaxf(c, -448.f), 448.f); d = fminf(fmaxf(d, -448.f), 448.f);
    int w = 0; w = __builtin_amdgcn_cvt_pk_fp8_f32(a, b, w, false); w = __builtin_amdgcn_cvt_pk_fp8_f32(c, d, w, true); return (unsigned)w; }
__device__ __forceinline__ unsigned pk2(float lo, float hi) { const f32x2v v = {lo, hi}; return __builtin_bit_cast(unsigned, __builtin_convertvector(v, bf16x2v)); }
__device__ __forceinline__ float bflo(unsigned w) { return __uint_as_float(w << 16); }
__device__ __forceinline__ float bfhi(unsigned w) { return __uint_as_float(w & 0xffff0000u); }
__device__ __forceinline__ float bf1(unsigned short w) { return __uint_as_float(((unsigned)w) << 16); }
__device__ __forceinline__ float wave_sum(float v) {
#pragma unroll
    for (int o = 1; o < 64; o <<= 1) v += __shfl_xor(v, o);
    return v;
}
__device__ __forceinline__ float xhalf_max(float x) { const auto r = __builtin_amdgcn_permlane32_swap(__float_as_uint(x), __float_as_uint(x), false, false); return fmaxf(__uint_as_float(r[0]), __uint_as_float(r[1])); }
__device__ __forceinline__ float dpp_xor1(float x) { return __int_as_float(__builtin_amdgcn_update_dpp(0, __float_as_int(x), 0xB1, 0xf, 0xf, true)); }
__device__ __forceinline__ float dpp_xor2(float x) { return __int_as_float(__builtin_amdgcn_update_dpp(0, __float_as_int(x), 0x4E, 0xf, 0xf, true)); }
__device__ __forceinline__ float dpp_xor4(float x) { int r = __builtin_amdgcn_update_dpp(0, __float_as_int(x), 0x104, 0xf, 0x5, false); r = __builtin_amdgcn_update_dpp(r, __float_as_int(x), 0x114, 0xf, 0xa, false); return __int_as_float(r); }
__device__ __forceinline__ float xhalf_sum(float x) { const auto r = __builtin_amdgcn_permlane32_swap(__float_as_uint(x), __float_as_uint(x), false, false); return __uint_as_float(r[0]) + __uint_as_float(r[1]); }
__device__ __forceinline__ float dpp_xor8(float x) { return __int_as_float(__builtin_amdgcn_update_dpp(0, __float_as_int(x), 0x128, 0xf, 0xf, true)); }
__device__ __forceinline__ float xrow_max(float x) { const auto r = __builtin_amdgcn_permlane16_swap(__float_as_uint(x), __float_as_uint(x), false, false); return fmaxf(__uint_as_float(r[0]), __uint_as_float(r[1])); }
__device__ __forceinline__ float xrow_sum(float x) { const auto r = __builtin_amdgcn_permlane16_swap(__float_as_uint(x), __float_as_uint(x), false, false); return __uint_as_float(r[0]) + __uint_as_float(r[1]); }
template <int U> __device__ __forceinline__ void wave_sum_n(float (&v)[U]) {
#pragma unroll
    for (int u = 0; u < U; ++u) { float x = v[u]; x += dpp_xor1(x); x += dpp_xor2(x); x += dpp_xor4(x); x += dpp_xor8(x); x = xrow_sum(x); v[u] = xhalf_sum(x); }
}
template <int U> __device__ __forceinline__ void wave_max_n(float (&v)[U]) {
#pragma unroll
    for (int u = 0; u < U; ++u) { float x = v[u]; x = fmaxf(x, dpp_xor1(x)); x = fmaxf(x, dpp_xor2(x)); x = fmaxf(x, dpp_xor4(x)); x = fmaxf(x, dpp_xor8(x)); x = xrow_max(x); v[u] = xhalf_max(x); }
}
__device__ __forceinline__ float dot2bf(unsigned a, unsigned b, float c) { return __builtin_amdgcn_fdot2_f32_bf16(__builtin_bit_cast(bf16x2v, a), __builtin_bit_cast(bf16x2v, b), c, false); }
#define MFMA32(a, b, c) __builtin_amdgcn_mfma_f32_32x32x16_bf16((a), (b), (c), 0, 0, 0)
#define MFMA16(a, b, c) __builtin_amdgcn_mfma_f32_16x16x32_bf16((a), (b), (c), 0, 0, 0)

struct Args { const float* in[20]; float* out; unsigned char* ws; int ph_lo, ph_hi; };
struct Frame {
    LAS unsigned char* lds;
    int tid, lane, wave, vcu, G;
    const struct Args* a; const int* pos; float* out; unsigned char* ws;
};
#define WSP(T, off) ((T*)(F.ws + (off)))

__device__ __forceinline__ int win_src(int n) {
    if (n < 1024) return n;
    if (n < 1536) return 1056 + (n - 1024);
    if (n < 2048) return 1696 + (n - 1536);
    if (n < 3072) return 2280 + (n - 2048);
    if (n < 4096) return 3304 + (n - 3072);
    if (n < 4128) return 1024 + (n - 4096);
    if (n < 4192) return 1568 + (n - 4128);
    if (n < 4256) return 1632 + (n - 4192);
    if (n < 4320) return 2208 + (n - 4256);
    if (n < 4328) return 2272 + (n - 4320);
    return -1;
}
__device__ __forceinline__ int wq_src(int n) {
    if (n < 512) return (n >> 6) * 96 + (n & 63);
    const int p = n - 512, hd = p >> 5, pp = p & 31, f = pp >> 3, r = pp & 7, j = 4 * f + (r & 3);
    return hd * 96 + 64 + (r < 4 ? j : 16 + j);
}
__device__ __forceinline__ int wkv_src(int n) { return n < 512 ? (n >> 6) * 128 + (n & 63) : ((n - 512) >> 6) * 128 + 64 + ((n - 512) & 63); }

template <int MAP, bool OUT8 = false>
__device__ __forceinline__ void transpose_item(const float* W, int ldw, bf16* WT, int K, int nblk, int item, const float* kscale, LAS float* scr, int lane) {
    const int kb = item / nblk, nb = item % nblk, k0 = 64 * kb, n0 = 32 * nb;
    const int nd = n0 + (lane & 31);
    const int sc = MAP == 0 ? nd : (MAP == 1 ? win_src(nd) : (MAP == 2 ? wq_src(nd) : wkv_src(nd)));
#pragma unroll 8
    for (int i = 0; i < 32; ++i) { const int kk = 2 * i + (lane >> 5); float v = 0.f; if (sc >= 0) { v = W[(size_t)(k0 + kk) * ldw + sc]; if (kscale) v *= kscale[k0 + kk]; } scr[kk * 33 + (lane & 31)] = v; }
    LDS_WAIT(); asm volatile("" ::: "memory");
    const int c = lane & 7;
#pragma unroll
    for (int j = 0; j < 4; ++j) { const int n = (lane >> 3) + 8 * j; const LAS float* s = scr + (8 * c) * 33 + n;
        if constexpr (OUT8) { int w0 = 0, w1 = 0;
            w0 = __builtin_amdgcn_cvt_pk_fp8_f32(256.f * s[0 * 33], 256.f * s[1 * 33], w0, false); w0 = __builtin_amdgcn_cvt_pk_fp8_f32(256.f * s[2 * 33], 256.f * s[3 * 33], w0, true);
            w1 = __builtin_amdgcn_cvt_pk_fp8_f32(256.f * s[4 * 33], 256.f * s[5 * 33], w1, false); w1 = __builtin_amdgcn_cvt_pk_fp8_f32(256.f * s[6 * 33], 256.f * s[7 * 33], w1, true);
            v2u o; o.x = (unsigned)w0; o.y = (unsigned)w1; *(GAS v2u*)((unsigned char*)WT + (size_t)(n0 + n) * K + k0 + 8 * c) = o; }
        else { v4u o; o.x = pk2(s[0 * 33], s[1 * 33]); o.y = pk2(s[2 * 33], s[3 * 33]); o.z = pk2(s[4 * 33], s[5 * 33]); o.w = pk2(s[6 * 33], s[7 * 33]);
            *(GAS v4u*)(WT + (size_t)(n0 + n) * K + k0 + 8 * c) = o; } }
    LDS_WAIT(); asm volatile("" ::: "memory");
}
__device__ __forceinline__ void conv8(const float* src, bf16* dst, size_t ngroups, size_t gtid, size_t NT) {
    for (size_t i0 = gtid; i0 < ngroups; i0 += 4 * NT) {
        f32x4 a[4], b[4];
#pragma unroll
        for (int u = 0; u < 4; ++u) { const size_t i = i0 + u * NT < ngroups ? i0 + u * NT : i0; a[u] = *(const GAS f32x4*)(src + 8 * i); b[u] = *(const GAS f32x4*)(src + 8 * i + 4); }
#pragma unroll
        for (int u = 0; u < 4; ++u) { const size_t i = i0 + u * NT; if (i < ngroups) { v4u o; o.x = pk2(a[u][0], a[u][1]); o.y = pk2(a[u][2], a[u][3]); o.z = pk2(b[u][0], b[u][1]); o.w = pk2(b[u][2], b[u][3]); *(GAS v4u*)(dst + 8 * i) = o; } }
    }
}

__device__ __forceinline__ void p0_prologue(Frame& F) {
    const size_t gtid = (size_t)F.vcu * (NWAVES * 64) + F.tid, NT = (size_t)F.G * (NWAVES * 64);
    { const int gwx = F.vcu * NWAVES + F.wave, NGWx = F.G * NWAVES, lane = F.lane; constexpr int U = 4;
      for (int t0 = gwx; t0 < M; t0 += NGWx * U) {
          f32x4 v[U][4]; float am[U];
#pragma unroll
          for (int u = 0; u < U; ++u) { const int t = t0 + u * NGWx < M ? t0 + u * NGWx : t0; const float* src = F.a->in[0] + (size_t)t * D + 16 * lane; am[u] = 0.f;
#pragma unroll
              for (int j = 0; j < 4; ++j) { v[u][j] = *(const GAS f32x4*)(src + 4 * j); am[u] = fmaxf(am[u], fmaxf(fmaxf(fabsf(v[u][j][0]), fabsf(v[u][j][1])), fmaxf(fabsf(v[u][j][2]), fabsf(v[u][j][3])))); } }
          wave_max_n<U>(am);
#pragma unroll
          for (int u = 0; u < U; ++u) { const int t = t0 + u * NGWx; if (t < M) { const float sc = am[u] > 0.f ? am[u] * (1.0f / 127.0f) : 1.0f, isc = 1.0f / sc; v4u o4;
#pragma unroll
              for (int j = 0; j < 4; ++j) { unsigned w = 0u;
#pragma unroll
                  for (int i = 0; i < 4; ++i) { float q = rintf(v[u][j][i] * isc); q = fminf(fmaxf(q, -127.f), 127.f); w |= ((unsigned)(int)q & 0xffu) << (8 * i); }
                  o4[j] = w; }
              *(GAS v4u*)(WSP(unsigned char, WS_XQ) + (size_t)t * D + 16 * lane) = o4; if (lane == 0) WSP(float, WS_SX)[t] = sc; } }
      }
      for (int n = gwx; n < HW; n += NGWx) { const int srcc = win_src(n); float w16[16]; float am = 0.f;
#pragma unroll
          for (int i = 0; i < 16; ++i) { w16[i] = srcc >= 0 ? F.a->in[2][(size_t)(16 * lane + i) * 4328 + srcc] : 0.f; am = fmaxf(am, fabsf(w16[i])); }
#pragma unroll
          for (int o = 1; o < 64; o <<= 1) am = fmaxf(am, __shfl_xor(am, o));
          const float sc = am > 0.f ? am * (1.0f / 127.0f) : 1.0f, isc = 1.0f / sc; v4u o4;
#pragma unroll
          for (int j = 0; j < 4; ++j) { unsigned w = 0u;
#pragma unroll
              for (int i = 0; i < 4; ++i) { float q = rintf(w16[4 * j + i] * isc); q = fminf(fmaxf(q, -127.f), 127.f); w |= ((unsigned)(int)q & 0xffu) << (8 * i); }
              o4[j] = w; }
          *(GAS v4u*)(WSP(unsigned char, WS_WIN_T) + (size_t)n * 1024 + 16 * lane) = o4; if (lane == 0) WSP(float, WS_SW)[n] = sc; }
      for (int n = gwx; n < 768; n += NGWx) { const int srcc = wq_src(n); float w16[16]; float am = 0.f;
#pragma unroll
          for (int i = 0; i < 16; ++i) { const int k = 16 * lane + i; w16[i] = lane < 48 ? F.a->in[6][(size_t)k * 768 + srcc] * F.a->in[4][k] : 0.f; am = fmaxf(am, fabsf(w16[i])); }
#pragma unroll
          for (int o = 1; o < 64; o <<= 1) am = fmaxf(am, __shfl_xor(am, o));
          const float sc = am > 0.f ? am * (1.0f / 127.0f) : 1.0f, isc = 1.0f / sc; v4u o4;
#pragma unroll
          for (int j = 0; j < 4; ++j) { unsigned w = 0u;
#pragma unroll
              for (int i = 0; i < 4; ++i) { float q = rintf(w16[4 * j + i] * isc); q = fminf(fmaxf(q, -127.f), 127.f); w |= ((unsigned)(int)q & 0xffu) << (8 * i); }
              o4[j] = w; }
          if (lane < 48) *(GAS v4u*)(WSP(unsigned char, WS_WQ_T) + (size_t)n * 768 + 16 * lane) = o4; if (lane == 0) WSP(float, WS_SW)[12288 + n] = sc; }
      for (int n = gwx; n < 2048; n += NGWx) { float w16[16]; float am = 0.f;
#pragma unroll
          for (int i = 0; i < 16; ++i) { w16[i] = F.a->in[14][(size_t)(16 * lane + i) * 2048 + n]; am = fmaxf(am, fabsf(w16[i])); }
#pragma unroll
          for (int o = 1; o < 64; o <<= 1) am = fmaxf(am, __shfl_xor(am, o));
          const float sc = am > 0.f ? am * (1.0f / 127.0f) : 1.0f, isc = 1.0f / sc; v4u o4;
#pragma unroll
          for (int j = 0; j < 4; ++j) { unsigned w = 0u;
#pragma unroll
              for (int i = 0; i < 4; ++i) { float q = rintf(w16[4 * j + i] * isc); q = fminf(fmaxf(q, -127.f), 127.f); w |= ((unsigned)(int)q & 0xffu) << (8 * i); }
              o4[j] = w; }
          *(GAS v4u*)(WSP(unsigned char, WS_WPQ_T) + (size_t)n * 1024 + 16 * lane) = o4; if (lane == 0) WSP(float, WS_SW)[8192 + n] = sc; }
    }
    conv8(F.a->in[15], WSP(bf16, WS_SUBK), (size_t)16 * 128 * 128 / 8, gtid, NT);
    for (size_t i = gtid; i < (size_t)HW; i += NT) { const int s = win_src((int)i); WSP(float, WS_BIASP)[i] = s >= 0 ? F.a->in[3][s] : 0.f; }
    for (size_t i = gtid; i < (size_t)M * 16; i += NT) { const int t = (int)(i >> 4), j = (int)(i & 15);
        const float inv = exp2f(-(float)j * 0.83048202372184059f);
        const float ang = (float)F.pos[t] * inv;
        const double tt = (double)ang * 0.15915494309189535; const float fr = (float)(tt - rint(tt));
        float2 cs; cs.x = __builtin_amdgcn_cosf(fr); cs.y = __builtin_amdgcn_sinf(fr); WSP(float2, WS_CS)[i] = cs; }
    LAS float* scr = (LAS float*)(F.lds + F.wave * 16384);
    const int gw = F.vcu * NWAVES + F.wave, NGW = F.G * NWAVES;
    constexpr int I_IN = (HW / 32) * 16, I_Q = 24 * 12, I_KV = 32 * 4, I_OA = 32 * 8, I_OUT = 32 * 16, I_PQ = 64 * 16;
    constexpr int NITEMS = I_KV + 2 * I_OA + I_OUT;
    for (int it = gw; it < NITEMS; it += NGW) {
        int r = it;
        if (r < I_KV) { transpose_item<3, true>(F.a->in[7], 1024, WSP(bf16, WS_WKV_T), 256, 32, r, F.a->in[5], scr, F.lane); continue; } r -= I_KV;
        if (r < I_OA) { transpose_item<0, true>(F.a->in[8], 1024, WSP(bf16, WS_WOA_T), 1024, 32, r, nullptr, scr, F.lane); continue; } r -= I_OA;
        if (r < I_OA) { transpose_item<0, true>(F.a->in[9], 1024, (bf16*)(F.ws + WS_WOA_T + 512), 1024, 32, r, nullptr, scr, F.lane); continue; } r -= I_OA;
        transpose_item<0, true>(F.a->in[11], 1024, WSP(bf16, WS_WOUT_T), 1024, 32, r, nullptr, scr, F.lane);
    }
}

typedef float f32x2p __attribute__((ext_vector_type(2)));
__device__ __forceinline__ v4u fp8x8_to_bf16x8(v2u w) {
    const f32x2p f0 = __builtin_amdgcn_cvt_pk_f32_fp8((int)w.x, false), f1 = __builtin_amdgcn_cvt_pk_f32_fp8((int)w.x, true), f2 = __builtin_amdgcn_cvt_pk_f32_fp8((int)w.y, false), f3 = __builtin_amdgcn_cvt_pk_f32_fp8((int)w.y, true);
    return (v4u){pk2(f0.x, f0.y), pk2(f1.x, f1.y), pk2(f2.x, f2.y), pk2(f3.x, f3.y)};
}
__device__ __forceinline__ void p2_small(Frame& F) {
    constexpr int U = 4;
    const int gw = F.vcu * NWAVES + F.wave, NGW = F.G * NWAVES, lane = F.lane;
    const bf16* Hb = WSP(bf16, WS_H);
    for (int t0 = gw; t0 < M; t0 += NGW * U) {
        v4u a[U], b[U]; v2u sm[U]; f32x4 ca[U], cb[U]; float sq[U], skv[U];
#pragma unroll
        for (int u = 0; u < U; ++u) { const int t = t0 + u * NGW < M ? t0 + u * NGW : t0; const bf16* hrow = Hb + (size_t)t * HW;
            { const v2u a8 = *(const GAS v2u*)((const unsigned char*)hrow + 8 * lane), b8 = *(const GAS v2u*)((const unsigned char*)hrow + 512 + 8 * lane);
              a[u] = fp8x8_to_bf16x8(a8); b[u] = fp8x8_to_bf16x8(b8); } sm[u] = *(const GAS v2u*)(hrow + H_KROPE + 4 * lane);
            ca[u] = *(const GAS f32x4*)(WSP(float, WS_CS) + (size_t)t * 32 + 8 * (lane & 3)); cb[u] = *(const GAS f32x4*)(WSP(float, WS_CS) + (size_t)t * 32 + 8 * (lane & 3) + 4); }
#pragma unroll
        for (int u = 0; u < U; ++u) { float sa = 0.f, sb = 0.f;
#pragma unroll
            for (int i = 0; i < 4; ++i) { const float a0 = bflo(a[u][i]), a1 = bfhi(a[u][i]), b0 = bflo(b[u][i]), b1 = bfhi(b[u][i]); sa += a0 * a0 + a1 * a1; sb += b0 * b0 + b1 * b1; }
            sq[u] = sa + (lane < 32 ? sb : 0.f); skv[u] = lane >= 32 ? sb : 0.f; }
        wave_sum_n<U>(sq); wave_sum_n<U>(skv);
        float cqm[U];
#pragma unroll
        for (int u = 0; u < U; ++u) { float ma = 0.f, mb = 0.f;
#pragma unroll
            for (int i = 0; i < 4; ++i) { ma = fmaxf(ma, fmaxf(fabsf(bflo(a[u][i])), fabsf(bfhi(a[u][i])))); mb = fmaxf(mb, fmaxf(fabsf(bflo(b[u][i])), fabsf(bfhi(b[u][i])))); }
            cqm[u] = fmaxf(ma, lane < 32 ? mb : 0.f); }
        wave_max_n<U>(cqm);
#pragma unroll
        for (int u = 0; u < U; ++u) cqm[u] = cqm[u] > 0.f ? cqm[u] : 1.0f;
        float kim[U];
#pragma unroll
        for (int u = 0; u < U; ++u) { const float m4 = fmaxf(fmaxf(fabsf(bflo(sm[u].x)), fabsf(bfhi(sm[u].x))), fmaxf(fabsf(bflo(sm[u].y)), fabsf(bfhi(sm[u].y)))); kim[u] = (lane >= 40 && lane < 56) ? m4 : 0.f; }
        wave_max_n<U>(kim);
#pragma unroll
        for (int u = 0; u < U; ++u) kim[u] = kim[u] > 0.f ? kim[u] : 1.0f;
#pragma unroll
        for (int u = 0; u < U; ++u) { const int t = t0 + u * NGW; const v2u s = sm[u];
            const float x0 = bflo(s.x), x1 = bfhi(s.x), x2 = bflo(s.y), x3 = bfhi(s.y);
            const float y0 = __shfl_down(x0, 4), y1 = __shfl_down(x1, 4), y2 = __shfl_down(x2, 4), y3 = __shfl_down(x3, 4);
            if (t < M) {
                { const float iq = 127.0f / cqm[u]; v2u qa, qb2;
#pragma unroll
                  for (int h2 = 0; h2 < 2; ++h2) { unsigned wa = 0u, wb = 0u;
#pragma unroll
                      for (int i = 0; i < 2; ++i) { const unsigned sa_ = a[u][2 * h2 + i], sb_ = b[u][2 * h2 + i];
                          float q0 = rintf(bflo(sa_) * iq), q1 = rintf(bfhi(sa_) * iq), q2 = rintf(bflo(sb_) * iq), q3 = rintf(bfhi(sb_) * iq);
                          q0 = fminf(fmaxf(q0, -127.f), 127.f); q1 = fminf(fmaxf(q1, -127.f), 127.f); q2 = fminf(fmaxf(q2, -127.f), 127.f); q3 = fminf(fmaxf(q3, -127.f), 127.f);
                          wa |= (((unsigned)(int)q0 & 0xffu) | (((unsigned)(int)q1 & 0xffu) << 8)) << (16 * i); wb |= (((unsigned)(int)q2 & 0xffu) | (((unsigned)(int)q3 & 0xffu) << 8)) << (16 * i); }
                      qa[h2] = wa; qb2[h2] = wb; }
                  *(GAS v2u*)(WSP(unsigned char, WS_XB) + (size_t)t * 768 + 8 * lane) = qa;
                  if (lane < 32) *(GAS v2u*)(WSP(unsigned char, WS_XB) + (size_t)t * 768 + 512 + 8 * lane) = qb2; }
                if (lane == 0) { WSP(float, WS_RSQ)[t] = (cqm[u] * (1.0f / 127.0f)) / sqrtf(sq[u] * (1.0f / 768.0f) + RMS_EPS); WSP(float, WS_RSKV)[t] = (1.0f / 256.0f) / sqrtf(skv[u] * (1.0f / 256.0f) + RMS_EPS); }
                if (lane >= 8 && lane < 24) { const int d0 = 4 * (lane - 8), pos0 = d0 < 32 ? 16 * (d0 >> 3) + (d0 & 7) : 16 * ((d0 - 32) >> 3) + 8 + ((d0 - 32) & 7);
                    int w8 = 0; w8 = __builtin_amdgcn_cvt_pk_fp8_f32(x0, x1, w8, false); w8 = __builtin_amdgcn_cvt_pk_fp8_f32(x2, x3, w8, true);
                    *(GAS int*)(WSP(unsigned char, WS_KB) + (size_t)t * 64 + pos0) = w8; }
                if (lane >= 24 && lane < 40) *(GAS unsigned*)(WSP(unsigned char, WS_VB) + (size_t)t * 64 + 4 * (lane - 24)) = pk4_fp8(x0, x1, x2, x3);
                if (lane >= 40 && lane < 56) { const float iq = 127.0f / kim[u]; unsigned q4 = 0u; const float xs4[4] = {x0, x1, x2, x3};
#pragma unroll
                    for (int i = 0; i < 4; ++i) { float q = rintf(xs4[i] * iq); q = fminf(fmaxf(q, -127.f), 127.f); q4 |= ((unsigned)(int)q & 0xffu) << (8 * i); }
                    *(GAS unsigned*)(WSP(unsigned char, WS_KIDX) + (size_t)t * 64 + 4 * (lane - 40)) = q4; if (lane == 40) WSP(float, WS_SW)[16384 + t] = kim[u] * (1.0f / 127.0f); }
                if (lane >= 56 && lane < 58) *(GAS f32x4*)(WSP(float, WS_WIDX) + (size_t)t * 8 + 4 * (lane - 56)) = (f32x4){bflo(s.x), bfhi(s.x), bflo(s.y), bfhi(s.y)};
                if (lane < 4) {
                    v4u o;
                    o.x = pk2(x0 * ca[u][0] - y0 * ca[u][1], x1 * ca[u][2] - y1 * ca[u][3]); o.y = pk2(x2 * cb[u][0] - y2 * cb[u][1], x3 * cb[u][2] - y3 * cb[u][3]);
                    o.z = pk2(y0 * ca[u][0] + x0 * ca[u][1], y1 * ca[u][2] + x1 * ca[u][3]); o.w = pk2(y2 * cb[u][0] + x2 * cb[u][1], y3 * cb[u][2] + x3 * cb[u][3]);
                    *(GAS v4u*)(WSP(bf16, WS_KPE) + (size_t)t * 32 + 8 * lane) = o;
                }
            } }
    }
}

constexpr int MLA_KP = 208, MLA_VP = 136;
constexpr int MLA_KOFF = 0, MLA_VOFF = 64 * MLA_KP, MLA_POFF = MLA_VOFF + 64 * MLA_VP, MLA_BUF = 22528;
static_assert(2 * MLA_BUF + 8 * 64 * MLA_KP <= MISC_OFF, "MLA LDS map");
__device__ __forceinline__ void mla_phase(Frame& F) {
    const int lane = F.lane, wave = F.wave, tid = F.tid, hh = lane >> 5, ql = lane & 31;
    const bf16* Qb = WSP(bf16, WS_Q); const bf16* KVb = WSP(bf16, WS_KV); const bf16* KPE = WSP(bf16, WS_KPE); bf16* OA = WSP(bf16, WS_XB);
    const float SC = 0.10206207261596575f * 1.4426950408889634f;
    for (int bh = F.vcu; bh < BATCH * 8; bh += F.G) {
        const int b = bh >> 3, h = bh & 7; const int* posb = F.pos + b * SEQ;
        for (int qb = 0; qb < 4; ++qb) {
            const int q0 = qb * 512 + wave * 64;
            int cq[2]; float mrun[2], lrun[2]; f32x16 o0[2], o1[2];
            LAS unsigned char* QW = F.lds + 2 * MLA_BUF + wave * (64 * MLA_KP);
#pragma unroll
            for (int qs = 0; qs < 2; ++qs) { const size_t tq = (size_t)b * SEQ + q0 + 32 * qs + ql;
#pragma unroll
                for (int s = 0; s < 4; ++s) *(LAS v4u*)(QW + (32 * qs + ql) * MLA_KP + (16 * s + 8 * hh) * 2) = fp8x8_to_bf16x8(*(const GAS v2u*)((const unsigned char*)Qb + tq * 768 + h * 64 + 16 * s + 8 * hh));
#pragma unroll
                for (int s = 0; s < 2; ++s) {
                    const v4u qw = fp8x8_to_bf16x8(*(const GAS v2u*)((const unsigned char*)Qb + tq * 768 + 512 + h * 32 + 16 * s + 8 * hh));
                    const f32x4 ca = *(const GAS f32x4*)(WSP(float, WS_CS) + tq * 32 + 8 * (2 * s + hh)), cb = *(const GAS f32x4*)(WSP(float, WS_CS) + tq * 32 + 8 * (2 * s + hh) + 4);
                    const float a0 = bflo(qw.x), a1 = bfhi(qw.x), a2 = bflo(qw.y), a3 = bfhi(qw.y), b0 = bflo(qw.z), b1 = bfhi(qw.z), b2 = bflo(qw.w), b3 = bfhi(qw.w);
                    v4u ow; ow.x = pk2(a0 * ca[0] - b0 * ca[1], a1 * ca[2] - b1 * ca[3]); ow.y = pk2(a2 * cb[0] - b2 * cb[1], a3 * cb[2] - b3 * cb[3]);
                    ow.z = pk2(b0 * ca[0] + a0 * ca[1], b1 * ca[2] + a1 * ca[3]); ow.w = pk2(b2 * cb[0] + a2 * cb[1], b3 * cb[2] + a3 * cb[3]);
                    *(LAS v4u*)(QW + (32 * qs + ql) * MLA_KP + (64 + 16 * s + 8 * hh) * 2) = ow; }
                cq[qs] = posb[q0 + 32 * qs + ql] >> 6; mrun[qs] = -1e30f; lrun[qs] = 0.f;
#pragma unroll
                for (int i = 0; i < 16; ++i) { o0[qs][i] = 0.f; o1[qs][i] = 0.f; } }
            const int cq_min = __builtin_amdgcn_readfirstlane(posb[q0] >> 6), cq_max = __builtin_amdgcn_readfirstlane(posb[q0 + 63] >> 6);
            const int cq_last = __builtin_amdgcn_readfirstlane(posb[qb * 512 + 511] >> 6), pos0 = __builtin_amdgcn_readfirstlane(posb[0]);
            int nvis = (cq_last + 1) * 64 - pos0; nvis = nvis > SEQ ? SEQ : (nvis < 1 ? 1 : nvis);
            const int ntiles = (nvis + 63) >> 6;
            const int vk = tid >> 3, vc = tid & 7, pk = tid >> 2, pc = tid & 3;
            v2u kr0_8, vr_8; v4u kr1 = (v4u){0u, 0u, 0u, 0u}; int pr = 0;
#define MLA_LOAD(t) do { const size_t tk = (size_t)b * SEQ + (t) * 64; const unsigned char* rowp_ = (const unsigned char*)KVb + (tk + vk) * 1024 + h * 64 + 8 * vc;     \
                kr0_8 = *(const GAS v2u*)(rowp_); vr_8 = *(const GAS v2u*)(rowp_ + 512); \
                if (tid < 256) kr1 = *(const GAS v4u*)(KPE + (tk + pk) * 32 + 8 * pc); if (tid < 64) pr = posb[(t) * 64 + tid]; } while (0)
#define MLA_STORE(buf) do { LAS unsigned char* B_ = F.lds + (buf) * MLA_BUF; const v4u kr0 = fp8x8_to_bf16x8(kr0_8), vr = fp8x8_to_bf16x8(vr_8); \
                *(LAS v4u*)(B_ + MLA_KOFF + vk * MLA_KP + vc * 16) = kr0; if (tid < 256) *(LAS v4u*)(B_ + MLA_KOFF + pk * MLA_KP + (8 + pc) * 16) = kr1; \
                _Pragma("unroll") for (int i_ = 0; i_ < 4; ++i_) { *(LAS unsigned short*)(B_ + MLA_VOFF + (8 * vc + 2 * i_) * MLA_VP + vk * 2) = (unsigned short)(vr[i_] & 0xffffu); \
                    *(LAS unsigned short*)(B_ + MLA_VOFF + (8 * vc + 2 * i_ + 1) * MLA_VP + vk * 2) = (unsigned short)(vr[i_] >> 16); } \
                if (tid < 64) *(LAS int*)(B_ + MLA_POFF + tid * 4) = pr; } while (0)
            __syncthreads();
            MLA_LOAD(0); MLA_STORE(0); __syncthreads();
            for (int t = 0; t < ntiles; ++t) {
                if (t + 1 < ntiles) MLA_LOAD(t + 1);
                const LAS unsigned char* Bc = F.lds + (t & 1) * MLA_BUF;
                const int ckmin = (*(const LAS int*)(Bc + MLA_POFF)) >> 6, ckmax = (*(const LAS int*)(Bc + MLA_POFF + 63 * 4)) >> 6;
                if (ckmin <= cq_max) {
                    f32x16 s0[2], s1[2];
#pragma unroll
                    for (int qs = 0; qs < 2; ++qs)
#pragma unroll
                        for (int i = 0; i < 16; ++i) { s0[qs][i] = 0.f; s1[qs][i] = 0.f; }
                    bf16x8 kf[2][2], qa_, qb_;
#define MLA_KFR(d_, s_) do { kf[d_][0] = *(const LAS bf16x8*)(Bc + MLA_KOFF + ql * MLA_KP + (16 * (s_) + 8 * hh) * 2); kf[d_][1] = *(const LAS bf16x8*)(Bc + MLA_KOFF + (32 + ql) * MLA_KP + (16 * (s_) + 8 * hh) * 2); } while (0)
                    MLA_KFR(0, 0);
#pragma unroll
                    for (int s = 0; s < 6; ++s) {
                        qa_ = *(const LAS bf16x8*)(QW + ql * MLA_KP + (16 * s + 8 * hh) * 2); qb_ = *(const LAS bf16x8*)(QW + (32 + ql) * MLA_KP + (16 * s + 8 * hh) * 2);
                        if (s + 1 < 6) MLA_KFR((s + 1) & 1, s + 1);
                        __builtin_amdgcn_sched_barrier(0);
                        s0[0] = MFMA32(kf[s & 1][0], qa_, s0[0]); s1[0] = MFMA32(kf[s & 1][1], qa_, s1[0]); s0[1] = MFMA32(kf[s & 1][0], qb_, s0[1]); s1[1] = MFMA32(kf[s & 1][1], qb_, s1[1]);
                        __builtin_amdgcn_sched_barrier(0);
                    }
#undef MLA_KFR
                    if (ckmax > cq_min) {
#pragma unroll
                        for (int rg = 0; rg < 4; ++rg) {
                            const v4u p0 = *(const LAS v4u*)(Bc + MLA_POFF + (8 * rg + 4 * hh) * 4), p1 = *(const LAS v4u*)(Bc + MLA_POFF + (32 + 8 * rg + 4 * hh) * 4);
#pragma unroll
                            for (int qs = 0; qs < 2; ++qs)
#pragma unroll
                                for (int i = 0; i < 4; ++i) { if (((int)p0[i] >> 6) > cq[qs]) s0[qs][4 * rg + i] = -1e30f; if (((int)p1[i] >> 6) > cq[qs]) s1[qs][4 * rg + i] = -1e30f; }
                        }
                    }
                    bf16x8 pf[2][2][2];
#pragma unroll
                    for (int qs = 0; qs < 2; ++qs) {
                        float mx = fmaxf(fmaxf(s0[qs][0], s0[qs][1]), s1[qs][0]);
#pragma unroll
                        for (int i = 2; i < 16; i += 2) mx = fmaxf(fmaxf(mx, s0[qs][i]), s0[qs][i + 1]);
#pragma unroll
                        for (int i = 1; i < 16; i += 2) mx = fmaxf(fmaxf(mx, s1[qs][i]), s1[qs][(i + 1) & 15]);
                        mx = xhalf_max(mx);
                        const float mcand = mx * SC;
                        if (__builtin_amdgcn_ballot_w64(mcand > mrun[qs] + 8.0f) != 0ull) {
                            const float mnew_ = fmaxf(mrun[qs], mcand); const float al = __builtin_amdgcn_exp2f(mrun[qs] - mnew_); lrun[qs] *= al; mrun[qs] = mnew_;
#pragma unroll
                            for (int i = 0; i < 16; ++i) { o0[qs][i] *= al; o1[qs][i] *= al; }
                        }
                        const float mnew = mrun[qs];
                        float ps = 0.f;
#pragma unroll
                        for (int i = 0; i < 16; ++i) { s0[qs][i] = __builtin_amdgcn_exp2f(fmaf(s0[qs][i], SC, -mnew)); s1[qs][i] = __builtin_amdgcn_exp2f(fmaf(s1[qs][i], SC, -mnew)); ps += s0[qs][i] + s1[qs][i]; }
                        lrun[qs] += ps;
#pragma unroll
                        for (int s2 = 0; s2 < 2; ++s2) {
                            v4u w0, w1;
                            w0.x = pk2(s0[qs][8 * s2 + 0], s0[qs][8 * s2 + 1]); w0.y = pk2(s0[qs][8 * s2 + 2], s0[qs][8 * s2 + 3]); w0.z = pk2(s0[qs][8 * s2 + 4], s0[qs][8 * s2 + 5]); w0.w = pk2(s0[qs][8 * s2 + 6], s0[qs][8 * s2 + 7]);
                            w1.x = pk2(s1[qs][8 * s2 + 0], s1[qs][8 * s2 + 1]); w1.y = pk2(s1[qs][8 * s2 + 2], s1[qs][8 * s2 + 3]); w1.z = pk2(s1[qs][8 * s2 + 4], s1[qs][8 * s2 + 5]); w1.w = pk2(s1[qs][8 * s2 + 6], s1[qs][8 * s2 + 7]);
                            pf[qs][0][s2] = __builtin_bit_cast(bf16x8, w0); pf[qs][1][s2] = __builtin_bit_cast(bf16x8, w1);
                        }
                    }
#pragma unroll
                    for (int kb = 0; kb < 2; ++kb)
#pragma unroll
                        for (int s2 = 0; s2 < 2; ++s2) {
                            const int ko = (32 * kb + 16 * s2 + 4 * hh) * 2;
                            const v2u a0 = *(const LAS v2u*)(Bc + MLA_VOFF + ql * MLA_VP + ko), a1 = *(const LAS v2u*)(Bc + MLA_VOFF + ql * MLA_VP + ko + 16);
                            const v2u c0 = *(const LAS v2u*)(Bc + MLA_VOFF + (32 + ql) * MLA_VP + ko), c1 = *(const LAS v2u*)(Bc + MLA_VOFF + (32 + ql) * MLA_VP + ko + 16);
                            const v4u va = (v4u){a0.x, a0.y, a1.x, a1.y}, vb = (v4u){c0.x, c0.y, c1.x, c1.y};
#pragma unroll
                            for (int qs = 0; qs < 2; ++qs) { o0[qs] = MFMA32(__builtin_bit_cast(bf16x8, va), pf[qs][kb][s2], o0[qs]); o1[qs] = MFMA32(__builtin_bit_cast(bf16x8, vb), pf[qs][kb][s2], o1[qs]); }
                        }
                }
                if (t + 1 < ntiles) MLA_STORE((t + 1) & 1);
                __syncthreads();
            }
#undef MLA_LOAD
#undef MLA_STORE
#pragma unroll
            for (int qs = 0; qs < 2; ++qs) {
                const float inv = 32.0f / xhalf_sum(lrun[qs]);
                unsigned char* orow = (unsigned char*)OA + ((size_t)b * SEQ + q0 + 32 * qs + ql) * 1024 + h * 64;
#pragma unroll
                for (int rg = 0; rg < 4; ++rg) {
                    *(GAS unsigned*)(orow + 8 * rg + 4 * hh) = pk4_fp8(o0[qs][4 * rg] * inv, o0[qs][4 * rg + 1] * inv, o0[qs][4 * rg + 2] * inv, o0[qs][4 * rg + 3] * inv);
                    *(GAS unsigned*)(orow + 32 + 8 * rg + 4 * hh) = pk4_fp8(o1[qs][4 * rg] * inv, o1[qs][4 * rg + 1] * inv, o1[qs][4 * rg + 2] * inv, o1[qs][4 * rg + 3] * inv);
                }
            }
        }
    }
}

__device__ __forceinline__ int t5_bucket(int rel) {
    const int n = rel < 0 ? -rel : rel; const int ret = rel > 0 ? 16 : 0;
    int large = 8 + (int)(log2f((float)(n < 1 ? 1 : n) * 0.125f) * 2.0f); large = large > 15 ? 15 : large;
    return ret + (n < 8 ? n : large);
}
constexpr int DSA_POS_OFF = 0, DSA_BT_OFF = 8192  , DSA_WAVE_OFF = 12288, DSA_VP = 160  , DSA_WAVE_BYTES = 18688  ,
              DSA_LIST_OFF = 16384, DSA_LIST_STRIDE = 544  , DSA_KCNT_OFF = 16384 + 2176, DSA_PBUF_OFF = 0;
constexpr int DSA_SENT = (DSA_WAVE_OFF + 8 * DSA_WAVE_BYTES) / 4;
static_assert(DSA_WAVE_OFF + 8 * DSA_WAVE_BYTES + 16 <= MISC_OFF && DSA_SENT < 65536, "DSA LDS map");
__device__ __forceinline__ int half32_sum(int v) {
    v += __builtin_amdgcn_update_dpp(0, v, 0x111, 0xf, 0xf, true);
    v += __builtin_amdgcn_update_dpp(0, v, 0x112, 0xf, 0xf, true);
    v += __builtin_amdgcn_update_dpp(0, v, 0x114, 0xf, 0xf, true);
    v += __builtin_amdgcn_update_dpp(0, v, 0x118, 0xf, 0xf, true);
    v += __builtin_amdgcn_update_dpp(0, v, 0x142, 0xa, 0xf, true);
    const int lo = __builtin_amdgcn_readlane(v, 31), hi = __builtin_amdgcn_readlane(v, 63);
    return (threadIdx.x & 32) ? hi : lo;
}
__device__ __forceinline__ void dsa_select(const unsigned (&kA)[64], int nq, int hq, int kl, LAS unsigned short* LISTQ, LAS int* KCNTQ, int nkb) {
    const int KQ = nq < 256 ? nq : 256;
    unsigned T = 0u; bool done = false; int gq = 2048;
    if (nq <= 256) { T = 0x00800000u; done = true; gq = nq; }
    for (int bit = 31; bit >= 0; --bit) {
        if (__builtin_amdgcn_ballot_w64(!done) == 0ull) break;
        const unsigned cand = T | (1u << bit); int n_ = 0;
#pragma unroll
        for (int q4 = 0; q4 < 4; ++q4) { if (16 * q4 < nkb) {
#pragma unroll
            for (int kb = 16 * q4; kb < 16 * q4 + 16; ++kb) n_ += (kA[kb] >= cand) ? 1 : 0; } }
        n_ = half32_sum(n_);
        if (!done && n_ >= KQ) { T = cand; gq = n_; done = (n_ == KQ); }
    }
                const unsigned ltmask = (1u << kl) - 1u; int base = 0;
    const bool ties = __builtin_amdgcn_ballot_w64(gq != KQ) != 0ull;
    if (!ties) {
#pragma unroll
        for (int q4 = 0; q4 < 4; ++q4) { if (16 * q4 < nkb) {
#pragma unroll
        for (int kb = 16 * q4; kb < 16 * q4 + 16; ++kb) {
            const bool sel = kA[kb] >= T;
            const unsigned long long bal = __builtin_amdgcn_ballot_w64(sel);
            const unsigned w = hq ? (unsigned)(bal >> 32) : (unsigned)bal;
            LISTQ[sel ? base + __popc(w & ltmask) : 271] = (unsigned short)(32 * kb + kl);
            base += __popc(w);
        } } }
    } else {
        int gt = 0;
#pragma unroll
        for (int kb = 0; kb < 64; ++kb) gt += (kA[kb] > T) ? 1 : 0;
        gt = half32_sum(gt);
        int rem = KQ - gt;
#pragma unroll
        for (int kb = 0; kb < 64; ++kb) {
            const unsigned long long gb_ = __builtin_amdgcn_ballot_w64(kA[kb] > T), eb_ = __builtin_amdgcn_ballot_w64(kA[kb] == T);
            unsigned e = hq ? (unsigned)(eb_ >> 32) : (unsigned)eb_; const int c = __popc(e), take = c < rem ? c : rem;
            for (int dr = c - take; dr > 0; --dr) e &= ~(0x80000000u >> __builtin_clz(e));
            rem -= take; const unsigned w = (hq ? (unsigned)(gb_ >> 32) : (unsigned)gb_) | e;
            if ((w >> kl) & 1u) LISTQ[base + __popc(w & ltmask)] = (unsigned short)(32 * kb + kl);
            base += __popc(w);
        }
    }
    for (int s_ = base + kl; s_ < 272; s_ += 32) LISTQ[s_] = (unsigned short)DSA_SENT;
    if (kl == 0) *KCNTQ = base;
}
__device__ __forceinline__ void dsa_phase(Frame& F) {
    const int lane = F.lane, wave = F.wave, tid = F.tid, hq = lane >> 5, kl = lane & 31;
    const bf16* Hb = WSP(bf16, WS_H); const unsigned char* KIDX8 = WSP(unsigned char, WS_KIDX); const float* SKI = WSP(float, WS_SW) + 16384; const unsigned char* KB8 = WSP(unsigned char, WS_KB); const bf16* VBb = WSP(bf16, WS_VB);
    const float* WIDX = WSP(float, WS_WIDX); bf16* OB = (bf16*)(F.ws + WS_XB + 512);
    LAS int* POSB = (LAS int*)(F.lds + DSA_POS_OFF); LAS _Float16* BT = (LAS _Float16*)(F.lds + DSA_BT_OFF);
    LAS unsigned char* WL = F.lds + DSA_WAVE_OFF + wave * DSA_WAVE_BYTES;
    LAS float* PBUF = (LAS float*)(WL + DSA_PBUF_OFF); LAS int* KCNT = (LAS int*)(WL + DSA_KCNT_OFF);
    __syncthreads();
    for (int i = tid; i < 2048; i += NWAVES * 64) { const int e = i >> 3; const int bk = t5_bucket(e < 255 ? e - 127 : 127); BT[i] = e < 255 ? (_Float16)F.a->in[10][bk * 8 + (i & 7)] : (_Float16)(-65504.0f); }
    if (tid == 0) POSB[DSA_SENT] = 0x3fffffff;
    const float NEG_INF = -__builtin_inff();
    for (int gid = F.vcu; gid < 2048; gid += F.G) {
        const int rr = gid >> 8, cu = gid & 255, xq = cu >> 5, jj = cu & 31, b = 4 * xq + (jj & 3), cc = jj >> 2, tile = 8 * rr + ((rr & 1) ? 7 - cc : cc);
        const int* posb = F.pos + b * SEQ;
        __syncthreads();
        *(LAS v4u*)(POSB + 4 * tid) = *(const GAS v4u*)(posb + 4 * tid);
        __syncthreads();
        const int q0 = tile * 32 + wave * 4;
        typedef int i32x16 __attribute__((ext_vector_type(16)));
        i32x4 Aq8[2]; float sqrow;
        { const int jj = kl >> 3, hhr = (kl >> 2) & 1, ii = kl & 3, qiA = 2 * hhr + (jj >> 1), hdA = 4 * (jj & 1) + ii; const size_t tA = (size_t)b * SEQ + q0 + qiA;
          float qf[2][16]; float am = 0.f;
#pragma unroll
          for (int s = 0; s < 2; ++s) { const v4u w8 = *(const GAS v4u*)((const unsigned char*)(Hb + tA * HW) + H_QIDX + hdA * 64 + 32 * s + 16 * hq);
#pragma unroll
              for (int i = 0; i < 4; ++i) { const f32x2p lo = __builtin_amdgcn_cvt_pk_f32_fp8((int)w8[i], false), hi = __builtin_amdgcn_cvt_pk_f32_fp8((int)w8[i], true);
                  qf[s][4 * i] = lo.x; qf[s][4 * i + 1] = lo.y; qf[s][4 * i + 2] = hi.x; qf[s][4 * i + 3] = hi.y; }
#pragma unroll
              for (int i = 0; i < 16; ++i) am = fmaxf(am, fabsf(qf[s][i])); }
          am = fmaxf(am, __shfl_xor(am, 32)); sqrow = am > 0.f ? am * (1.0f / 127.0f) : 1.0f; const float isq = 1.0f / sqrow;
#pragma unroll
          for (int s = 0; s < 2; ++s)
#pragma unroll
              for (int w = 0; w < 4; ++w) { unsigned q4 = 0u;
#pragma unroll
                  for (int i = 0; i < 4; ++i) { float q = rintf(qf[s][4 * w + i] * isq); q = fminf(fmaxf(q, -127.f), 127.f); q4 |= ((unsigned)(int)q & 0xffu) << (8 * i); }
                  Aq8[s][w] = (int)q4; } }
        const size_t tq0 = (size_t)b * SEQ + q0 + 2 * hq;
        float wv[16];
        { const f32x4 w0a = *(const GAS f32x4*)(WIDX + tq0 * 8), w0b = *(const GAS f32x4*)(WIDX + tq0 * 8 + 4), w1a = *(const GAS f32x4*)(WIDX + tq0 * 8 + 8), w1b = *(const GAS f32x4*)(WIDX + tq0 * 8 + 12);
          const float wb[16] = {w0a[0], w0a[1], w0a[2], w0a[3], w0b[0], w0b[1], w0b[2], w0b[3], w1a[0], w1a[1], w1a[2], w1a[3], w1b[0], w1b[1], w1b[2], w1b[3]};
#pragma unroll
          for (int v = 0; v < 16; ++v) { const int rsrc = 8 * (2 * (v >> 3) + ((v & 7) >> 2)) + 4 * hq + (v & 3); wv[v] = wb[v] * __shfl(sqrow, rsrc); } }
        const int cq0 = POSB[q0 + 2 * hq] >> 6, cq1 = POSB[q0 + 2 * hq + 1] >> 6;
        int nvis = ((POSB[q0 + 3] >> 6) + 1) * 64 - POSB[0]; nvis = nvis > SEQ ? SEQ : (nvis < 1 ? 1 : nvis);
        const int nkb = __builtin_amdgcn_readfirstlane((nvis + 31) >> 5);
        LAS unsigned* KBL = (LAS unsigned*)WL;
        unsigned kA[64]; int nA = 0, nB = 0;
        const unsigned char* kp = KIDX8 + ((size_t)b * SEQ + kl) * 64 + 16 * hq;
        const float* skp = SKI + (size_t)b * SEQ + kl;
        i32x4 kr[8][2]; float skr[8];
#pragma unroll
        for (int j = 0; j < 7; ++j) { const int jb = j < nkb ? j : nkb - 1; kr[j][0] = *(const GAS i32x4*)(kp + (size_t)jb * 2048); kr[j][1] = *(const GAS i32x4*)(kp + (size_t)jb * 2048 + 32); skr[j] = skp[jb * 32]; }
        { const int lastb = (nkb > 7 ? 6 : nkb - 1); kp += (size_t)lastb * 2048; skp += lastb * 32; }
#pragma unroll
        for (int kb = 0; kb < 64; ++kb) {
            if (kb < nkb) {
                const int key = 32 * kb + kl;
                if (kb + 7 < nkb) { kp += 2048; skp += 32; }
                kr[(kb + 7) & 7][0] = *(const GAS i32x4*)kp; kr[(kb + 7) & 7][1] = *(const GAS i32x4*)(kp + 32); skr[(kb + 7) & 7] = *skp;
                i32x16 acc;
#pragma unroll
                for (int i = 0; i < 16; ++i) acc[i] = 0;
                acc = __builtin_amdgcn_mfma_i32_32x32x32_i8(Aq8[0], kr[kb & 7][0], acc, 0, 0, 0);
                acc = __builtin_amdgcn_mfma_i32_32x32x32_i8(Aq8[1], kr[kb & 7][1], acc, 0, 0, 0);
                const int ck = POSB[key] >> 6;
                float sa = 0.f, sb = 0.f;
#pragma unroll
                for (int hd_ = 0; hd_ < 8; ++hd_) { const int a_ = acc[hd_] > 0 ? acc[hd_] : 0, b_ = acc[8 + hd_] > 0 ? acc[8 + hd_] : 0; sa += wv[hd_] * (float)a_; sb += wv[8 + hd_] * (float)b_; }
                sa *= skr[kb & 7]; sb *= skr[kb & 7];
                const bool ma = ck <= cq0, mb = ck <= cq1;
                nA += ma ? 1 : 0; nB += mb ? 1 : 0;
                const unsigned ua = __float_as_uint(ma ? sa + 0.0f : NEG_INF), ub = __float_as_uint(mb ? sb + 0.0f : NEG_INF);
                kA[kb] = ua ^ ((unsigned)((int)ua >> 31) | 0x80000000u); KBL[kb * 64 + lane] = ub ^ ((unsigned)((int)ub >> 31) | 0x80000000u);
            } else { kA[kb] = 0x007fffffu; KBL[kb * 64 + lane] = 0x007fffffu; }
        }
#pragma unroll
        for (int o = 1; o < 32; o <<= 1) { nA += __shfl_xor(nA, o); nB += __shfl_xor(nB, o); }
#if DSA_SKIP != 2
        dsa_select(kA, nA, hq, kl, (LAS unsigned short*)(WL + DSA_LIST_OFF + (2 * hq) * DSA_LIST_STRIDE), KCNT + 2 * hq, nkb);
#pragma unroll
        for (int kb = 0; kb < 64; ++kb) kA[kb] = KBL[kb * 64 + lane];
        dsa_select(kA, nB, hq, kl, (LAS unsigned short*)(WL + DSA_LIST_OFF + (2 * hq + 1) * DSA_LIST_STRIDE), KCNT + 2 * hq + 1, nkb);
#endif
#if DSA_SKIP == 0
        const int hd = lane & 15, g4 = lane >> 4;
        const unsigned char* vsrc8 = (const unsigned char*)VBb + (size_t)b * SEQ * 64;
        const int vrr = lane >> 2;
        const unsigned vx_hi = (unsigned)(((lane >> 4) & 1) << 1);
        unsigned vrd[4];
        { const int rp = (lane & 15) >> 1, keyr = rp < 4 ? 4 * g4 + rp : 16 + 4 * g4 + (rp - 4); const unsigned xk = (unsigned)(((keyr >> 4) & 1) | (((keyr >> 2) & 1) << 1));
#pragma unroll
          for (int d = 0; d < 4; ++d) vrd[d] = (unsigned)(size_t)WL + (unsigned)(keyr * 64) + ((((unsigned)d) ^ xk) << 4) + 8u * (lane & 1); }
        v4u kw[16]; v2u qwr[2];
#define DSA_KQ_LOAD(qn) do { const LAS unsigned short* LISTn_ = (const LAS unsigned short*)(WL + DSA_LIST_OFF + (qn) * DSA_LIST_STRIDE); const int nblkn_ = (__builtin_amdgcn_readfirstlane(KCNT[qn]) + 15) >> 4; \
            _Pragma("unroll") for (int c = 0; c < 2; ++c) qwr[c] = *(const GAS v2u*)((const unsigned char*)(Hb + ((size_t)b * SEQ + q0 + (qn)) * HW) + H_QB + (hd & 7) * 64 + 32 * c + 8 * g4);     \
            int kidx_[16]; _Pragma("unroll") for (int blk = 0; blk < 16; ++blk) { const int idl_ = (int)LISTn_[16 * blk + hd]; kidx_[blk] = idl_ < 2047 ? idl_ : 2047; }     \
            __builtin_amdgcn_sched_barrier(0);                             \
            _Pragma("unroll") for (int blk = 0; blk < 16; ++blk) kw[blk] = *(const GAS v4u*)(KB8 + ((size_t)b * SEQ + kidx_[blk]) * 64 + 16 * g4); } while (0)
        DSA_KQ_LOAD(0);
        for (int qq_ = 0; qq_ < 4 * DSA_REP; ++qq_) { const int q = qq_ & 3;
            const LAS unsigned short* LIST = (const LAS unsigned short*)(WL + DSA_LIST_OFF + q * DSA_LIST_STRIDE);
            const int L = __builtin_amdgcn_readfirstlane(KCNT[q]), nblk = (L + 15) >> 4, L16 = 16 * nblk;
            const size_t tq = (size_t)b * SEQ + q0 + q; const int posq = POSB[q0 + q];
            {
#pragma unroll 8
              for (int it = 0; it < 16; ++it) { const int slot_ = 16 * it + vrr; const int l_ = (int)LIST[slot_]; const int idx_ = l_ < 2047 ? l_ : 2047;
                  __builtin_amdgcn_global_load_lds((const unsigned*)(vsrc8 + (size_t)idx_ * 64 + ((((unsigned)(lane & 3)) ^ ((unsigned)(it & 1) | vx_hi)) << 4)), (LAS unsigned*)(WL + it * 1024), 16, 0, 0); } }
            long Bq8[2];
#pragma unroll
            for (int c = 0; c < 2; ++c) Bq8[c] = (long)(((unsigned long long)qwr[c].y << 32) | qwr[c].x);
            float lg[16][4]; float mx = -1e30f;
            { v2u id4s[16];
#pragma unroll
              for (int blk = 0; blk < 16; ++blk) id4s[blk] = *(const LAS v2u*)(LIST + 16 * blk + 4 * g4);
              __builtin_amdgcn_sched_barrier(0);
              int ps[16][4];
#pragma unroll
              for (int blk = 0; blk < 16; ++blk) { const v2u id4 = id4s[blk];
                  ps[blk][0] = POSB[id4.x & 0xffffu]; ps[blk][1] = POSB[id4.x >> 16]; ps[blk][2] = POSB[id4.y & 0xffffu]; ps[blk][3] = POSB[id4.y >> 16]; }
              __builtin_amdgcn_sched_barrier(0);
#pragma unroll
              for (int blk = 0; blk < 16; ++blk)
#pragma unroll
                  for (int i = 0; i < 4; ++i) { int rel = ps[blk][i] - posq; rel = rel < -127 ? -127 : (rel > 128 ? 128 : rel);
                      lg[blk][i] = (float)BT[(rel + 127) * 8 + (hd & 7)]; }
              __builtin_amdgcn_sched_barrier(0); }
#pragma unroll
            for (int blk = 0; blk < 16; ++blk) {
                f32x4 acc = (f32x4){0.f, 0.f, 0.f, 0.f};
                acc = __builtin_amdgcn_mfma_f32_16x16x32_fp8_fp8((long)(((unsigned long long)kw[blk].y << 32) | kw[blk].x), Bq8[0], acc, 0, 0, 0);
                acc = __builtin_amdgcn_mfma_f32_16x16x32_fp8_fp8((long)(((unsigned long long)kw[blk].w << 32) | kw[blk].z), Bq8[1], acc, 0, 0, 0);
#pragma unroll
                for (int i = 0; i < 4; ++i) { const float v = acc[i] * 0.125f + lg[blk][i]; lg[blk][i] = v; mx = fmaxf(mx, v); }
            }
            const bool more = qq_ + 1 < 4 * DSA_REP;
            mx = fmaxf(mx, __shfl_xor(mx, 16)); mx = xhalf_max(mx);
            const float ex0 = 8.0f - mx * 1.4426950408889634f;
            long pf8[8];
#pragma unroll
            for (int c = 0; c < 8; ++c) {
                float e[8];
#pragma unroll
                for (int i = 0; i < 4; ++i) { e[i] = __builtin_amdgcn_exp2f(fmaf(lg[2 * c][i], 1.4426950408889634f, ex0)); e[4 + i] = __builtin_amdgcn_exp2f(fmaf(lg[2 * c + 1][i], 1.4426950408889634f, ex0)); }
                int plo, phi; asm("" : "=v"(plo), "=v"(phi));
                plo = __builtin_amdgcn_cvt_pk_fp8_f32(e[0], e[1], plo, false); plo = __builtin_amdgcn_cvt_pk_fp8_f32(e[2], e[3], plo, true);
                phi = __builtin_amdgcn_cvt_pk_fp8_f32(e[4], e[5], phi, false); phi = __builtin_amdgcn_cvt_pk_fp8_f32(e[6], e[7], phi, true);
                pf8[c] = (long)(((unsigned long long)(unsigned)phi << 32) | (unsigned)plo);
            }
            if (more) DSA_KQ_LOAD((qq_ + 1) & 3);
            f32x4 oacc[4], osum = (f32x4){0.f, 0.f, 0.f, 0.f};
#pragma unroll
            for (int d = 0; d < 4; ++d) oacc[d] = (f32x4){0.f, 0.f, 0.f, 0.f};
            if (more) asm volatile("s_waitcnt vmcnt(18)" ::: "memory"); else asm volatile("s_waitcnt vmcnt(0)" ::: "memory");
            v2u tv_[8][4];
#pragma unroll
            for (int gc = 0; gc < 8; ++gc)
                asm volatile("ds_read_b64_tr_b8 %0, %4 offset:%8\n\tds_read_b64_tr_b8 %1, %5 offset:%8\n\tds_read_b64_tr_b8 %2, %6 offset:%8\n\tds_read_b64_tr_b8 %3, %7 offset:%8"
                             : "=&v"(tv_[gc][0]), "=&v"(tv_[gc][1]), "=&v"(tv_[gc][2]), "=&v"(tv_[gc][3]) : "v"(vrd[0]), "v"(vrd[1]), "v"(vrd[2]), "v"(vrd[3]), "i"(gc * 2048) : "memory");
            asm volatile("s_waitcnt lgkmcnt(0)" : "+v"(tv_[0][0]), "+v"(tv_[0][1]), "+v"(tv_[0][2]), "+v"(tv_[0][3]), "+v"(tv_[1][0]), "+v"(tv_[1][1]), "+v"(tv_[1][2]), "+v"(tv_[1][3]) :: "memory");
            asm volatile("" : "+v"(tv_[2][0]), "+v"(tv_[2][1]), "+v"(tv_[2][2]), "+v"(tv_[2][3]), "+v"(tv_[3][0]), "+v"(tv_[3][1]), "+v"(tv_[3][2]), "+v"(tv_[3][3]) :: "memory");
            asm volatile("" : "+v"(tv_[4][0]), "+v"(tv_[4][1]), "+v"(tv_[4][2]), "+v"(tv_[4][3]), "+v"(tv_[5][0]), "+v"(tv_[5][1]), "+v"(tv_[5][2]), "+v"(tv_[5][3]) :: "memory");
            asm volatile("" : "+v"(tv_[6][0]), "+v"(tv_[6][1]), "+v"(tv_[6][2]), "+v"(tv_[6][3]), "+v"(tv_[7][0]), "+v"(tv_[7][1]), "+v"(tv_[7][2]), "+v"(tv_[7][3]) :: "memory");
#pragma unroll
            for (int gc = 0; gc < 8; ++gc) { const long pb = pf8[gc];
                osum = __builtin_amdgcn_mfma_f32_16x16x32_fp8_fp8((long)0x3838383838383838ll, pb, osum, 0, 0, 0);
#pragma unroll
                for (int d = 0; d < 4; ++d) oacc[d] = __builtin_amdgcn_mfma_f32_16x16x32_fp8_fp8((long)(((unsigned long long)tv_[gc][d].y << 32) | tv_[gc][d].x), pb, oacc[d], 0, 0, 0); }
            const float inv32 = 32.0f / osum[0];
            if (hd < 8) {
#pragma unroll
                for (int d = 0; d < 4; ++d) *(GAS unsigned*)((unsigned char*)OB + tq * 1024 + hd * 64 + 16 * d + 4 * g4) = pk4_fp8(oacc[d][0] * inv32, oacc[d][1] * inv32, oacc[d][2] * inv32, oacc[d][3] * inv32);
            }
        }
#else
        { unsigned keep = 0u;
#if DSA_SKIP == 2
#pragma unroll
          for (int kb = 0; kb < 64; ++kb) keep ^= kA[kb];
          keep ^= (unsigned)(nA + nB);
#endif
          for (int q = 0; q < 4; ++q)
#pragma unroll
              for (int i = 0; i < 8; ++i) *(GAS unsigned short*)(OB + ((size_t)b * SEQ + q0 + q) * 512 + i * 64 + lane) = (unsigned short)((keep == 0x12345u) ? 1u : 0u); }
#endif
    }
}

__device__ __forceinline__ void ln1_phase(Frame& F) {
    constexpr int U = 4;
    const int gw = F.vcu * NWAVES + F.wave, NGW = F.G * NWAVES, lane = F.lane;
    const bf16* Y = WSP(bf16, WS_H);
    f32x4 g[4], bb[4];
#pragma unroll
    for (int j = 0; j < 4; ++j) { g[j] = *((const GAS f32x4*)F.a->in[12] + lane + 64 * j); bb[j] = *((const GAS f32x4*)F.a->in[13] + lane + 64 * j); }
    for (int t0 = gw; t0 < M; t0 += NGW * U) {
        f32x4 v[U][4]; float s[U], s2[U], am[U];
#pragma unroll
        for (int u = 0; u < U; ++u) { const int t = t0 + u * NGW < M ? t0 + u * NGW : t0; const GAS v2u* yr = (const GAS v2u*)(Y + (size_t)t * D) + lane;
#pragma unroll
            for (int j = 0; j < 4; ++j) { const v2u w = yr[64 * j]; v[u][j] = (f32x4){bflo(w.x), bfhi(w.x), bflo(w.y), bfhi(w.y)}; } }
#pragma unroll
        for (int u = 0; u < U; ++u) { s[u] = 0.f;
#pragma unroll
            for (int j = 0; j < 4; ++j) s[u] += (v[u][j][0] + v[u][j][1]) + (v[u][j][2] + v[u][j][3]); }
        wave_sum_n<U>(s);
#pragma unroll
        for (int u = 0; u < U; ++u) { const float mean = s[u] * (1.f / D); s2[u] = 0.f;
#pragma unroll
            for (int j = 0; j < 4; ++j) { v[u][j] = v[u][j] - mean; s2[u] += (v[u][j][0] * v[u][j][0] + v[u][j][1] * v[u][j][1]) + (v[u][j][2] * v[u][j][2] + v[u][j][3] * v[u][j][3]); } }
        wave_sum_n<U>(s2);
#pragma unroll
        for (int u = 0; u < U; ++u) { const float rstd = 1.f / sqrtf(s2[u] * (1.f / D) + LN_EPS); am[u] = 0.f;
#pragma unroll
            for (int j = 0; j < 4; ++j) { v[u][j] = v[u][j] * rstd * g[j] + bb[j]; am[u] = fmaxf(am[u], fmaxf(fmaxf(fabsf(v[u][j][0]), fabsf(v[u][j][1])), fmaxf(fabsf(v[u][j][2]), fabsf(v[u][j][3])))); } }
        wave_max_n<U>(am);
#pragma unroll
        for (int u = 0; u < U; ++u) { const int t = t0 + u * NGW; if (t < M) {
            const float xm = am[u] > 0.f ? am[u] * 1.01f : 1.0f, isq = 119.0f / xm;
#pragma unroll
            for (int j = 0; j < 4; ++j) {
                unsigned q4 = 0u;
#pragma unroll
                for (int i = 0; i < 4; ++i) { float q = rintf(v[u][j][i] * isq); q = fminf(fmaxf(q, -119.f), 119.f); q4 |= ((unsigned)(int)q & 0xffu) << (8 * i); }
                *((GAS unsigned*)(F.ws + WS_X1Q + (size_t)t * D) + lane + 64 * j) = q4; }
            if (lane == 0) WSP(float, WS_SX)[t] = xm * (1.0f / 119.0f); } }
    }
}

template <int OFF> __device__ __forceinline__ void sort16_desc(float (&x)[64]) {
#define S16_CE(i, j) { const float hi_ = fmaxf(x[OFF + (i)], x[OFF + (j)]), lo_ = fminf(x[OFF + (i)], x[OFF + (j)]); x[OFF + (i)] = hi_; x[OFF + (j)] = lo_; }
    S16_CE(0, 13) S16_CE(1, 12) S16_CE(2, 15) S16_CE(3, 14) S16_CE(4, 8) S16_CE(5, 6) S16_CE(7, 11) S16_CE(9, 10)
    S16_CE(0, 5) S16_CE(1, 7) S16_CE(2, 9) S16_CE(3, 4) S16_CE(6, 13) S16_CE(8, 14) S16_CE(10, 15) S16_CE(11, 12)
    S16_CE(0, 1) S16_CE(2, 3) S16_CE(4, 5) S16_CE(6, 8) S16_CE(7, 9) S16_CE(10, 11) S16_CE(12, 13) S16_CE(14, 15)
    S16_CE(0, 2) S16_CE(1, 3) S16_CE(4, 10) S16_CE(5, 11) S16_CE(6, 7) S16_CE(8, 9) S16_CE(12, 14) S16_CE(13, 15)
    S16_CE(1, 2) S16_CE(3, 12) S16_CE(4, 6) S16_CE(5, 7) S16_CE(8, 10) S16_CE(9, 11) S16_CE(13, 14)
    S16_CE(1, 4) S16_CE(2, 6) S16_CE(5, 8) S16_CE(7, 10) S16_CE(9, 13) S16_CE(11, 14)
    S16_CE(2, 4) S16_CE(3, 6) S16_CE(9, 12) S16_CE(11, 13)
    S16_CE(3, 5) S16_CE(6, 8) S16_CE(7, 9) S16_CE(10, 12)
    S16_CE(3, 4) S16_CE(5, 6) S16_CE(7, 8) S16_CE(9, 10) S16_CE(11, 12)
    S16_CE(6, 7) S16_CE(8, 9)
#undef S16_CE
}
template <int OFF> __device__ __forceinline__ void bitonic_merge16_desc(float (&x)[64]) {
#pragma unroll
    for (int j = 8; j > 0; j >>= 1)
#pragma unroll
        for (int i = 0; i < 16; ++i) { const int l = i ^ j; if (l > i) { const float hi = fmaxf(x[OFF + i], x[OFF + l]), lo = fminf(x[OFF + i], x[OFF + l]); x[OFF + i] = hi; x[OFF + l] = lo; } }
}
template <int OFF, int OFFB> __device__ __forceinline__ void merge_top16(float (&x)[64]) {
#pragma unroll
    for (int i = 0; i < 16; ++i) x[OFF + i] = fmaxf(x[OFF + i], x[OFFB + 15 - i]);
    bitonic_merge16_desc<OFF>(x);
}
__device__ __forceinline__ void top16_of_64(float (&x)[64]) {
    sort16_desc<0>(x); sort16_desc<16>(x); sort16_desc<32>(x); sort16_desc<48>(x);
    merge_top16<0, 16>(x); merge_top16<32, 48>(x); merge_top16<0, 32>(x);
}
__device__ __forceinline__ void route_phase(Frame& F) {
    const int lane = F.lane, hh = lane >> 5, tl = lane & 31;
    const bf16* QP = (const bf16*)(F.ws + WS_H + 256 * MiB); const bf16* SUBK = WSP(bf16, WS_SUBK);
    unsigned short* EIDX = WSP(unsigned short, WS_Q); bf16* GATE = (bf16*)(F.ws + WS_Q + 32 * MiB);
    LAS float* SCR = (LAS float*)(F.lds + F.wave * 16384);
    LAS unsigned char* TB = F.lds + F.wave * 16384;
    LAS unsigned char* CT = F.lds + 8 * 16384;
    __syncthreads();
    if (F.tid < 64) { const int c = F.tid; int a, bb;
        if (c < 16) { a = 0; bb = c; } else if (c < 24) { a = 1; bb = c - 16; } else if (c < 29) { a = 2; bb = c - 24; } else if (c < 33) { a = 3; bb = c - 29; } else if (c < 36) { a = 4; bb = c - 33; }
        else if (c < 42) { a = 5 + ((c - 36) >> 1); bb = (c - 36) & 1; } else { a = 8 + ((c - 42) & 7); bb = 0; }
        CT[c] = (unsigned char)(a | (bb << 4)); }
    __syncthreads();
    const float NEG_INF = -__builtin_inff();
    const int gw = F.vcu * NWAVES + F.wave, NGW = F.G * NWAVES;
    for (int wu = gw; wu < M / 32; wu += NGW) {
        const size_t tok = (size_t)wu * 32 + tl;
        const bf16* skp = SUBK + (size_t)tl * 128 + 8 * hh;
        bf16x8 ak[2][8];
#pragma unroll
        for (int s = 0; s < 8; ++s) ak[0][s] = *(const GAS bf16x8*)(skp + 16 * s);
        for (int h2 = 0; h2 < 4; ++h2) {
          for (int hi = 0; hi < 2; ++hi) { const int h = 2 * h2 + hi;
#pragma unroll
            for (int p = 0; p < 2; ++p) {
                const int hp = 2 * h + p;
                bf16x8 bq[8];
#pragma unroll
                for (int s = 0; s < 8; ++s) bq[s] = *(const GAS bf16x8*)(QP + tok * 2048 + hp * 128 + 16 * s + 8 * hh);
                float sc[64];
#pragma unroll
                for (int nb = 0; nb < 4; ++nb) {
                    { const int nidx = 4 * hp + nb + 1; const bf16* nx = skp + (size_t)(nidx < 64 ? nidx : 63) * (32 * 128);
#pragma unroll
                      for (int s = 0; s < 8; ++s) ak[(nb + 1) & 1][s] = *(const GAS bf16x8*)(nx + 16 * s); }
                    f32x16 acc;
#pragma unroll
                    for (int i = 0; i < 16; ++i) acc[i] = 0.f;
#pragma unroll
                    for (int s = 0; s < 8; ++s) acc = MFMA32(ak[nb & 1][s], bq[s], acc);
#pragma unroll
                    for (int v = 0; v < 16; ++v) { const int n = 32 * nb + (v & 3) + 8 * (v >> 2) + 4 * hh; sc[16 * nb + v] = __uint_as_float((__float_as_uint(acc[v]) & ~0x7fu) | (unsigned)n); }
                    asm volatile("" ::: "memory");
                }
                top16_of_64(sc);
                { float pt[16];
#pragma unroll
                  for (int i = 0; i < 16; ++i) pt[i] = __shfl_xor(sc[15 - i], 32);
#pragma unroll
                  for (int i = 0; i < 16; ++i) sc[i] = fmaxf(sc[i], pt[i]); }
                bitonic_merge16_desc<0>(sc);
#pragma unroll
                for (int k = 0; k < 16; ++k) SCR[((hi * 2 + p) * 16 + k) * 64 + lane] = sc[k];
            }
          }
            const int h = 2 * h2 + hh;
            float tv[2][16];
#pragma unroll
            for (int p = 0; p < 2; ++p)
#pragma unroll
                for (int k = 0; k < 16; ++k) tv[p][k] = SCR[((hh * 2 + p) * 16 + k) * 64 + lane];
            asm volatile("s_waitcnt lgkmcnt(0)" ::: "memory");
#pragma unroll
            for (int k = 0; k < 16; ++k) { TB[lane * 32 + k] = (unsigned char)(__float_as_uint(tv[0][k]) & 0x7fu); TB[lane * 32 + 16 + k] = (unsigned char)(__float_as_uint(tv[1][k]) & 0x7fu); }
            float cand[64];
            { int c = 0;
#pragma unroll
              for (int a = 0; a < 16; ++a)
#pragma unroll
                  for (int bb = 0; bb < 16; ++bb) if ((a + 1) * (bb + 1) <= 16) { cand[c] = __uint_as_float((__float_as_uint(tv[0][a] + tv[1][bb]) & ~0x3fu) | (unsigned)c); ++c; }
#pragma unroll
              for (int i = 50; i < 64; ++i) cand[i] = NEG_INF; }
            top16_of_64(cand);
            float top[16]; int eid[16];
            { unsigned abv[16];
#pragma unroll
              for (int k = 0; k < 16; ++k) { top[k] = cand[k]; abv[k] = CT[(int)(__float_as_uint(cand[k]) & 0x3fu)]; }
              __builtin_amdgcn_sched_barrier(0);
              unsigned e1_[16], e2_[16];
#pragma unroll
              for (int k = 0; k < 16; ++k) { e1_[k] = TB[lane * 32 + (abv[k] & 15u)]; e2_[k] = TB[lane * 32 + 16 + (abv[k] >> 4)]; }
              __builtin_amdgcn_sched_barrier(0);
#pragma unroll
              for (int k = 0; k < 16; ++k) eid[k] = (int)(e1_[k] * 128u + e2_[k]); }
            float gs = 0.f, ge[16];
#pragma unroll
            for (int k = 0; k < 16; ++k) { ge[k] = __builtin_amdgcn_exp2f((top[k] - top[0]) * 1.4426950408889634f); gs += ge[k]; }
            const float gi = 1.0f / gs;
            {
                v4u e0, e1;
                e0.x = (unsigned)eid[0] | ((unsigned)eid[1] << 16); e0.y = (unsigned)eid[2] | ((unsigned)eid[3] << 16); e0.z = (unsigned)eid[4] | ((unsigned)eid[5] << 16); e0.w = (unsigned)eid[6] | ((unsigned)eid[7] << 16);
                e1.x = (unsigned)eid[8] | ((unsigned)eid[9] << 16); e1.y = (unsigned)eid[10] | ((unsigned)eid[11] << 16); e1.z = (unsigned)eid[12] | ((unsigned)eid[13] << 16); e1.w = (unsigned)eid[14] | ((unsigned)eid[15] << 16);
                *(GAS v4u*)(EIDX + tok * 128 + h * 16) = e0; *(GAS v4u*)(EIDX + tok * 128 + h * 16 + 8) = e1;
#pragma unroll
                for (int k8 = 0; k8 < 2; ++k8) *(GAS v4u*)(GATE + tok * 128 + h * 16 + 8 * k8) = (v4u){pk2(ge[8 * k8] * gi, ge[8 * k8 + 1] * gi), pk2(ge[8 * k8 + 2] * gi, ge[8 * k8 + 3] * gi), pk2(ge[8 * k8 + 4] * gi, ge[8 * k8 + 5] * gi), pk2(ge[8 * k8 + 6] * gi, ge[8 * k8 + 7] * gi)};
            }
        }
    }
}

__device__ __forceinline__ float gelu_tanh(float x) {
    const float z = 0.7978845608028654f * (x + 0.044715f * x * x * x);
    const float e = __builtin_amdgcn_exp2f(z * 2.8853900817779268f);
    const float th = 1.0f - 2.0f * __builtin_amdgcn_rcpf(e + 1.0f);
    return 0.5f * x * (1.0f + th);
}
#define UB0(w) ((float)((w) & 0xffu))
#define UB1(w) ((float)(((w) >> 8) & 0xffu))
#define UB2(w) ((float)(((w) >> 16) & 0xffu))
#define UB3(w) ((float)((w) >> 24))
struct E1Meta { v4u xa, xb, e0, e1; };
__device__ __forceinline__ void e1_phase(Frame& F) {
    const int lane = F.lane, r = lane & 7, gi = lane >> 3, per = F.G >> 2, shard = F.vcu / (per > 0 ? per : 1) > 3 ? 3 : F.vcu / (per > 0 ? per : 1);
    const int wsh = (F.vcu - shard * per) * NWAVES + F.wave, nwsh = (shard == 3 ? F.G - 3 * per : per) * NWAVES;
    const unsigned char* X1Q = (const unsigned char*)(F.ws + WS_X1Q); const unsigned short* EIDX = WSP(unsigned short, WS_Q);
    const unsigned char* tb = WSP(unsigned char, WS_PU) + (size_t)shard * SHARD_BYTES; const unsigned roff = 16u * (unsigned)r; bf16* PART = WSP(bf16, WS_H) + (size_t)shard * M * 128;
#define E1_META(M_, tt) do { const int t_ = (tt) < M ? (tt) : wsh; \
        M_.xa = *(const GAS v4u*)(X1Q + (size_t)t_ * D + 256 * shard + 32 * r); M_.xb = *(const GAS v4u*)(X1Q + (size_t)t_ * D + 256 * shard + 32 * r + 16); \
        M_.e0 = *(const GAS v4u*)(EIDX + (size_t)t_ * 128 + 16 * gi); M_.e1 = *(const GAS v4u*)(EIDX + (size_t)t_ * 128 + 16 * gi + 8); } while (0)
#define E1_ROWS(UR_, QH_, QL_, M_) do { \
        _Pragma("unroll") for (int i = 0; i < 16; ++i) { const unsigned w_ = i < 8 ? M_.e0[i >> 1] : M_.e1[(i - 8) >> 1]; const unsigned id_ = (i & 1) ? (w_ >> 16) : (w_ & 0xffffu); UR_[i] = *(const GAS v4u*)(tb + (size_t)(id_ * 128u + roff)); } \
        _Pragma("unroll") for (int w = 0; w < 4; ++w) { const unsigned q0_ = w < 2 ? M_.xa[2 * w] : M_.xb[2 * w - 4], q1_ = w < 2 ? M_.xa[2 * w + 1] : M_.xb[2 * w - 3]; \
            const unsigned y0_ = ((q0_ ^ 0x80808080u) + 0x08080808u) ^ 0x80808080u, y1_ = ((q1_ ^ 0x80808080u) + 0x08080808u) ^ 0x80808080u; \
            QH_[w] = ((y0_ >> 4) & 0x0f0f0f0fu) | (y1_ & 0xf0f0f0f0u); QL_[w] = (q0_ & 0x0f0f0f0fu) | ((q1_ << 4) & 0xf0f0f0f0u); } } while (0)
#define E1_XOR(v, o) ((o) == 4 ? dpp_xor4(v) : ((o) == 2 ? dpp_xor2(v) : dpp_xor1(v)))
#define E1_TR(n, o) _Pragma("unroll") for (int i = 0; i < (n); ++i) { const bool up_ = (lane & (o)) != 0; \
            const float k0_ = up_ ? part[i + (n)] : part[i], s0_ = up_ ? part[i] : part[i + (n)], k1_ = up_ ? part[8 + i + (n)] : part[8 + i], s1_ = up_ ? part[8 + i] : part[8 + i + (n)]; \
            part[i] = k0_ + E1_XOR(s0_, (o)); part[8 + i] = k1_ + E1_XOR(s1_, (o)); }
#define E1_COMP(UR_, QH_, QL_, tt) do { if ((tt) < M) { float part[16]; \
        _Pragma("unroll") for (int i = 0; i < 16; ++i) { int sh_ = 0, sl_ = 0; \
            _Pragma("unroll") for (int w = 0; w < 4; ++w) { sh_ = __builtin_amdgcn_sdot8((int)UR_[i][w], (int)QH_[w], sh_, false); sl_ = __builtin_amdgcn_sdot8((int)UR_[i][w], (int)QL_[w], sl_, false); } \
            part[i] = (float)(sh_ * 16 + sl_); } \
        E1_TR(4, 4) E1_TR(2, 2) E1_TR(1, 1) \
        bf16* po_ = PART + (size_t)(tt) * 128 + 16 * gi + r; const unsigned pw_ = pk2(part[0], part[8]); po_[0] = (bf16)(pw_ & 0xffffu); po_[8] = (bf16)(pw_ >> 16); } } while (0)
    E1Meta mA, mB; v4u urA[16], urB[16]; unsigned qhA[4], qlA[4], qhB[4], qlB[4];
    int t = wsh;
    E1_META(mA, t); E1_META(mB, t + nwsh);
    E1_ROWS(urA, qhA, qlA, mA);
    for (; t < M; t += 2 * nwsh) {
        E1_META(mA, t + 2 * nwsh);
        E1_ROWS(urB, qhB, qlB, mB);
        E1_COMP(urA, qhA, qlA, t);
        E1_META(mB, t + 3 * nwsh);
        E1_ROWS(urA, qhA, qlA, mA);
        E1_COMP(urB, qhB, qlB, t + nwsh);
    }
#undef E1_META
#undef E1_ROWS
#undef E1_TR
#undef E1_XOR
#undef E1_COMP
}
__device__ __forceinline__ void er_phase(Frame& F) {
    constexpr int U = 4;
    const int gw = F.vcu * NWAVES + F.wave, NGW = F.G * NWAVES, lane = F.lane;
    const unsigned short* EIDX = WSP(unsigned short, WS_Q); const bf16* GATE = (const bf16*)(F.ws + WS_Q + 32 * MiB); unsigned char* COEF8 = (unsigned char*)(F.ws + WS_Q + 64 * MiB);
    const bf16* PART = WSP(bf16, WS_H); const float* SU = WSP(float, WS_SU); const float* SV = WSP(float, WS_SV); const float* SX = WSP(float, WS_SX);
    for (int t0 = gw; t0 < M; t0 += NGW * U) {
        float sacc[U][2], gt[U][2]; int ee[U][2];
#pragma unroll
        for (int u = 0; u < U; ++u) { const int t = t0 + u * NGW < M ? t0 + u * NGW : t0;
#pragma unroll
            for (int hs = 0; hs < 2; ++hs) { const int slot = lane + 64 * hs; float a = 0.f;
#pragma unroll
                for (int sh = 0; sh < 4; ++sh) a += bf1(PART[((size_t)sh * M + t) * 128 + slot]);
                sacc[u][hs] = a; ee[u][hs] = (int)EIDX[(size_t)t * 128 + slot]; gt[u][hs] = bf1(GATE[(size_t)t * 128 + slot]); } }
#pragma unroll
        for (int u = 0; u < U; ++u) { const int t = t0 + u * NGW < M ? t0 + u * NGW : t0; const float step0 = SX[t];
#pragma unroll
            for (int hs = 0; hs < 2; ++hs) { const float c = gt[u][hs] * gelu_tanh(SU[ee[u][hs]] * step0 * sacc[u][hs]) * SV[ee[u][hs]]; sacc[u][hs] = c; } }
#pragma unroll
        for (int u = 0; u < U; ++u) { const int t = t0 + u * NGW; if (t < M) {
#pragma unroll
            for (int hs = 0; hs < 2; ++hs) { const int k = 8 * (lane & 15) + (lane >> 4) + 4 * hs; const float cs = fminf(fmaxf(64.0f * sacc[u][hs], -448.f), 448.f);
                const int hi = __builtin_amdgcn_cvt_pk_fp8_f32(cs, 0.f, 0, false); const float rlo = 16.0f * (cs - __builtin_amdgcn_cvt_f32_fp8(hi, 0)); const int lo = __builtin_amdgcn_cvt_pk_fp8_f32(rlo, 0.f, 0, false);
                COEF8[(size_t)t * 256 + k] = (unsigned char)(hi & 0xff); COEF8[(size_t)t * 256 + 128 + k] = (unsigned char)(lo & 0xff); } } }
    }
}
struct E2Idx { v4u e0, e1; };
__device__ __forceinline__ void e2_phase(Frame& F) {
    typedef int i32x8 __attribute__((ext_vector_type(8))); typedef float f32x2s __attribute__((ext_vector_type(2)));
    const int lane = F.lane, g = lane >> 3, r = lane & 15, kb = lane >> 4, per = F.G >> 2, shard = F.vcu / (per > 0 ? per : 1) > 3 ? 3 : F.vcu / (per > 0 ? per : 1);
    const int wsh = (F.vcu - shard * per) * NWAVES + F.wave, nwsh = (shard == 3 ? F.G - 3 * per : per) * NWAVES;
    const unsigned char* X1Q = (const unsigned char*)(F.ws + WS_X1Q); const float* SX = WSP(float, WS_SX); const unsigned short* EIDX = WSP(unsigned short, WS_Q); const unsigned char* COEF8 = (const unsigned char*)(F.ws + WS_Q + 64 * MiB);
    const unsigned char* tb = WSP(unsigned char, WS_PV) + (size_t)shard * SHARD_BYTES; bf16* Y2 = (bf16*)(F.ws + WS_H + 256 * MiB);
    LAS unsigned char* LB = F.lds + F.wave * 16384;
    const unsigned roff = (unsigned)(((lane & 7) ^ g) << 4);
    const unsigned rdbase = (unsigned)(size_t)LB + (unsigned)((32 * kb + r) * 128);
    __syncthreads();
#define E2_IDX(E_, tt) do { const int t_ = (tt) < M ? (tt) : wsh; \
        E_.e0 = *(const GAS v4u*)(EIDX + (size_t)t_ * 128 + 16 * g); E_.e1 = *(const GAS v4u*)(EIDX + (size_t)t_ * 128 + 16 * g + 8); } while (0)
#define E2_GATHER(E_) do { _Pragma("unroll") for (int j = 0; j < 16; ++j) { const unsigned w_ = j < 8 ? E_.e0[j >> 1] : E_.e1[(j - 8) >> 1]; const unsigned id_ = (j & 1) ? (w_ >> 16) : (w_ & 0xffffu); \
            __builtin_amdgcn_global_load_lds((const unsigned*)(tb + (size_t)(id_ * 128u + roff)), (LAS unsigned*)(LB + j * 1024), 16, 0, 0); } } while (0)
#define E2_UNIT(ECUR_, ENXT_, tt) do { const int t_ = (tt) < M ? (tt) : wsh;     \
        v4u a0_ = (v4u){0u, 0u, 0u, 0u}, a1_ = a0_, xq_ = a0_; float sx_ = 0.f; \
        if (r < 2) { \
            if (E2_ALAY == 1) { a0_ = *(const GAS v4u*)(COEF8 + (size_t)t_ * 256 + r * 128 + 16 * kb); a1_ = *(const GAS v4u*)(COEF8 + (size_t)t_ * 256 + r * 128 + 64 + 16 * kb); }     \
            else if (E2_ALAY == 2) { const v2u p0_ = *(const GAS v2u*)(COEF8 + (size_t)t_ * 256 + r * 128 + 8 * kb), p1_ = *(const GAS v2u*)(COEF8 + (size_t)t_ * 256 + r * 128 + 32 + 8 * kb), p2_ = *(const GAS v2u*)(COEF8 + (size_t)t_ * 256 + r * 128 + 64 + 8 * kb), p3_ = *(const GAS v2u*)(COEF8 + (size_t)t_ * 256 + r * 128 + 96 + 8 * kb); \
                a0_ = (v4u){p0_.x, p0_.y, p1_.x, p1_.y}; a1_ = (v4u){p2_.x, p2_.y, p3_.x, p3_.y}; }     \
            else { a0_ = *(const GAS v4u*)(COEF8 + (size_t)t_ * 256 + r * 128 + 32 * kb); a1_ = *(const GAS v4u*)(COEF8 + (size_t)t_ * 256 + r * 128 + 32 * kb + 16); } } \
        if (lane < 16) { xq_ = *(const GAS v4u*)(X1Q + (size_t)t_ * D + 256 * shard + 16 * lane); sx_ = ALPHA * SX[t_]; }     \
        asm volatile("s_waitcnt vmcnt(0)" ::: "memory");                  \
        v2u bq_[16][2]; \
        _Pragma("unroll") for (int q = 0; q < 8; ++q) { const unsigned ad_ = rdbase + (unsigned)((q ^ (r & 7)) << 4); \
            asm volatile("ds_read_b64_tr_b4 %0, %4\n\tds_read_b64_tr_b4 %1, %4 offset:2048\n\tds_read_b64_tr_b4 %2, %4 offset:8\n\tds_read_b64_tr_b4 %3, %4 offset:2056" \
                         : "=&v"(bq_[2 * q][0]), "=&v"(bq_[2 * q][1]), "=&v"(bq_[2 * q + 1][0]), "=&v"(bq_[2 * q + 1][1]) : "v"(ad_) : "memory"); } \
        asm volatile("s_waitcnt lgkmcnt(0)" : "+v"(bq_[0][0]), "+v"(bq_[0][1]), "+v"(bq_[1][0]), "+v"(bq_[1][1]), "+v"(bq_[2][0]), "+v"(bq_[2][1]), "+v"(bq_[3][0]), "+v"(bq_[3][1]) :: "memory");     \
        asm volatile("" : "+v"(bq_[4][0]), "+v"(bq_[4][1]), "+v"(bq_[5][0]), "+v"(bq_[5][1]), "+v"(bq_[6][0]), "+v"(bq_[6][1]), "+v"(bq_[7][0]), "+v"(bq_[7][1]) :: "memory"); \
        asm volatile("" : "+v"(bq_[8][0]), "+v"(bq_[8][1]), "+v"(bq_[9][0]), "+v"(bq_[9][1]), "+v"(bq_[10][0]), "+v"(bq_[10][1]), "+v"(bq_[11][0]), "+v"(bq_[11][1]) :: "memory"); \
        asm volatile("" : "+v"(bq_[12][0]), "+v"(bq_[12][1]), "+v"(bq_[13][0]), "+v"(bq_[13][1]), "+v"(bq_[14][0]), "+v"(bq_[14][1]), "+v"(bq_[15][0]), "+v"(bq_[15][1]) :: "memory"); \
        E2_GATHER(ENXT_);                                                \
        E2_IDX(ECUR_, (tt) + 2 * nwsh); \
        const i32x8 a8_ = (i32x8){(int)a0_.x, (int)a0_.y, (int)a0_.z, (int)a0_.w, (int)a1_.x, (int)a1_.y, (int)a1_.z, (int)a1_.w}; float val_[16]; \
        _Pragma("unroll") for (int nb = 0; nb < 16; ++nb) { const i32x8 b8_ = (i32x8){(int)bq_[nb][0].x, (int)bq_[nb][0].y, (int)bq_[nb][1].x, (int)bq_[nb][1].y, 0, 0, 0, 0}; \
            const f32x4 d_ = __builtin_amdgcn_mfma_scale_f32_16x16x128_f8f6f4(a8_, b8_, (f32x4){0.f, 0.f, 0.f, 0.f}, 0  , 4  , 0, 0, 0, 0); \
            val_[nb] = (d_[0] + d_[1] * 0.0625f) * (1.0f / 64.0f); } \
        if (lane < 16) { v4u o0_, o1_; float xr_[16]; \
            _Pragma("unroll") for (int i = 0; i < 16; ++i) xr_[i] = sx_ * (float)(((int)(xq_[i >> 2] << (24 - 8 * (i & 3)))) >> 24); \
            o0_.x = pk2(xr_[0] + val_[0], xr_[1] + val_[1]); o0_.y = pk2(xr_[2] + val_[2], xr_[3] + val_[3]); o0_.z = pk2(xr_[4] + val_[4], xr_[5] + val_[5]); o0_.w = pk2(xr_[6] + val_[6], xr_[7] + val_[7]); \
            o1_.x = pk2(xr_[8] + val_[8], xr_[9] + val_[9]); o1_.y = pk2(xr_[10] + val_[10], xr_[11] + val_[11]); o1_.z = pk2(xr_[12] + val_[12], xr_[13] + val_[13]); o1_.w = pk2(xr_[14] + val_[14], xr_[15] + val_[15]); \
            *(GAS v4u*)(Y2 + (size_t)t_ * D + 256 * shard + 16 * lane) = o0_; *(GAS v4u*)(Y2 + (size_t)t_ * D + 256 * shard + 16 * lane + 8) = o1_; } } while (0)
    E2Idx eA, eB;
    int t = wsh;
    E2_IDX(eA, t); E2_IDX(eB, t + nwsh);
    E2_GATHER(eA);
    for (; t < M; t += 2 * nwsh) {
        E2_UNIT(eA, eB, t);
        E2_UNIT(eB, eA, t + nwsh);
    }
    asm volatile("s_waitcnt vmcnt(0)" ::: "memory");
    __syncthreads();
#undef E2_IDX
#undef E2_GATHER
#undef E2_UNIT
}
__device__ __forceinline__ void ln2_phase(Frame& F) {
    constexpr int U = 4;
    const int gw = F.vcu * NWAVES + F.wave, NGW = F.G * NWAVES, lane = F.lane;
    const bf16* Y = (const bf16*)(F.ws + WS_H + 256 * MiB);
    f32x4 g[4], bb[4];
#pragma unroll
    for (int j = 0; j < 4; ++j) { g[j] = *((const GAS f32x4*)F.a->in[18] + lane + 64 * j); bb[j] = *((const GAS f32x4*)F.a->in[19] + lane + 64 * j); }
    for (int t0 = gw; t0 < M; t0 += NGW * U) {
        f32x4 v[U][4]; float s[U], s2[U];
#pragma unroll
        for (int u = 0; u < U; ++u) { const int t = t0 + u * NGW < M ? t0 + u * NGW : t0; const GAS v2u* yr = (const GAS v2u*)(Y + (size_t)t * D) + lane;
#pragma unroll
            for (int j = 0; j < 4; ++j) { const v2u w = yr[64 * j]; v[u][j] = (f32x4){bflo(w.x), bfhi(w.x), bflo(w.y), bfhi(w.y)}; } }
#pragma unroll
        for (int u = 0; u < U; ++u) { s[u] = 0.f;
#pragma unroll
            for (int j = 0; j < 4; ++j) s[u] += (v[u][j][0] + v[u][j][1]) + (v[u][j][2] + v[u][j][3]); }
        wave_sum_n<U>(s);
#pragma unroll
        for (int u = 0; u < U; ++u) { const float mean = s[u] * (1.f / D); s2[u] = 0.f;
#pragma unroll
            for (int j = 0; j < 4; ++j) { v[u][j] = v[u][j] - mean; s2[u] += (v[u][j][0] * v[u][j][0] + v[u][j][1] * v[u][j][1]) + (v[u][j][2] * v[u][j][2] + v[u][j][3] * v[u][j][3]); } }
        wave_sum_n<U>(s2);
#pragma unroll
        for (int u = 0; u < U; ++u) { const int t = t0 + u * NGW; const float rstd = 1.f / sqrtf(s2[u] * (1.f / D) + LN_EPS); if (t < M) {
#pragma unroll
            for (int j = 0; j < 4; ++j) *((GAS f32x4*)(F.out + (size_t)t * D) + lane + 64 * j) = v[u][j] * rstd * g[j] + bb[j]; } }
    }
}

__device__ __forceinline__ void ph1_inproj(Frame& F) {
    pg8::Gemm g{WSP(bf16, WS_XQ), WSP(bf16, WS_WIN_T), M, HW, 512, 512, 512}; pg8::StaticOrder S; S.init(M, HW, F.G, (int)blockIdx.x);
    pg8::EpiI8G E{WSP(bf16, WS_H), HW, WSP(float, WS_SX), WSP(float, WS_SW), WSP(float, WS_BIASP), H_GA, H_GB + 1024, 2048};
    pg8::gemm_phase<pg8::EpiI8G, pg8::StaticOrder, true, true, 1>(F.lds, g, S, E);
}
__device__ __forceinline__ void ph3_up(Frame& F) {
    { pg8::Gemm g{WSP(bf16, WS_XB), WSP(bf16, WS_WQ_T), M, 768, 384, 384, 384}; pg8::StaticOrder S; S.init(M, 768, F.G, (int)blockIdx.x);
      pg8::EpiI8F8 E{WSP(unsigned char, WS_Q), 768, WSP(float, WS_RSQ), WSP(float, WS_SW) + 12288};
      pg8::gemm_phase<pg8::EpiI8F8, pg8::StaticOrder, true, true, 1>(F.lds, g, S, E); }
    __syncthreads();
    { pg8::Gemm g{(const bf16*)((const unsigned char*)WSP(bf16, WS_H) + H_CKV), WSP(bf16, WS_WKV_T), M, 1024, 128, HW, 128};     pg8::StaticOrder S; S.init(M, 1024, F.G, (int)blockIdx.x);
      pg8::EpiScaleF8 E{WSP(unsigned char, WS_KV), 1024, WSP(float, WS_RSKV)};
      pg8::gemm_phase<pg8::EpiScaleF8, pg8::StaticOrder, true, true, 2>(F.lds, g, S, E); }
}
__device__ __forceinline__ void peer_tables_convert(Frame& F) {
    { const int gwq = F.vcu * NWAVES + F.wave, NGWq = F.G * NWAVES, lane = F.lane;
      for (int r = gwq; r < 2 * 16384; r += NGWq) {
          const int tb = r >> 14, row = r & 16383; const float* srow = (tb ? F.a->in[17] : F.a->in[16]) + (size_t)row * 1024;
          float x[16]; float ss = 0.f;
          if (tb) {
#pragma unroll
              for (int n = 0; n < 16; ++n) x[n] = srow[256 * (lane >> 4) + 16 * n + (lane & 15)];
          } else {
#pragma unroll
              for (int j = 0; j < 4; ++j) { const f32x4 v = *(const GAS f32x4*)(srow + 16 * lane + 4 * j); x[4 * j] = v[0]; x[4 * j + 1] = v[1]; x[4 * j + 2] = v[2]; x[4 * j + 3] = v[3]; }
          }
#pragma unroll
          for (int n = 0; n < 16; ++n) ss += x[n] * x[n];
#pragma unroll
          for (int o = 1; o < 64; o <<= 1) ss += __shfl_xor(ss, o);
          const float rms = sqrtf(ss * (1.0f / 1024.0f));
          const float sc = rms > 0.f ? (tb ? rms * (1.0f / 2.1f) : rms * 0.335f) : 1.0f, isc = 1.0f / sc;
          v2u o2;
#pragma unroll
          for (int h = 0; h < 2; ++h) { unsigned w = 0u;
#pragma unroll
              for (int i = 0; i < 8; ++i) { const float xs = x[8 * h + i] * isc; unsigned c; int pos;
                  if (tb) { const float a = fabsf(xs); c = (unsigned)((a > 0.25f) + (a > 0.75f) + (a > 1.25f) + (a > 1.75f) + (a > 2.5f) + (a > 3.5f) + (a > 5.0f)) | (xs < 0.f ? 8u : 0u); pos = 4 * i; }
                  else { float q = rintf(xs); q = fminf(fmaxf(q, -8.f), 7.f); c = (unsigned)(int)q & 0xfu; pos = 8 * (i & 3) + 4 * (i >> 2); }
                  w |= c << pos; }
              if (h == 0) o2.x = w; else o2.y = w; }
          *(GAS v2u*)((unsigned char*)(F.ws + (tb ? WS_PV : WS_PU)) + (size_t)(lane >> 4) * SHARD_BYTES + (size_t)row * 128 + 8 * (lane & 15)) = o2;
          if (lane == 0) ((float*)(F.ws + (tb ? WS_SV : WS_SU)))[row] = sc;
      } }
}
__device__ __forceinline__ void ph4_attn(Frame& F) {
#if !EXP_NOMIX && !EXP_NOMLA
    if ((PHASE_MASK >> 17) & 1) { mla_phase(F); int t_ = threadIdx.x; asm volatile("" : "+v"(t_)); F.tid = t_; F.lane = t_ & 63; }
#endif
#if !EXP_NOMIX && !EXP_NODSA
    if ((PHASE_MASK >> 16) & 1) dsa_phase(F);
#endif
    peer_tables_convert(F);
}
__device__ __forceinline__ void ph5_merge(Frame& F) {
#if EXP_NOMIX
    { const size_t gtid = (size_t)F.vcu * (NWAVES * 64) + F.tid, NT = (size_t)F.G * (NWAVES * 64); for (size_t i = gtid; i < (size_t)M * 1024 / 8; i += NT) *(GAS v4u*)(WSP(bf16, WS_Q) + 8 * i) = (v4u){0u, 0u, 0u, 0u}; }
#else
    { pg8::Gemm g{WSP(bf16, WS_XB), WSP(bf16, WS_WOA_T), M, 1024, 512, 512, 512}; pg8::StaticOrder S; S.init(M, 1024, F.G, (int)blockIdx.x);
      pg8::EpiGate2 E{(unsigned char*)(F.ws + WS_Q), 1024, (const unsigned char*)(WSP(bf16, WS_H) + H_GA), 2 * HW, 1.0f / 8192.0f};
      pg8::gemm_phase<pg8::EpiGate2, pg8::StaticOrder, true, true, 2>(F.lds, g, S, E); }
#endif
}
__device__ __forceinline__ void ph6_out(Frame& F) {
    pg8::Gemm g{(const bf16*)(F.ws + WS_Q), WSP(bf16, WS_WOUT_T), M, 1024, 512, 512, 512}; pg8::StaticOrder S; S.init(M, 1024, F.G, (int)blockIdx.x);
    pg8::EpiResF32 E{WSP(bf16, WS_H), F.a->in[0], 1024, ALPHA, 1.0f / 8192.0f};
    pg8::gemm_phase<pg8::EpiResF32, pg8::StaticOrder, true, true, 2>(F.lds, g, S, E);
}
__device__ __forceinline__ void ph8_peerq(Frame& F) {
    pg8::Gemm g{WSP(bf16, WS_X1Q), WSP(bf16, WS_WPQ_T), M, 2048, 512, 512, 512}; pg8::StaticOrder S; S.init(M, 2048, F.G, (int)blockIdx.x);
    pg8::EpiI8 E{(bf16*)(F.ws + WS_H + 256 * MiB), 2048, WSP(float, WS_SX), WSP(float, WS_SW) + 8192, nullptr};
    pg8::gemm_phase<pg8::EpiI8, pg8::StaticOrder, true, true, 1>(F.lds, g, S, E);
}

__global__ void __launch_bounds__(NWAVES * 64, 2) fwd_kernel(Args args) {
    extern __shared__ __attribute__((aligned(16))) unsigned char lds[];
    Frame F;
    F.lds = (LAS unsigned char*)lds;
    F.tid = threadIdx.x; F.lane = F.tid & 63; F.wave = __builtin_amdgcn_readfirstlane(F.tid >> 6);
    F.G = gridDim.x; { const int bx = blockIdx.x; F.vcu = (F.G % 8 == 0) ? (bx % 8) * (F.G / 8) + bx / 8 : bx; }
    F.a = &args; F.pos = (const int*)args.in[1]; F.out = args.out; F.ws = args.ws;
    volatile LAS unsigned* MISC = (volatile LAS unsigned*)(F.lds + MISC_OFF);
    if (F.tid < 32) MISC[F.tid] = 0u;
    __syncthreads();
    XcdBarrier bar = xcd_barrier_post((unsigned*)(F.ws + WS_CTL) + CW_BAR, MISC + 8);
    const int lo = args.ph_lo, hi = args.ph_hi;
#define IN(k) (lo <= (k) && (k) < hi && ((PHASE_MASK >> (k)) & 1))
#define SEAM(k) do { if (IN(k) && IN((k) + 1)) xcd_barrier(bar); } while (0)

#define RUNPH(k, call) do { if (IN(k)) { call; if ((REPEAT_MASK >> (k)) & 1) { xcd_barrier(bar); call; } } } while (0)
    RUNPH(0, p0_prologue(F)); SEAM(0);
    RUNPH(1, ph1_inproj(F)); SEAM(1);
    RUNPH(2, p2_small(F)); SEAM(2);
    RUNPH(3, ph3_up(F)); SEAM(3);
    RUNPH(4, ph4_attn(F)); SEAM(4);
    RUNPH(5, ph5_merge(F)); SEAM(5);
    RUNPH(6, ph6_out(F)); SEAM(6);
    RUNPH(7, ln1_phase(F)); SEAM(7);
    RUNPH(8, ph8_peerq(F)); SEAM(8);
    RUNPH(9, route_phase(F)); SEAM(9);
    RUNPH(10, e1_phase(F)); SEAM(10);
    RUNPH(11, er_phase(F)); SEAM(11);
    RUNPH(12, e2_phase(F)); SEAM(12);
    RUNPH(13, ln2_phase(F));
#undef RUNPH
#undef IN
#undef SEAM
}

extern "C" void kernel_launch(void* const* d_in, const int* in_sizes, int n_in, void* d_out, int out_size, void* d_ws, size_t ws_size, hipStream_t stream) {
    static int grid = 0;
    if (grid == 0) {
        if (n_in != 20 || out_size != M * D || ws_size < WS_END) { fprintf(stderr, "kernel_launch: unexpected shapes (n_in %d out %d ws %zu)\n", n_in, out_size, ws_size); grid = -1; return; }
        int dev = 0, cus = 0, per_cu = 0;
        if (hipGetDevice(&dev) != hipSuccess || hipDeviceGetAttribute(&cus, hipDeviceAttributeMultiprocessorCount, dev) != hipSuccess) { grid = -1; return; }
        if (hipFuncSetAttribute((const void*)fwd_kernel, hipFuncAttributeMaxDynamicSharedMemorySize, LDS_BYTES) != hipSuccess) { grid = -1; return; }
        if (hipOccupancyMaxActiveBlocksPerMultiprocessor(&per_cu, (const void*)fwd_kernel, NWAVES * 64, LDS_BYTES) != hipSuccess || per_cu < 1) { fprintf(stderr, "kernel_launch: occupancy query says %d\n", per_cu); }
        (void)hipGetLastError();
        grid = cus;
    }
    if (grid < 0) return;
    (void)hipMemsetAsync((char*)d_ws + WS_CTL, 0, CTL_ZERO_BYTES, stream);
    Args a{};
    for (int i = 0; i < 20; ++i) a.in[i] = (const float*)d_in[i];
    a.out = (float*)d_out; a.ws = (unsigned char*)d_ws; a.ph_lo = 0; a.ph_hi = NPHASES;
    hipLaunchKernelGGL(fwd_kernel, dim3(grid), dim3(NWAVES * 64), LDS_BYTES, stream, a);
}
```
